# Optimizing an MI355X kernel written in HIP

```python
import jax, jax.numpy as jnp
from jax import lax
import numpy as np

D_MODEL = 1024
BATCH = 2
SEQ = 8192
DEPTH = 1

PLE_DIM = 256
HEAD_DIM = 64
N_ATTN_HEADS = 8
D_ATTN = N_ATTN_HEADS * HEAD_DIM
D_CONV = D_MODEL // 2
D_MIX = D_ATTN + D_CONV
D_IN = 3 * D_ATTN + 2 * D_CONV
CONV_WIDTH = 31
ROPE_DIM = HEAD_DIM // 4
ROPE_THETA = 500000.0
DILATED_PATTERNS = ((128, 1), (512, 4), (2048, 16))
ATTN_BLOCK = 128
N_KEYS = 128
N_EXPERTS = N_KEYS * N_KEYS
PEER_HEADS = 8
PEER_TOPK = 16
D_KEY = 256
PEER_BLOCK = 128
EPS = 1e-6

kernel_name = "hymba_dilated_conformer_peer_layer"


def _rmsnorm(x, g):
    xf = x.astype(jnp.float32)
    y = xf * lax.rsqrt(jnp.mean(xf * xf, axis=-1, keepdims=True) + EPS)
    return (y * g.astype(jnp.float32)).astype(x.dtype)


def _layernorm(x, g, b):
    xf = x.astype(jnp.float32)
    mu = jnp.mean(xf, axis=-1, keepdims=True)
    var = jnp.mean(jnp.square(xf - mu), axis=-1, keepdims=True)
    y = (xf - mu) * lax.rsqrt(var + EPS)
    return (y * g.astype(jnp.float32) + b.astype(jnp.float32)).astype(x.dtype)


def _partial_rope(t, positions):
    inv_freq = ROPE_THETA ** (-jnp.arange(0, ROPE_DIM, 2, dtype=jnp.float32) / ROPE_DIM)
    ang = positions.astype(jnp.float32)[..., None] * inv_freq
    cos = jnp.cos(ang)[:, :, None, :]
    sin = jnp.sin(ang)[:, :, None, :]
    tr = t[..., :ROPE_DIM].astype(jnp.float32)
    t1, t2 = tr[..., :ROPE_DIM // 2], tr[..., ROPE_DIM // 2:]
    rot = jnp.concatenate([t1 * cos - t2 * sin, t2 * cos + t1 * sin], axis=-1).astype(t.dtype)
    return jnp.concatenate([rot, t[..., ROPE_DIM:]], axis=-1)


def _dilated_attention(q, k, v, window, dilation):
    B, S, H, Dh = q.shape
    span = window // dilation
    L = S // dilation
    nb = -(-L // ATTN_BLOCK)
    Lp = nb * ATTN_BLOCK

    def to_sub(t):
        t = t.reshape(B, L, dilation, H, Dh).transpose(0, 2, 3, 1, 4)
        return jnp.pad(t, ((0, 0), (0, 0), (0, 0), (0, Lp - L), (0, 0)))

    def windows(t):
        t = jnp.pad(t, ((0, 0), (0, 0), (0, 0), (ATTN_BLOCK, 0), (0, 0)))
        t = t.reshape(B, dilation, H, nb + 1, ATTN_BLOCK, Dh)
        return jnp.concatenate([t[:, :, :, :-1], t[:, :, :, 1:]], axis=4)

    qb = to_sub(q).reshape(B, dilation, H, nb, ATTN_BLOCK, Dh)
    kw = windows(to_sub(k))
    vw = windows(to_sub(v))
    qi = jnp.arange(ATTN_BLOCK)[:, None]
    kj = jnp.arange(2 * ATTN_BLOCK)[None, :]
    blk = jnp.arange(nb)[:, None, None]
    dist = ATTN_BLOCK + qi - kj
    key_pos = blk * ATTN_BLOCK + kj - ATTN_BLOCK
    mask = (dist >= 0) & (dist <= span) & (key_pos >= 0)
    s = jnp.einsum('bdhnqe,bdhnke->bdhnqk', qb, kw,
                   preferred_element_type=jnp.float32) * (Dh ** -0.5)
    s = jnp.where(mask, s, -jnp.inf)
    m = jnp.max(s, axis=-1, keepdims=True)
    e = jnp.exp(s - m)
    l = jnp.sum(e, axis=-1, keepdims=True)
    o = jnp.einsum('bdhnqk,bdhnke->bdhnqe', e.astype(vw.dtype), vw,
                   preferred_element_type=jnp.float32) / l
    lse = (m + jnp.log(l))[..., 0]

    def from_sub(t):
        t = t.reshape(B, dilation, H, Lp, *t.shape[5:])[:, :, :, :L]
        t = jnp.moveaxis(t, 3, 1)
        return t.reshape(B, S, H, *t.shape[4:])

    return from_sub(o), from_sub(lse)


def _token_mixers(xn, positions, w_in, conv_w, conv_b, conv_ln_g, conv_ln_b,
                  g_attn_out, g_conv_out, w_out):
    B, S, _ = xn.shape
    z = xn @ w_in
    q, k, v, a, gt = jnp.split(z, [D_ATTN, 2 * D_ATTN, 3 * D_ATTN, 3 * D_ATTN + D_CONV], axis=-1)
    heads = lambda t: t.reshape(B, S, N_ATTN_HEADS, HEAD_DIM)
    q = _partial_rope(heads(q), positions)
    k = _partial_rope(heads(k), positions)
    v = heads(v)
    outs, lses = zip(*[_dilated_attention(q, k, v, w, d) for (w, d) in DILATED_PATTERNS])
    alpha = jax.nn.softmax(jnp.stack(lses, axis=0), axis=0)
    attn = jnp.sum(alpha[..., None] * jnp.stack(outs, axis=0), axis=0)
    attn = attn.reshape(B, S, D_ATTN).astype(xn.dtype)
    glu = a * jax.nn.sigmoid(gt)
    c = lax.conv_general_dilated(glu, conv_w[:, None, :], window_strides=(1,),
                                 padding=[(CONV_WIDTH - 1, 0)],
                                 dimension_numbers=('NWC', 'WIO', 'NWC'),
                                 feature_group_count=D_CONV) + conv_b
    c = jax.nn.silu(_layernorm(c, conv_ln_g, conv_ln_b))
    y = jnp.concatenate([_rmsnorm(attn, g_attn_out), _rmsnorm(c, g_conv_out)], axis=-1)
    return y @ w_out


def _peer(xn, w_q, sub_keys, expert_u, expert_v):
    B, S, D = xn.shape
    N = B * S
    HK = PEER_HEADS * PEER_TOPK
    xt = xn.reshape(N, D)
    q = (xt @ w_q).reshape(N, PEER_HEADS, 2, D_KEY // 2)
    s = jnp.einsum('nhpc,pkc->nhpk', q, sub_keys, preferred_element_type=jnp.float32)
    s_half, i_half = lax.top_k(s, PEER_TOPK)
    cand = (s_half[:, :, 0, :, None] + s_half[:, :, 1, None, :]).reshape(
        N, PEER_HEADS, PEER_TOPK * PEER_TOPK)
    top_s, top_c = lax.top_k(cand, PEER_TOPK)
    i1 = jnp.take_along_axis(i_half[:, :, 0], top_c // PEER_TOPK, axis=-1)
    i2 = jnp.take_along_axis(i_half[:, :, 1], top_c % PEER_TOPK, axis=-1)
    nblk = N // PEER_BLOCK
    expert = (i1 * N_KEYS + i2).reshape(nblk, PEER_BLOCK, HK)
    gate = jax.nn.softmax(top_s, axis=-1).reshape(nblk, PEER_BLOCK, HK)

    def block(args):
        xb, eb, gb = args
        h = jnp.einsum('td,tkd->tk', xb, expert_u[eb], preferred_element_type=jnp.float32)
        act = (jax.nn.gelu(h, approximate=False) * gb).astype(xb.dtype)
        return jnp.einsum('tk,tkd->td', act, expert_v[eb])

    y = lax.map(block, (xt.reshape(nblk, PEER_BLOCK, D), expert, gate))
    return y.reshape(B, S, D)


def setup_inputs(seed: int = 0) -> dict:
    key = jax.random.key(seed)
    ks = jax.random.split(key, 20)
    nrm = lambda k, shape, scale: jax.random.normal(k, shape, jnp.float32) * scale
    gain = lambda k, shape: 1.0 + 0.02 * jax.random.normal(k, shape, jnp.float32)
    return {
        "x": nrm(ks[0], (BATCH, SEQ, D_MODEL), 1.0),
        "p": nrm(ks[1], (DEPTH, BATCH, SEQ, PLE_DIM), 1.0),
        "positions": jnp.broadcast_to(jnp.arange(SEQ, dtype=jnp.int32), (BATCH, SEQ)),
        "norm_mix": gain(ks[2], (DEPTH, D_MODEL)),
        "w_in": nrm(ks[3], (DEPTH, D_MODEL, D_IN), D_MODEL ** -0.5),
        "conv_w": nrm(ks[4], (DEPTH, CONV_WIDTH, D_CONV), CONV_WIDTH ** -0.5),
        "conv_b": nrm(ks[5], (DEPTH, D_CONV), 0.02),
        "conv_ln_g": gain(ks[6], (DEPTH, D_CONV)),
        "conv_ln_b": nrm(ks[7], (DEPTH, D_CONV), 0.02),
        "g_attn_out": gain(ks[8], (DEPTH, D_ATTN)),
        "g_conv_out": gain(ks[9], (DEPTH, D_CONV)),
        "w_out": nrm(ks[10], (DEPTH, D_MIX, D_MODEL), D_MIX ** -0.5),
        "norm_ffn": gain(ks[11], (DEPTH, D_MODEL)),
        "peer_wq": nrm(ks[12], (DEPTH, D_MODEL, PEER_HEADS * D_KEY), D_MODEL ** -0.5),
        "sub_keys": nrm(ks[13], (DEPTH, 2, N_KEYS, D_KEY // 2), (D_KEY // 2) ** -0.5),
        "expert_u": nrm(ks[14], (DEPTH, N_EXPERTS, D_MODEL), D_MODEL ** -0.5),
        "expert_v": nrm(ks[15], (DEPTH, N_EXPERTS, D_MODEL), PEER_HEADS ** -0.5),
        "norm_ple": gain(ks[16], (DEPTH, D_MODEL)),
        "w_ple_gate": nrm(ks[17], (DEPTH, D_MODEL, D_MODEL), D_MODEL ** -0.5),
        "w_ple_proj": nrm(ks[18], (DEPTH, PLE_DIM, D_MODEL), PLE_DIM ** -0.5),
        "final_norm": gain(ks[19], (D_MODEL,)),
    }


def reference(x, p, positions, norm_mix, w_in, conv_w, conv_b, conv_ln_g, conv_ln_b,
              g_attn_out, g_conv_out, w_out, norm_ffn, peer_wq, sub_keys, expert_u,
              expert_v, norm_ple, w_ple_gate, w_ple_proj, final_norm):
    h = x
    for i in range(DEPTH):
        h = h + _token_mixers(_rmsnorm(h, norm_mix[i]), positions, w_in[i], conv_w[i], conv_b[i],
                              conv_ln_g[i], conv_ln_b[i], g_attn_out[i], g_conv_out[i], w_out[i])
        h = h + _peer(_rmsnorm(h, norm_ffn[i]), peer_wq[i], sub_keys[i], expert_u[i], expert_v[i])
        ple_gate = jax.nn.sigmoid(_rmsnorm(h, norm_ple[i]) @ w_ple_gate[i])
        h = h + ple_gate * (p[i] @ w_ple_proj[i])
    return _rmsnorm(h, final_norm)
```

```cpp
#include <hip/hip_runtime.h>
#include <cstdio>
#include <cstdint>
#include <cmath>

constexpr int BATCH = 2, SEQ = 8192, DM = 1024, NTOK = BATCH * SEQ;
constexpr int PLE = 256, HD = 64, NH = 8, DATT = 512, DCONV = 512, DIN = 2560, CW = 31;
constexpr int NKEYS = 128, NEXP = 16384, PH = 8, TOPK = 16, HK = PH * TOPK;
constexpr float EPS = 1e-6f;
constexpr float QSCALE = 0.125f * 1.4426950408889634f;

typedef unsigned short bf16;
typedef unsigned v4u __attribute__((ext_vector_type(4)));
typedef unsigned v2u __attribute__((ext_vector_type(2)));
typedef float f32x4 __attribute__((ext_vector_type(4)));

constexpr size_t MiB = 1u << 20;
constexpr size_t WS_CTL = 0;
constexpr size_t WS_ROPE = 1 * MiB;
constexpr size_t WS_WIN = 2 * MiB;
constexpr size_t WS_WOUT = 7 * MiB;
constexpr size_t WS_WQK = 9 * MiB;
constexpr size_t WS_WG = 13 * MiB;
constexpr size_t WS_WP = 15 * MiB;
constexpr size_t WS_U = 16 * MiB;
constexpr size_t WS_V = 48 * MiB;
constexpr size_t WS_XN = 80 * MiB;
constexpr size_t WS_Q = 112 * MiB, WS_K = 128 * MiB, WS_VV = 144 * MiB, WS_GLU = 160 * MiB;
constexpr size_t WS_SC = 112 * MiB;
constexpr size_t WS_ATT = 176 * MiB;
constexpr size_t WS_Y = 192 * MiB;
constexpr size_t WS_EID = 224 * MiB;
constexpr size_t WS_GATE = 232 * MiB;
constexpr size_t WS_PP = 240 * MiB;
constexpr size_t WS_MISC = 248 * MiB;
constexpr size_t WS_END = 256 * MiB;

__device__ __forceinline__ unsigned f2bf(float f) { unsigned u = __float_as_uint(f); return (u + 0x7fffu + ((u >> 16) & 1u)) >> 16; }
__device__ __forceinline__ float bf2f(unsigned h) { return __uint_as_float(h << 16); }
__device__ __forceinline__ unsigned pk2(float lo, float hi) { return f2bf(lo) | (f2bf(hi) << 16); }
__device__ __forceinline__ float bflo(unsigned w) { return __uint_as_float(w << 16); }
__device__ __forceinline__ float bfhi(unsigned w) { return __uint_as_float(w & 0xffff0000u); }
__device__ __forceinline__ float wave_sum(float v) {
#pragma unroll
    for (int o = 1; o < 64; o <<= 1) v += __shfl_xor(v, o);
    return v;
}
__device__ __forceinline__ float sigmoidf_(float x) { return 1.f / (1.f + __expf(-x)); }
__device__ __forceinline__ float gelu_erf(float x) { return 0.5f * x * (1.f + erff(x * 0.70710678118654752f)); }

__device__ __forceinline__ unsigned f2key(float f) { unsigned u = __float_as_uint(f); return (u & 0x80000000u) ? ~u : (u | 0x80000000u); }
__device__ __forceinline__ float key2f(unsigned k) { unsigned u = (k & 0x80000000u) ? (k & 0x7fffffffu) : ~k; return __uint_as_float(u); }
__device__ __forceinline__ void ins16(unsigned (&L)[16], unsigned x) {
#pragma unroll
    for (int i = 0; i < 16; ++i) { const unsigned h = L[i] > x ? L[i] : x; x = L[i] > x ? x : L[i]; L[i] = h; }
}
#define INS16(L, xx) ins16(L, (xx))
__device__ __forceinline__ int sel16(const int (&a)[16], int i) {
    int v0 = a[0], v1 = a[1], v2 = a[2], v3 = a[3], v4 = a[4], v5 = a[5], v6 = a[6], v7 = a[7], v8 = a[8], v9 = a[9], v10 = a[10], v11 = a[11], v12 = a[12], v13 = a[13], v14 = a[14], v15 = a[15];
    asm volatile("" : "+v"(v0), "+v"(v1), "+v"(v2), "+v"(v3), "+v"(v4), "+v"(v5), "+v"(v6), "+v"(v7));
    asm volatile("" : "+v"(v8), "+v"(v9), "+v"(v10), "+v"(v11), "+v"(v12), "+v"(v13), "+v"(v14), "+v"(v15));
    const bool b0 = i & 1, b1 = i & 2, b2 = i & 4, b3 = i & 8;
    const int t0 = b0 ? v1 : v0, t1 = b0 ? v3 : v2, t2 = b0 ? v5 : v4, t3 = b0 ? v7 : v6, t4 = b0 ? v9 : v8, t5 = b0 ? v11 : v10, t6 = b0 ? v13 : v12, t7 = b0 ? v15 : v14;
    const int s0 = b1 ? t1 : t0, s1 = b1 ? t3 : t2, s2 = b1 ? t5 : t4, s3 = b1 ? t7 : t6;
    const int r0 = b2 ? s1 : s0, r1 = b2 ? s3 : s2;
    return b3 ? r1 : r0;
}
__device__ __forceinline__ void topk_combine(const unsigned (&La)[16], const unsigned (&Lb)[16], int* eid_out, float* gate_out) {
    float a[16], b[16]; int ia[16], ib[16];
#pragma unroll
    for (int i = 0; i < 16; ++i) { a[i] = key2f(La[i] & ~127u); ia[i] = 127 - (int)(La[i] & 127u); b[i] = key2f(Lb[i] & ~127u); ib[i] = 127 - (int)(Lb[i] & 127u);
        asm volatile("" : "+v"(ia[i]), "+v"(ib[i])); }
    unsigned Lc[16];
#pragma unroll
    for (int i = 0; i < 16; ++i) Lc[i] = 0u;
#define TK_CAND(i, j) do { const float s_ = a[i] + b[j]; const unsigned k_ = (f2key(s_) & ~255u) | (unsigned)(255 - ((i) * 16 + (j))); INS16(Lc, k_); } while (0)
    TK_CAND(0, 0); TK_CAND(0, 1); TK_CAND(0, 2); TK_CAND(0, 3); TK_CAND(0, 4); TK_CAND(0, 5); TK_CAND(0, 6); TK_CAND(0, 7);
    TK_CAND(0, 8); TK_CAND(0, 9); TK_CAND(0, 10); TK_CAND(0, 11); TK_CAND(0, 12); TK_CAND(0, 13); TK_CAND(0, 14); TK_CAND(0, 15);
    TK_CAND(1, 0); TK_CAND(1, 1); TK_CAND(1, 2); TK_CAND(1, 3); TK_CAND(1, 4); TK_CAND(1, 5); TK_CAND(1, 6); TK_CAND(1, 7);
    TK_CAND(2, 0); TK_CAND(2, 1); TK_CAND(2, 2); TK_CAND(2, 3); TK_CAND(2, 4);
    TK_CAND(3, 0); TK_CAND(3, 1); TK_CAND(3, 2); TK_CAND(3, 3);
    TK_CAND(4, 0); TK_CAND(4, 1); TK_CAND(4, 2);
    TK_CAND(5, 0); TK_CAND(5, 1); TK_CAND(6, 0); TK_CAND(6, 1); TK_CAND(7, 0); TK_CAND(7, 1);
    TK_CAND(8, 0); TK_CAND(9, 0); TK_CAND(10, 0); TK_CAND(11, 0); TK_CAND(12, 0); TK_CAND(13, 0); TK_CAND(14, 0); TK_CAND(15, 0);
#undef TK_CAND
    float sv[16]; float m = -3.0e38f;
#pragma unroll
    for (int r = 0; r < 16; ++r) { sv[r] = key2f(Lc[r] & ~255u); m = fmaxf(m, sv[r]); }
    float sum = 0.f;
#pragma unroll
    for (int r = 0; r < 16; ++r) { sv[r] = __expf(sv[r] - m); sum += sv[r]; }
    const float inv = 1.f / sum;
#pragma unroll
    for (int r = 0; r < 16; ++r) { const int c = 255 - (int)(Lc[r] & 255u); const int i1 = sel16(ia, c >> 4), i2 = sel16(ib, c & 15);
        eid_out[r] = i1 * NKEYS + i2; gate_out[r] = sv[r] * inv; }
}
namespace nv {
__device__ __forceinline__ int win_srccol(int n) { if (n < 1536) return n; const int j = n - 1536, u = j >> 8, r = j & 255; return r < 128 ? 1536 + 128 * u + r : 2048 + 128 * u + (r - 128); }
__global__ void transpose_w(const float* W, int K, int NW, int N, bf16* WT, int mode) {
    const size_t i = (size_t)blockIdx.x * blockDim.x + threadIdx.x; if (i >= (size_t)N * K) return;
    const int n = (int)(i / K), k = (int)(i % K); const int c = mode == 1 ? win_srccol(n) : n;
    WT[i] = (bf16)f2bf(W[(size_t)k * NW + c]);
}
__global__ void fold_wq(const float* wq, const float* keys, bf16* WQK) {
    const size_t i = (size_t)blockIdx.x * blockDim.x + threadIdx.x; if (i >= (size_t)2048 * 1024) return;
    const int n = (int)(i / 1024), d = (int)(i % 1024); const int hp = n >> 7, kk = n & 127, p = hp & 1;
    const float* w = wq + (size_t)d * 2048 + hp * 128; const float* kr = keys + ((size_t)p * 128 + kk) * 128; float s = 0.f;
    for (int c = 0; c < 128; ++c) s += w[c] * kr[c];
    WQK[i] = (bf16)f2bf(s);
}
__global__ void cvt_bf16(const float* src, bf16* dst, size_t n) { const size_t i = (size_t)blockIdx.x * blockDim.x + threadIdx.x; if (i < n) dst[i] = (bf16)f2bf(src[i]); }
struct Freq { float f[8]; };
__global__ void rope_table(const int* pos, float* cs, float* sn, Freq fr) {
    const int i = blockIdx.x * blockDim.x + threadIdx.x; if (i >= NTOK * 8) return;
    const float ang = (float)pos[i >> 3] * fr.f[i & 7]; cs[i] = cosf(ang); sn[i] = sinf(ang);
}
template <bool OUTF32> __device__ __forceinline__ void rms_row(int row, int lane, const float* in, const float* g, void* out) {
    const f32x4* xr = (const f32x4*)(in + (size_t)row * DM) + lane; f32x4 v[4]; float s = 0.f;
#pragma unroll
    for (int j = 0; j < 4; ++j) { v[j] = xr[64 * j]; s += v[j].x * v[j].x + v[j].y * v[j].y + v[j].z * v[j].z + v[j].w * v[j].w; }
    const float r = rsqrtf(wave_sum(s) * (1.f / DM) + EPS);
#pragma unroll
    for (int j = 0; j < 4; ++j) { const f32x4 gg = ((const f32x4*)g)[lane + 64 * j]; const f32x4 o = v[j] * r * gg;
        if (OUTF32) ((f32x4*)((float*)out + (size_t)row * DM))[lane + 64 * j] = o;
        else { v2u w; w.x = pk2(o.x, o.y); w.y = pk2(o.z, o.w); ((v2u*)((bf16*)out + (size_t)row * DM))[lane + 64 * j] = w; } }
}
template <bool OUTF32> __global__ void rms_rows(const float* in, const float* g, void* out) {
    const int row = blockIdx.x * 4 + (threadIdx.x >> 6); if (row >= NTOK) return; rms_row<OUTF32>(row, threadIdx.x & 63, in, g, out);
}
struct GP { const bf16* A; const bf16* Bt; const float* cs; const float* sn; bf16 *Q, *Kb, *Vb, *GLU; const float* x; float* H; bf16* O; const bf16* PPO; int M, N, K, pad; };
__device__ __forceinline__ void dot4(const bf16* A, const bf16* Bt, int K, int m0, int n, float (&acc)[4]) {
    const v4u* b = (const v4u*)(Bt + (size_t)n * K);
#pragma unroll
    for (int r = 0; r < 4; ++r) acc[r] = 0.f;
    for (int kc = 0; kc < K / 8; ++kc) { const v4u bw = b[kc];
#pragma unroll
        for (int r = 0; r < 4; ++r) { const v4u aw = ((const v4u*)(A + (size_t)(m0 + r) * K))[kc];
            acc[r] += bflo(aw.x) * bflo(bw.x) + bfhi(aw.x) * bfhi(bw.x) + bflo(aw.y) * bflo(bw.y) + bfhi(aw.y) * bfhi(bw.y) + bflo(aw.z) * bflo(bw.z) + bfhi(aw.z) * bfhi(bw.z) + bflo(aw.w) * bflo(bw.w) + bfhi(aw.w) * bfhi(bw.w); } }
}
template <int EPI> __global__ void gemm(GP p) {
    const int n = blockIdx.x * 256 + threadIdx.x, m0 = blockIdx.y * 4; if (n >= p.N) return;
    float acc[4];
    if (EPI == 1) {
        if (n < 1024) {
            dot4(p.A, p.Bt, p.K, m0, n, acc); const int hc = n & 63;
            if (hc < 16) { float pa[4]; dot4(p.A, p.Bt, p.K, m0, n ^ 8, pa);
#pragma unroll
                for (int r = 0; r < 4; ++r) { const float c = p.cs[(size_t)(m0 + r) * 8 + (hc & 7)], s = p.sn[(size_t)(m0 + r) * 8 + (hc & 7)];
                    acc[r] = (hc & 8) ? acc[r] * c + pa[r] * s : acc[r] * c - pa[r] * s; } }
#pragma unroll
            for (int r = 0; r < 4; ++r) { if (n < 512) p.Q[(size_t)(m0 + r) * 512 + n] = (bf16)f2bf(acc[r] * QSCALE); else p.Kb[(size_t)(m0 + r) * 512 + n - 512] = (bf16)f2bf(acc[r]); }
        } else if (n < 1536) { dot4(p.A, p.Bt, p.K, m0, n, acc);
#pragma unroll
            for (int r = 0; r < 4; ++r) p.Vb[(size_t)(m0 + r) * 512 + n - 1024] = (bf16)f2bf(acc[r]);
        } else { const int j = n - 1536, u = j >> 8, rr = j & 255; if (rr >= 128) return; float g[4]; dot4(p.A, p.Bt, p.K, m0, n, acc); dot4(p.A, p.Bt, p.K, m0, n + 128, g);
#pragma unroll
            for (int r = 0; r < 4; ++r) p.GLU[(size_t)(m0 + r) * 512 + 128 * u + rr] = (bf16)f2bf(acc[r] * sigmoidf_(g[r])); }
    } else {
        dot4(p.A, p.Bt, p.K, m0, n, acc);
#pragma unroll
        for (int r = 0; r < 4; ++r) { const size_t o = (size_t)(m0 + r) * p.N + n;
            if (EPI == 2) p.H[o] = p.x[o] + acc[r];
            if (EPI == 3) p.O[o] = (bf16)f2bf(acc[r]);
            if (EPI == 4) p.H[o] = p.H[o] + sigmoidf_(acc[r]) * bf2f(p.PPO[o]); }
    }
}
__device__ __forceinline__ void attn_item(int gw, int lane, const bf16* Q, const bf16* Kb, const bf16* Vb, bf16* ATT) {
    const int tok = gw >> 3, h = gw & 7, b = tok / SEQ, s = tok % SEQ;
    const float q = bf2f(Q[(size_t)tok * 512 + h * 64 + lane]);
    float o[3], lse[3]; const int dil[3] = {1, 4, 16};
#pragma unroll
    for (int p = 0; p < 3; ++p) { float m = -3.0e38f, l = 0.f, acc = 0.f;
        for (int j = 0; j <= 128; ++j) { const int tk = s - j * dil[p]; if (tk < 0) break; const size_t kr = ((size_t)b * SEQ + tk) * 512 + h * 64 + lane;
            const float sc = wave_sum(q * bf2f(Kb[kr])); const float mn = fmaxf(m, sc), al = exp2f(m - mn), pe = exp2f(sc - mn);
            l = l * al + pe; acc = acc * al + pe * bf2f(Vb[kr]); m = mn; }
        o[p] = acc / l; lse[p] = m + log2f(l); }
    const float M = fmaxf(lse[0], fmaxf(lse[1], lse[2])); const float w0 = exp2f(lse[0] - M), w1 = exp2f(lse[1] - M), w2 = exp2f(lse[2] - M);
    ATT[(size_t)tok * 512 + h * 64 + lane] = (bf16)f2bf((w0 * o[0] + w1 * o[1] + w2 * o[2]) / (w0 + w1 + w2));
}
__global__ void attn(const bf16* Q, const bf16* Kb, const bf16* Vb, bf16* ATT) {
    const int gw = blockIdx.x * 4 + (threadIdx.x >> 6); if (gw >= NTOK * NH) return; attn_item(gw, threadIdx.x & 63, Q, Kb, Vb, ATT);
}
__device__ __forceinline__ void mix_token(int tok, int lane, const bf16* GLU, const bf16* ATT, const float* cw, const float* cb, const float* lg, const float* lb, const float* ga, const float* gc, bf16* Y) {
    const int s = tok % SEQ, c0 = lane * 8; float acc[8];
    { const f32x4 b0 = *(const f32x4*)(cb + c0), b1 = *(const f32x4*)(cb + c0 + 4); acc[0] = b0.x; acc[1] = b0.y; acc[2] = b0.z; acc[3] = b0.w; acc[4] = b1.x; acc[5] = b1.y; acc[6] = b1.z; acc[7] = b1.w; }
    for (int j = 0; j < CW; ++j) { const int ts = s - (CW - 1) + j; if (ts < 0) continue;
        const v4u g = *(const v4u*)(GLU + (size_t)(tok - (CW - 1) + j) * 512 + c0); const f32x4 w0 = *(const f32x4*)(cw + j * 512 + c0), w1 = *(const f32x4*)(cw + j * 512 + c0 + 4);
        acc[0] += w0.x * bflo(g.x); acc[1] += w0.y * bfhi(g.x); acc[2] += w0.z * bflo(g.y); acc[3] += w0.w * bfhi(g.y); acc[4] += w1.x * bflo(g.z); acc[5] += w1.y * bfhi(g.z); acc[6] += w1.z * bflo(g.w); acc[7] += w1.w * bfhi(g.w); }
    float sm = 0.f;
#pragma unroll
    for (int i = 0; i < 8; ++i) sm += acc[i];
    const float mean = wave_sum(sm) * (1.f / 512.f); float sq = 0.f;
#pragma unroll
    for (int i = 0; i < 8; ++i) { acc[i] -= mean; sq += acc[i] * acc[i]; }
    const float rstd = rsqrtf(wave_sum(sq) * (1.f / 512.f) + EPS); float ss = 0.f;
#pragma unroll
    for (int i = 0; i < 8; ++i) { const float y = acc[i] * rstd * lg[c0 + i] + lb[c0 + i]; acc[i] = y * sigmoidf_(y); ss += acc[i] * acc[i]; }
    const float rc = rsqrtf(wave_sum(ss) * (1.f / 512.f) + EPS);
    v4u o; o.x = pk2(acc[0] * rc * gc[c0 + 0], acc[1] * rc * gc[c0 + 1]); o.y = pk2(acc[2] * rc * gc[c0 + 2], acc[3] * rc * gc[c0 + 3]); o.z = pk2(acc[4] * rc * gc[c0 + 4], acc[5] * rc * gc[c0 + 5]); o.w = pk2(acc[6] * rc * gc[c0 + 6], acc[7] * rc * gc[c0 + 7]);
    *(v4u*)(Y + (size_t)tok * 1024 + 512 + c0) = o;
    const v4u a = *(const v4u*)(ATT + (size_t)tok * 512 + c0); float av[8] = {bflo(a.x), bfhi(a.x), bflo(a.y), bfhi(a.y), bflo(a.z), bfhi(a.z), bflo(a.w), bfhi(a.w)}; float sa = 0.f;
#pragma unroll
    for (int i = 0; i < 8; ++i) sa += av[i] * av[i];
    const float ra = rsqrtf(wave_sum(sa) * (1.f / 512.f) + EPS);
    v4u oa; oa.x = pk2(av[0] * ra * ga[c0 + 0], av[1] * ra * ga[c0 + 1]); oa.y = pk2(av[2] * ra * ga[c0 + 2], av[3] * ra * ga[c0 + 3]); oa.z = pk2(av[4] * ra * ga[c0 + 4], av[5] * ra * ga[c0 + 5]); oa.w = pk2(av[6] * ra * ga[c0 + 6], av[7] * ra * ga[c0 + 7]);
    *(v4u*)(Y + (size_t)tok * 1024 + c0) = oa;
}
__global__ void mix_norm(const bf16* GLU, const bf16* ATT, const float* cw, const float* cb, const float* lg, const float* lb, const float* ga, const float* gc, bf16* Y) {
    const int tok = blockIdx.x * 4 + (threadIdx.x >> 6); if (tok >= NTOK) return; mix_token(tok, threadIdx.x & 63, GLU, ATT, cw, cb, lg, lb, ga, gc, Y);
}
__device__ __forceinline__ void topk_item(int i, const bf16* SC, int* EID, float* GATE) {
    const bf16* row = SC + (size_t)i * 256; unsigned La[16], Lb[16];
#pragma unroll
    for (int q = 0; q < 16; ++q) { La[q] = 0u; Lb[q] = 0u; }
    for (int c = 0; c < 128; ++c) { const unsigned k = (f2key(bf2f(row[c])) & ~127u) | (unsigned)(127 - c); INS16(La, k); }
    for (int c = 0; c < 128; ++c) { const unsigned k = (f2key(bf2f(row[128 + c])) & ~127u) | (unsigned)(127 - c); INS16(Lb, k); }
    int e[16]; float g[16]; topk_combine(La, Lb, e, g);
#pragma unroll
    for (int r = 0; r < 16; ++r) { EID[(size_t)i * 16 + r] = e[r]; GATE[(size_t)i * 16 + r] = g[r]; }
}
__global__ void topk(const bf16* SC, int* EID, float* GATE) {
    const int i = blockIdx.x * blockDim.x + threadIdx.x; if (i >= NTOK * PH) return; topk_item(i, SC, EID, GATE);
}
__device__ __forceinline__ void peer_token(int tok, int lane, const bf16* XN, const bf16* U, const bf16* V, const int* EID, const float* GATE, float* H) {
    float x[16], y[16];
    { const v4u a = ((const v4u*)(XN + (size_t)tok * 1024))[lane * 2], b = ((const v4u*)(XN + (size_t)tok * 1024))[lane * 2 + 1];
      x[0] = bflo(a.x); x[1] = bfhi(a.x); x[2] = bflo(a.y); x[3] = bfhi(a.y); x[4] = bflo(a.z); x[5] = bfhi(a.z); x[6] = bflo(a.w); x[7] = bfhi(a.w);
      x[8] = bflo(b.x); x[9] = bfhi(b.x); x[10] = bflo(b.y); x[11] = bfhi(b.y); x[12] = bflo(b.z); x[13] = bfhi(b.z); x[14] = bflo(b.w); x[15] = bfhi(b.w); }
#pragma unroll
    for (int i = 0; i < 16; ++i) y[i] = 0.f;
    for (int k = 0; k < HK; ++k) { const int e = EID[(size_t)tok * HK + k]; const float g = GATE[(size_t)tok * HK + k];
        const v4u a = ((const v4u*)(U + (size_t)e * 1024))[lane * 2], b = ((const v4u*)(U + (size_t)e * 1024))[lane * 2 + 1];
        float d = x[0] * bflo(a.x) + x[1] * bfhi(a.x) + x[2] * bflo(a.y) + x[3] * bfhi(a.y) + x[4] * bflo(a.z) + x[5] * bfhi(a.z) + x[6] * bflo(a.w) + x[7] * bfhi(a.w)
                + x[8] * bflo(b.x) + x[9] * bfhi(b.x) + x[10] * bflo(b.y) + x[11] * bfhi(b.y) + x[12] * bflo(b.z) + x[13] * bfhi(b.z) + x[14] * bflo(b.w) + x[15] * bfhi(b.w);
        d = wave_sum(d); const float act = gelu_erf(d) * g;
        const v4u c = ((const v4u*)(V + (size_t)e * 1024))[lane * 2], dd = ((const v4u*)(V + (size_t)e * 1024))[lane * 2 + 1];
        y[0] += act * bflo(c.x); y[1] += act * bfhi(c.x); y[2] += act * bflo(c.y); y[3] += act * bfhi(c.y); y[4] += act * bflo(c.z); y[5] += act * bfhi(c.z); y[6] += act * bflo(c.w); y[7] += act * bfhi(c.w);
        y[8] += act * bflo(dd.x); y[9] += act * bfhi(dd.x); y[10] += act * bflo(dd.y); y[11] += act * bfhi(dd.y); y[12] += act * bflo(dd.z); y[13] += act * bfhi(dd.z); y[14] += act * bflo(dd.w); y[15] += act * bfhi(dd.w); }
    float* hr = H + (size_t)tok * 1024 + lane * 16;
#pragma unroll
    for (int i = 0; i < 4; ++i) { f32x4 v = ((f32x4*)hr)[i]; v.x += y[4 * i]; v.y += y[4 * i + 1]; v.z += y[4 * i + 2]; v.w += y[4 * i + 3]; ((f32x4*)hr)[i] = v; }
}
__global__ void peer(const bf16* XN, const bf16* U, const bf16* V, const int* EID, const float* GATE, float* H) {
    const int tok = blockIdx.x * 4 + (threadIdx.x >> 6); if (tok >= NTOK) return; peer_token(tok, threadIdx.x & 63, XN, U, V, EID, GATE, H);
}
}
namespace pg8 {
#define PG8_LAS __attribute__((address_space(3)))
typedef unsigned short bf16_t;
typedef short bf16x8 __attribute__((ext_vector_type(8)));
typedef float f32x4 __attribute__((ext_vector_type(4)));
typedef unsigned u32x4 __attribute__((ext_vector_type(4)));
constexpr int BM = 256, BK = 64, HALF = 128, HTB = HALF * BK * 2  , STAGE_BYTES = 8 * HTB, NXCD = 8, WGM = 8;

__host__ __device__ __forceinline__ int lds_byte(int r, int c) { const int st = (r >> 4) * 2 + (c >> 5), rr = r & 15, cc = c & 31, ob = rr * 64 + cc * 2; return st * 1024 + (ob ^ (((ob >> 9) & 1) << 5)); }
__host__ __device__ __forceinline__ void stage_rc(int b, int& R, int& C) { const int st = b / 1024, sb = b % 1024, swz = sb ^ (((sb >> 9) & 1) << 5); R = (st >> 1) * 16 + swz / 64; C = (st & 1) * 32 + (swz % 64) / 2; }
__host__ __device__ __forceinline__ int perm32(int rho) { const int n = rho >> 4, i = rho & 15; return 8 * (i >> 2) + 4 * n + (i & 3); }

struct Unit { int pm, pn; };
struct Gemm { const bf16_t* A; const bf16_t* Bt; int M, N, K; };

struct StaticOrder {
    int nM, nN, nwg, G, c;
    __host__ __device__ void init(int M, int N, int G_, int c_) { nM = M / BM; nN = N / BM; nwg = nM * nN; G = G_; c = c_; }
    __host__ __device__ bool next(int i, Unit& u) const {
        const long L = (long)i * G + c; if (L >= nwg) return false;
        int wgid = (int)L; { const int q = nwg / NXCD, r = nwg % NXCD, xcd = wgid % NXCD, off = wgid / NXCD; wgid = (xcd < r ? xcd * (q + 1) : r * (q + 1) + (xcd - r) * q) + off; }
        const int nig = WGM * nN, gid = wgid / nig, fm = gid * WGM, gsz = (nM - fm) < WGM ? (nM - fm) : WGM;
        u.pm = fm + ((wgid % nig) % gsz); u.pn = (wgid % nig) / gsz; return true;
    }
    __device__ __forceinline__ void a_ready(const Unit&) const {}
    __device__ __forceinline__ void done(const Unit&) const {}
};

__device__ __forceinline__ unsigned cvt_pk_bf16(float lo, float hi) { unsigned r; asm volatile("v_cvt_pk_bf16_f32 %0, %1, %2" : "=v"(r) : "v"(lo), "v"(hi)); return r; }
typedef float f32x2 __attribute__((ext_vector_type(2)));
__device__ __forceinline__ f32x2 gelu_pk(f32x2 v) {
    const f32x2 av = __builtin_elementwise_abs(v), d = av * 0.2316418882f + 1.0f;
    f32x2 t; t.x = __builtin_amdgcn_rcpf(d.x); t.y = __builtin_amdgcn_rcpf(d.y);
    f32x2 q = t * 0.5307027145f + (-0.7265760135f); q = q * t + 0.7107068705f; q = q * t + (-0.142248368f); q = q * t + 0.127414796f; q = q * t;
    const f32x2 s = (v * v) * (-0.72134752044f);
    f32x2 e; e.x = __builtin_amdgcn_exp2f(s.x); e.y = __builtin_amdgcn_exp2f(s.y);
    const f32x2 m = v * (q * e), r = v - m;
    f32x2 o; o.x = v.x < 0.f ? m.x : r.x; o.y = v.y < 0.f ? m.y : r.y; return o;
}

template <int ACT  > struct EpiBf16 {
    static constexpr bool PERM = true, AFTER_DRAIN = false; static_assert(ACT == 0 || ACT == 1, "EpiBf16: ACT is 0 (none) or 1 (gelu_pk)");
    bf16_t* O; int ldc; const float* bias; int split_cols; size_t split_stride; float scale0;
    __device__ __forceinline__ void operator()(const f32x4 (&acc)[2][2][4][2], const Unit& u, int wr, int wc, int fr, int fq) const {
        const int row0 = u.pm * BM + wr * 64 + fr; int colt = u.pn * BM; bf16_t* base = O;
        float sc = 1.f; if (split_cols) { const int t = colt / split_cols; base += (size_t)t * split_stride; colt -= t * split_cols; if (t == 0) sc = scale0; }
        const int col0 = colt + wc * 32 + 8 * fq, bcol0 = u.pn * BM + wc * 32 + 8 * fq;
        f32x4 bv[2][2];
#pragma unroll
        for (int bj = 0; bj < 2; ++bj)
#pragma unroll
            for (int n = 0; n < 2; ++n) bv[bj][n] = bias ? *(const f32x4*)(bias + bcol0 + bj * HALF + 4 * n) : (f32x4){0.f, 0.f, 0.f, 0.f};
#pragma unroll
        for (int ai = 0; ai < 2; ++ai)
#pragma unroll
            for (int m = 0; m < 4; ++m) { bf16_t* rowp = base + (size_t)(row0 + ai * HALF + m * 16) * ldc + col0;
#pragma unroll
                for (int bj = 0; bj < 2; ++bj) { f32x4 v0 = acc[ai][bj][m][0] + bv[bj][0], v1 = acc[ai][bj][m][1] + bv[bj][1];
                    if (ACT == 1) { f32x2 a = gelu_pk((f32x2){v0[0], v0[1]}), b = gelu_pk((f32x2){v0[2], v0[3]}), c = gelu_pk((f32x2){v1[0], v1[1]}), d = gelu_pk((f32x2){v1[2], v1[3]});
                        v0 = (f32x4){a.x, a.y, b.x, b.y}; v1 = (f32x4){c.x, c.y, d.x, d.y}; }
                    v0 = v0 * sc; v1 = v1 * sc; u32x4 w; w.x = cvt_pk_bf16(v0[0], v0[1]); w.y = cvt_pk_bf16(v0[2], v0[3]); w.z = cvt_pk_bf16(v1[0], v1[1]); w.w = cvt_pk_bf16(v1[2], v1[3]);
                    *(u32x4*)(rowp + bj * HALF) = w; } }
    }
};
struct EpiInProj {
    static constexpr bool PERM = true, AFTER_DRAIN = false;
    bf16_t* QKVG; const float* cs; const float* sn;
    __device__ __forceinline__ void operator()(const f32x4 (&acc)[2][2][4][2], const Unit& u, int wr, int wc, int fr, int fq) const {
        const int row0 = u.pm * BM + wr * 64 + fr;
        if (u.pn < 6) {
            bf16_t* dst = QKVG + (size_t)(u.pn >> 1) * ((size_t)16384 * 512);
            const int col0 = (u.pn & 1) * 256 + wc * 32 + 8 * fq;
            const bool rope_wave = (u.pn < 4) && ((wc & 1) == 0);
            const float sc = u.pn < 2 ? 0.125f * 1.4426950408889634f : 1.f;
#pragma unroll
            for (int ai = 0; ai < 2; ++ai)
#pragma unroll
                for (int m = 0; m < 4; ++m) { const int row = row0 + ai * HALF + m * 16;
                    f32x4 c0 = {1.f, 1.f, 1.f, 1.f}, c1 = c0, s0 = {0.f, 0.f, 0.f, 0.f}, s1 = s0;
                    if (rope_wave) { c0 = *(const f32x4*)(cs + (size_t)row * 8); c1 = *(const f32x4*)(cs + (size_t)row * 8 + 4); s0 = *(const f32x4*)(sn + (size_t)row * 8); s1 = *(const f32x4*)(sn + (size_t)row * 8 + 4); }
#pragma unroll
                    for (int bj = 0; bj < 2; ++bj) { f32x4 v0 = acc[ai][bj][m][0], v1 = acc[ai][bj][m][1];
                        if (rope_wave) { f32x4 p0, p1;
                            p0.x = __shfl_xor(v0.x, 16); p0.y = __shfl_xor(v0.y, 16); p0.z = __shfl_xor(v0.z, 16); p0.w = __shfl_xor(v0.w, 16);
                            p1.x = __shfl_xor(v1.x, 16); p1.y = __shfl_xor(v1.y, 16); p1.z = __shfl_xor(v1.z, 16); p1.w = __shfl_xor(v1.w, 16);
                            if (fq == 0) { v0 = v0 * c0 - p0 * s0; v1 = v1 * c1 - p1 * s1; }
                            else if (fq == 1) { v0 = v0 * c0 + p0 * s0; v1 = v1 * c1 + p1 * s1; } }
                        v0 = v0 * sc; v1 = v1 * sc; u32x4 w; w.x = cvt_pk_bf16(v0[0], v0[1]); w.y = cvt_pk_bf16(v0[2], v0[3]); w.z = cvt_pk_bf16(v1[0], v1[1]); w.w = cvt_pk_bf16(v1[2], v1[3]);
                        *(u32x4*)(dst + (size_t)row * 512 + col0 + bj * HALF) = w; } }
        } else {
            const int ch0 = (u.pn - 6) * 128 + wc * 32 + 8 * fq;
#pragma unroll
            for (int ai = 0; ai < 2; ++ai)
#pragma unroll
                for (int m = 0; m < 4; ++m) { const int row = row0 + ai * HALF + m * 16;
                    const f32x4 a0 = acc[ai][0][m][0], g0 = acc[ai][1][m][0], a1 = acc[ai][0][m][1], g1 = acc[ai][1][m][1];
#define GLU1(av, gv) ((av) * __builtin_amdgcn_rcpf(1.f + __expf(-(gv))))
                    u32x4 w; w.x = cvt_pk_bf16(GLU1(a0.x, g0.x), GLU1(a0.y, g0.y)); w.y = cvt_pk_bf16(GLU1(a0.z, g0.z), GLU1(a0.w, g0.w)); w.z = cvt_pk_bf16(GLU1(a1.x, g1.x), GLU1(a1.y, g1.y)); w.w = cvt_pk_bf16(GLU1(a1.z, g1.z), GLU1(a1.w, g1.w));
#undef GLU1
                    *(u32x4*)(QKVG + (size_t)3 * 16384 * 512 + (size_t)row * 512 + ch0) = w; }
        }
    }
};
struct EpiResid {
    static constexpr bool PERM = false, AFTER_DRAIN = false;
    const float* base; float* H;
    __device__ __forceinline__ void operator()(const f32x4 (&acc)[2][2][4][2], const Unit& u, int wr, int wc, int fr, int fq) const {
        const int row0 = u.pm * BM + wr * 64 + fr, col0 = u.pn * BM + wc * 32 + 4 * fq;
#pragma unroll
        for (int ai = 0; ai < 2; ++ai)
#pragma unroll
            for (int m = 0; m < 4; ++m) { const size_t ro = (size_t)(row0 + ai * HALF + m * 16) * 1024 + col0;
#pragma unroll
                for (int bj = 0; bj < 2; ++bj)
#pragma unroll
                    for (int n = 0; n < 2; ++n) { const size_t o = ro + bj * HALF + n * 16; *(f32x4*)(H + o) = *(const f32x4*)(base + o) + acc[ai][bj][m][n]; } }
    }
};
struct EpiPle {
    static constexpr bool PERM = false, AFTER_DRAIN = false;
    float* H; const bf16_t* PPO;
    __device__ __forceinline__ void operator()(const f32x4 (&acc)[2][2][4][2], const Unit& u, int wr, int wc, int fr, int fq) const {
        typedef unsigned u32x2 __attribute__((ext_vector_type(2)));
        const int row0 = u.pm * BM + wr * 64 + fr, col0 = u.pn * BM + wc * 32 + 4 * fq;
#pragma unroll
        for (int ai = 0; ai < 2; ++ai)
#pragma unroll
            for (int m = 0; m < 4; ++m) { const size_t ro = (size_t)(row0 + ai * HALF + m * 16) * 1024 + col0;
#pragma unroll
                for (int bj = 0; bj < 2; ++bj)
#pragma unroll
                    for (int n = 0; n < 2; ++n) { const size_t o = ro + bj * HALF + n * 16; const u32x2 pw = *(const u32x2*)(PPO + o); const f32x4 a = acc[ai][bj][m][n]; f32x4 h = *(const f32x4*)(H + o);
                        h[0] += __builtin_amdgcn_rcpf(1.f + __expf(-a[0])) * __uint_as_float(pw.x << 16); h[1] += __builtin_amdgcn_rcpf(1.f + __expf(-a[1])) * __uint_as_float(pw.x & 0xffff0000u);
                        h[2] += __builtin_amdgcn_rcpf(1.f + __expf(-a[2])) * __uint_as_float(pw.y << 16); h[3] += __builtin_amdgcn_rcpf(1.f + __expf(-a[3])) * __uint_as_float(pw.y & 0xffff0000u);
                        *(f32x4*)(H + o) = h; } }
    }
};
template <class Epi, class Sched, bool ALIGN_EPI = false, bool SP2 = false>
__device__ __forceinline__ void gemm_phase(PG8_LAS unsigned char* lds, const Gemm g, const Sched& S, const Epi& E) {
    int tid_ = threadIdx.x; asm volatile("" : "+v"(tid_));
    const int tid = tid_, wid = __builtin_amdgcn_readfirstlane(tid >> 6), lane = tid & 63, wr = wid >> 2, wc = wid & 3, fr = lane & 15, fq = lane >> 4;
    const int K = g.K, nt = K / BK;
    unsigned voffA[2], voffB[2];
#pragma unroll
    for (int i = 0; i < 2; ++i) { int R, C; stage_rc(tid * 16 + i * 8192, R, C); const int Rb = Epi::PERM ? ((R & ~31) + perm32(R & 31)) : R;
        voffA[i] = (unsigned)(R * K + C) * 2u; voffB[i] = (unsigned)(Rb * K + C) * 2u; }
    const size_t kstep = (size_t)(BK * 2);
    const size_t hstep = (size_t)HALF * K * 2;
    const size_t tstep = 2 * hstep;
    const unsigned ldsw = (unsigned)wid * 1024u;
    const int aoff = lds_byte(wr * 64 + fr, fq * 8), boff = lds_byte(wc * 32 + fr, fq * 8);
#define PG8_SA(b, h) (((b) * 2 + (h)) * HTB)
#define PG8_SB(b, h) ((4 + (b) * 2 + (h)) * HTB)
#define PG8_STAGE(bufoff, gbase, voff) do { _Pragma("unroll") for (int _i = 0; _i < 2; ++_i) \
        __builtin_amdgcn_global_load_lds((const unsigned*)((const char*)(gbase) + (voff)[_i]), (PG8_LAS unsigned*)(lds + (bufoff) + ldsw + _i * 8192), 16, 0, 0); } while (0)
#define PG8_LDA(dst, b, h) do { _Pragma("unroll") for (int m = 0; m < 4; ++m) _Pragma("unroll") for (int k = 0; k < 2; ++k) dst[m][k] = *(const PG8_LAS bf16x8*)(lds + PG8_SA(b, h) + aoff + m * 2048 + k * 1024); } while (0)
#define PG8_LDB(dst, b, h) do { _Pragma("unroll") for (int n = 0; n < 2; ++n) _Pragma("unroll") for (int k = 0; k < 2; ++k) dst[n][k] = *(const PG8_LAS bf16x8*)(lds + PG8_SB(b, h) + boff + n * 2048 + k * 1024); } while (0)
#define PG8_MMA(ai, bj, At, Bt) do { __builtin_amdgcn_s_setprio(1); _Pragma("unroll") for (int m = 0; m < 4; ++m) _Pragma("unroll") for (int n = 0; n < 2; ++n) _Pragma("unroll") for (int k = 0; k < 2; ++k) \
        acc[ai][bj][m][n] = __builtin_amdgcn_mfma_f32_16x16x32_bf16(Bt[n][k], At[m][k], acc[ai][bj][m][n], 0, 0, 0); __builtin_amdgcn_s_setprio(0); } while (0)
#define PG8_WAIT_V(n) asm volatile("s_waitcnt vmcnt(" #n ")" ::: "memory")
#define PG8_WAIT_L(n) asm volatile("s_waitcnt lgkmcnt(" #n ")" ::: "memory")
#define PG8_BAR __builtin_amdgcn_s_barrier()
#define PG8_SCHED __builtin_amdgcn_sched_barrier(0)
    Unit cur, nxt; int ui = 0;
    if (!S.next(0, cur)) return;
    f32x4 acc[2][2][4][2];
#pragma unroll
    for (int a = 0; a < 2; ++a)
#pragma unroll
        for (int b = 0; b < 2; ++b)
#pragma unroll
            for (int m = 0; m < 4; ++m)
#pragma unroll
                for (int n = 0; n < 2; ++n) acc[a][b][m][n] = (f32x4){0.f, 0.f, 0.f, 0.f};
    bf16x8 At[4][2], B0[2][2], B1[2][2];
    const char* cA = (const char*)g.A + (size_t)cur.pm * tstep; const char* cB = (const char*)g.Bt + (size_t)cur.pn * tstep;
    S.a_ready(cur);
    if constexpr (SP2) {
        PG8_STAGE(PG8_SB(0, 0), cB, voffB); PG8_STAGE(PG8_SB(0, 1), cB + hstep, voffB); PG8_STAGE(PG8_SA(0, 0), cA, voffA); PG8_STAGE(PG8_SA(0, 1), cA + hstep, voffA);
        if (wr == 1) PG8_BAR;
        PG8_WAIT_V(2); PG8_BAR;
        PG8_STAGE(PG8_SB(1, 0), cB + kstep, voffB); PG8_STAGE(PG8_SA(1, 0), cA + kstep, voffA); PG8_STAGE(PG8_SB(1, 1), cB + hstep + kstep, voffB);
        PG8_WAIT_V(6); PG8_BAR;
    } else {
        PG8_STAGE(PG8_SB(0, 0), cB, voffB); PG8_STAGE(PG8_SA(0, 0), cA, voffA); PG8_STAGE(PG8_SB(0, 1), cB + hstep, voffB); PG8_STAGE(PG8_SA(0, 1), cA + hstep, voffA);
        if (wr == 1) PG8_BAR;
        PG8_WAIT_V(4); PG8_BAR;
        PG8_STAGE(PG8_SB(1, 0), cB + kstep, voffB); PG8_STAGE(PG8_SA(1, 0), cA + kstep, voffA); PG8_STAGE(PG8_SB(1, 1), cB + hstep + kstep, voffB);
        PG8_WAIT_V(6); PG8_BAR;
    }
    for (;;) {
        const bool has_next = S.next(ui + 1, nxt);
        const char* nA = has_next ? (const char*)g.A + (size_t)nxt.pm * tstep : cA; const char* nB = has_next ? (const char*)g.Bt + (size_t)nxt.pn * tstep : cB;
        for (int t = 0; t < nt; t += 2) {
            const bool last = (t == nt - 2);
            const char* a1 = cA + (size_t)(t + 1) * kstep;
            const char* a2 = last ? nA : cA + (size_t)(t + 2) * kstep; const char* b2 = last ? nB : cB + (size_t)(t + 2) * kstep;
            const char* a3 = a2 + kstep; const char* b3 = b2 + kstep;
            if (last && has_next) S.a_ready(nxt);
            if constexpr (SP2) {
            PG8_LDB(B0, 0, 0); PG8_LDB(B1, 0, 1); PG8_SCHED; PG8_LDA(At, 0, 0); PG8_STAGE(PG8_SA(1, 1), a1 + hstep, voffA);
            PG8_WAIT_V(8); PG8_WAIT_L(0); PG8_BAR; PG8_MMA(0, 0, At, B0); PG8_MMA(0, 1, At, B1); PG8_BAR; PG8_SCHED;
            PG8_LDA(At, 0, 1); PG8_STAGE(PG8_SB(0, 0), b2, voffB); PG8_STAGE(PG8_SB(0, 1), b2 + hstep, voffB); PG8_STAGE(PG8_SA(0, 0), a2, voffA);
            PG8_WAIT_V(8); PG8_WAIT_L(0); PG8_BAR; PG8_MMA(1, 0, At, B0); PG8_MMA(1, 1, At, B1); PG8_BAR; PG8_SCHED;
            PG8_LDB(B0, 1, 0); PG8_LDB(B1, 1, 1); PG8_SCHED; PG8_LDA(At, 1, 0); PG8_STAGE(PG8_SA(0, 1), a2 + hstep, voffA);
            PG8_WAIT_V(8); PG8_WAIT_L(0); PG8_BAR; PG8_MMA(0, 0, At, B0); PG8_MMA(0, 1, At, B1); PG8_BAR; PG8_SCHED;
            PG8_LDA(At, 1, 1); PG8_STAGE(PG8_SB(1, 0), b3, voffB); PG8_STAGE(PG8_SB(1, 1), b3 + hstep, voffB); PG8_STAGE(PG8_SA(1, 0), a3, voffA);
            PG8_WAIT_V(8); PG8_WAIT_L(0); PG8_BAR; PG8_MMA(1, 0, At, B0); PG8_MMA(1, 1, At, B1); PG8_BAR; PG8_SCHED;
            } else {
            PG8_LDB(B0, 0, 0); PG8_SCHED; PG8_LDA(At, 0, 0); PG8_STAGE(PG8_SA(1, 1), a1 + hstep, voffA);
            PG8_WAIT_L(8); PG8_BAR; PG8_WAIT_L(0); PG8_MMA(0, 0, At, B0); PG8_BAR; PG8_SCHED;
            PG8_LDB(B1, 0, 1); PG8_STAGE(PG8_SB(0, 0), b2, voffB);
            PG8_BAR; PG8_WAIT_L(0); PG8_MMA(0, 1, At, B1); PG8_BAR;
            PG8_LDA(At, 0, 1); PG8_STAGE(PG8_SA(0, 0), a2, voffA);
            PG8_BAR; PG8_WAIT_L(0); PG8_MMA(1, 0, At, B0); PG8_BAR; PG8_SCHED;
            PG8_STAGE(PG8_SB(0, 1), b2 + hstep, voffB);
            PG8_WAIT_V(6); PG8_BAR; PG8_MMA(1, 1, At, B1); PG8_BAR;
            PG8_LDB(B0, 1, 0); PG8_SCHED; PG8_LDA(At, 1, 0); PG8_STAGE(PG8_SA(0, 1), a2 + hstep, voffA);
            PG8_WAIT_L(8); PG8_BAR; PG8_WAIT_L(0); PG8_MMA(0, 0, At, B0); PG8_BAR; PG8_SCHED;
            PG8_LDB(B1, 1, 1); PG8_STAGE(PG8_SB(1, 0), b3, voffB);
            PG8_BAR; PG8_WAIT_L(0); PG8_MMA(0, 1, At, B1); PG8_BAR;
            PG8_LDA(At, 1, 1); PG8_STAGE(PG8_SA(1, 0), a3, voffA);
            PG8_BAR; PG8_WAIT_L(0); PG8_MMA(1, 0, At, B0); PG8_BAR; PG8_SCHED;
            PG8_STAGE(PG8_SB(1, 1), b3 + hstep, voffB);
            PG8_WAIT_V(6); PG8_BAR; PG8_MMA(1, 1, At, B1); PG8_BAR;
            }
        }
        if constexpr (ALIGN_EPI) { if (wr == 0) PG8_BAR; }
        if constexpr (!Epi::AFTER_DRAIN) { E(acc, cur, wr, wc, fr, fq); S.done(cur); }
        if (!has_next) break;
#pragma unroll
        for (int a = 0; a < 2; ++a)
#pragma unroll
            for (int b = 0; b < 2; ++b)
#pragma unroll
                for (int m = 0; m < 4; ++m)
#pragma unroll
                    for (int n = 0; n < 2; ++n) acc[a][b][m][n] = (f32x4){0.f, 0.f, 0.f, 0.f};
        cur = nxt; cA = nA; cB = nB; ++ui;
        if constexpr (ALIGN_EPI) { if (wr == 1) PG8_BAR; }
    }
    PG8_WAIT_V(0);
    if constexpr (!ALIGN_EPI) { if (wr == 0) PG8_BAR; }
    PG8_BAR;
    if constexpr (Epi::AFTER_DRAIN) { E.fused(acc, cur, wr, wc, fr, fq, lds, wid, lane); S.done(cur); }
#undef PG8_SA
#undef PG8_SB
#undef PG8_STAGE
#undef PG8_LDA
#undef PG8_LDB
#undef PG8_MMA
#undef PG8_WAIT_V
#undef PG8_WAIT_L
#undef PG8_BAR
#undef PG8_SCHED
}
}
#define GAS __attribute__((address_space(1)))
#define LAS __attribute__((address_space(3)))
typedef short bf16x8 __attribute__((ext_vector_type(8)));
typedef GAS unsigned gu32;
typedef GAS unsigned long long gu64;
#define RLX_AGENT __ATOMIC_RELAXED, __HIP_MEMORY_SCOPE_AGENT
#define LDS_WAIT() asm volatile("s_waitcnt lgkmcnt(0)" ::: "memory")
#define VM_WAIT() asm volatile("s_waitcnt vmcnt(0)" ::: "memory")
__device__ __forceinline__ unsigned long long rt() { return __builtin_amdgcn_s_memrealtime(); }

#define XB_TMO      128
#define XB_XCNT(j)  (256  + 64 * (j))
#define XB_XSUB(j)  (1280 + 64 * (j))
#define XB_XGEN(j)  (2304 + 64 * (j))
#define XB_TOP      3328
#define XB_TOPGEN   3392
#define XCD_BAR_WORDS 3456
#define XB_SPIN_CAP (1u << 18)

__device__ __forceinline__ unsigned xb_ld(unsigned* p)              { return __hip_atomic_load(p, __ATOMIC_RELAXED, __HIP_MEMORY_SCOPE_AGENT); }
__device__ __forceinline__ unsigned xb_add(unsigned* p, unsigned v) { return __hip_atomic_fetch_add(p, v, __ATOMIC_RELAXED, __HIP_MEMORY_SCOPE_AGENT); }
__device__ __forceinline__ unsigned xb_xcc_id() { return (unsigned)__builtin_amdgcn_s_getreg((3 << 11) | 20) & 0xFu; }
#define XB_SPIN(cond, bar) do { unsigned _sp = 0; while (cond) { __builtin_amdgcn_s_sleep(1); \
    if ((++_sp & 255u) == 0u) { if (xb_ld(&(bar)[XB_TMO])) break; if (_sp > XB_SPIN_CAP) { atomicAdd(&(bar)[XB_TMO], 1u); break; } } } } while (0)

struct XcdBarrier {
    unsigned* bar; unsigned x;
    volatile LAS unsigned* st;
};

__device__ __forceinline__ XcdBarrier xcd_barrier_post(unsigned* bar, volatile LAS unsigned* st) {
    XcdBarrier b; b.bar = bar; b.x = xb_xcc_id(); b.st = st;
    if (threadIdx.x == 0) (void)xb_add(&bar[XB_XCNT(b.x)], 1u);
    return b;
}
__device__ __forceinline__ void xcd_barrier_complete(unsigned* bar, unsigned x, unsigned& nloc, unsigned& nx) {
    const unsigned G = gridDim.x * gridDim.y * gridDim.z;
    unsigned sum, cnt, mine, sp = 0u;
    for (;;) {
        sum = 0u; cnt = 0u; mine = 0u;
#pragma unroll
        for (unsigned j = 0; j < 16; ++j) { const unsigned c = xb_ld(&bar[XB_XCNT(j)]); sum += c; cnt += (c > 0u) ? 1u : 0u; mine = (j == x) ? c : mine; }
        if (sum == G) break;
        __builtin_amdgcn_s_sleep(1);
        if ((++sp & 255u) == 0u) { if (xb_ld(&bar[XB_TMO])) break; if (sp > XB_SPIN_CAP) { atomicAdd(&bar[XB_TMO], 1u); break; } }
    }
    nloc = mine > 0u ? mine : 1u; nx = cnt > 0u ? cnt : 1u;
}

__device__ __forceinline__ void xcd_barrier(const XcdBarrier& b) {
    asm volatile("s_waitcnt vmcnt(0)" ::: "memory");
    __syncthreads();
    if (threadIdx.x == 0) {
        unsigned* bar = b.bar;
        __builtin_amdgcn_s_waitcnt(0);
        unsigned nloc = b.st[0], nx = b.st[1];
        if (nloc == 0u) { xcd_barrier_complete(bar, b.x, nloc, nx); b.st[0] = nloc; b.st[1] = nx; }
        const unsigned old = xb_add(&bar[XB_XSUB(b.x)], 1u);
        const unsigned gen = old / nloc;
        if (old + 1u == (gen + 1u) * nloc) {
            __builtin_amdgcn_fence(__ATOMIC_RELEASE, "agent");
            asm volatile("s_waitcnt vmcnt(0)" ::: "memory");
            const unsigned og = xb_add(&bar[XB_TOP], 1u);
            const unsigned tg = og / nx;
            if (og + 1u == (tg + 1u) * nx) xb_add(&bar[XB_TOPGEN], 1u);
            else XB_SPIN(xb_ld(&bar[XB_TOPGEN]) == tg, bar);
            __builtin_amdgcn_fence(__ATOMIC_ACQUIRE, "agent");
            xb_add(&bar[XB_XGEN(b.x)], 1u);
            asm volatile("s_waitcnt vmcnt(0)" ::: "memory");
        } else {
            XB_SPIN(xb_ld(&bar[XB_XGEN(b.x)]) == gen, bar);
            __builtin_amdgcn_fence(__ATOMIC_ACQUIRE, "agent");
            asm volatile("s_waitcnt vmcnt(0)" ::: "memory");
        }
    }
    __syncthreads();
}
#ifndef PH_MASK
#define PH_MASK 0xFFFu
#endif
constexpr int NWAVES = 8;
constexpr int RING_OFF = 0, RING_BYTES = 131072;
constexpr int LDSCTL_OFF = RING_BYTES, MISC_OFF = LDSCTL_OFF + 320;
constexpr int LDS_BYTES = 147456;
constexpr int CW_BAR = 4096;

struct Params {
    const float *x, *p; const int* pos; const float *norm_mix, *w_in, *conv_w, *conv_b, *ln_g, *ln_b, *g_att, *g_conv, *w_out, *norm_ffn, *wq, *keys, *eu, *ev, *norm_ple, *wg, *wp, *fin;
    float* out; unsigned char* ws; float freq[8];
};

__device__ __forceinline__ void transpose_item(const float* W, int K, int NW, bf16* WT, int n_dst0, int n_src0, int k0, LAS float* scr, int lane) {
#pragma unroll 8
    for (int i = 0; i < 32; ++i) { const int kk = 2 * i + (lane >> 5); scr[kk * 33 + (lane & 31)] = W[(size_t)(k0 + kk) * NW + n_src0 + (lane & 31)]; }
    LDS_WAIT(); asm volatile("" ::: "memory");
    const int c = lane & 7;
#pragma unroll
    for (int j = 0; j < 4; ++j) { const int n = (lane >> 3) + 8 * j; const LAS float* s = scr + (8 * c) * 33 + n;
        v4u o; o.x = pk2(s[0 * 33], s[1 * 33]); o.y = pk2(s[2 * 33], s[3 * 33]); o.z = pk2(s[4 * 33], s[5 * 33]); o.w = pk2(s[6 * 33], s[7 * 33]);
        *(v4u*)(WT + (size_t)(n_dst0 + n) * K + k0 + 8 * c) = o; }
    LDS_WAIT(); asm volatile("" ::: "memory");
}

__global__ void __launch_bounds__(NWAVES * 64, 2) mega(Params a) {
    extern __shared__ __attribute__((aligned(16))) unsigned char lds_raw[];
    LAS unsigned char* lds = (LAS unsigned char*)lds_raw;
    volatile LAS unsigned* MISC = (volatile LAS unsigned*)(lds + MISC_OFF);
    const int tid = threadIdx.x, lane = tid & 63, wave = __builtin_amdgcn_readfirstlane(tid >> 6);
    const int G = gridDim.x, bx = blockIdx.x, vcu = (G % 8 == 0) ? (bx % 8) * (G / 8) + bx / 8 : bx;
    const int gw = vcu * NWAVES + wave, NGW = G * NWAVES, gt = vcu * (NWAVES * 64) + tid, NGT = G * NWAVES * 64;
    unsigned* ctl = (unsigned*)(a.ws + WS_CTL);
#define H ((float*)a.out)
#define cs ((float*)(a.ws + WS_ROPE))
#define sn ((float*)(a.ws + WS_ROPE) + NTOK * 8)
#define WIN ((bf16*)(a.ws + WS_WIN))
#define WOUT ((bf16*)(a.ws + WS_WOUT))
#define WQK ((bf16*)(a.ws + WS_WQK))
#define WG ((bf16*)(a.ws + WS_WG))
#define WP ((bf16*)(a.ws + WS_WP))
#define U ((bf16*)(a.ws + WS_U))
#define V ((bf16*)(a.ws + WS_V))
#define XN ((bf16*)(a.ws + WS_XN))
#define Q ((bf16*)(a.ws + WS_Q))
#define Kb ((bf16*)(a.ws + WS_K))
#define Vb ((bf16*)(a.ws + WS_VV))
#define GLU ((bf16*)(a.ws + WS_GLU))
#define SC ((bf16*)(a.ws + WS_SC))
#define ATT ((bf16*)(a.ws + WS_ATT))
#define Y ((bf16*)(a.ws + WS_Y))
#define EID ((int*)(a.ws + WS_EID))
#define GATE ((float*)(a.ws + WS_GATE))
#define PP ((bf16*)(a.ws + WS_PP))

    for (int u = tid; u < (LDS_BYTES - LDSCTL_OFF) / 4; u += NWAVES * 64) ((LAS unsigned*)(lds + LDSCTL_OFF))[u] = 0u;
    __syncthreads();
    XcdBarrier bar = xcd_barrier_post(ctl + CW_BAR, MISC + 8);

    if (PH_MASK & (1u << 0)) {
    {
        LAS float* scr = (LAS float*)(lds + RING_OFF + wave * 16384);
        constexpr int I_IN = (DM / 64) * (DIN / 32), I_SQ = (DM / 64) * (DM / 32), I_WP = (PLE / 64) * (DM / 32);
        for (int it = gw; it < I_IN + 2 * I_SQ + I_WP; it += NGW) {
            int r = it;
            if (r < I_IN) { const int nb = r % (DIN / 32), kb = r / (DIN / 32); transpose_item(a.w_in, DM, DIN, WIN, 32 * nb, nv::win_srccol(32 * nb), 64 * kb, scr, lane); continue; } r -= I_IN;
            if (r < I_SQ) { const int nb = r % (DM / 32), kb = r / (DM / 32); transpose_item(a.w_out, DM, DM, WOUT, 32 * nb, 32 * nb, 64 * kb, scr, lane); continue; } r -= I_SQ;
            if (r < I_SQ) { const int nb = r % (DM / 32), kb = r / (DM / 32); transpose_item(a.wg, DM, DM, WG, 32 * nb, 32 * nb, 64 * kb, scr, lane); continue; } r -= I_SQ;
            { const int nb = r % (DM / 32), kb = r / (DM / 32); transpose_item(a.wp, PLE, DM, WP, 32 * nb, 32 * nb, 64 * kb, scr, lane); }
        }
        for (int i = gt; i < 2048 * 1024; i += NGT) { const int n = i >> 10, d = i & 1023, hp = n >> 7, kk = n & 127, p = hp & 1;
            const float* w = a.wq + (size_t)d * 2048 + hp * 128; const float* kr = a.keys + ((size_t)p * 128 + kk) * 128; float s = 0.f;
            for (int c = 0; c < 128; c += 4) { const f32x4 wv = *(const f32x4*)(w + c), kv = *(const f32x4*)(kr + c); s += wv.x * kv.x + wv.y * kv.y + wv.z * kv.z + wv.w * kv.w; }
            WQK[i] = (bf16)f2bf(s); }
        for (size_t i = gt; i < (size_t)NEXP * DM / 8; i += NGT) { const f32x4 u0 = ((const f32x4*)a.eu)[2 * i], u1 = ((const f32x4*)a.eu)[2 * i + 1], v0 = ((const f32x4*)a.ev)[2 * i], v1 = ((const f32x4*)a.ev)[2 * i + 1];
            v4u o; o.x = pk2(u0.x, u0.y); o.y = pk2(u0.z, u0.w); o.z = pk2(u1.x, u1.y); o.w = pk2(u1.z, u1.w); ((v4u*)U)[i] = o;
            o.x = pk2(v0.x, v0.y); o.y = pk2(v0.z, v0.w); o.z = pk2(v1.x, v1.y); o.w = pk2(v1.z, v1.w); ((v4u*)V)[i] = o; }
        for (size_t i = gt; i < (size_t)NTOK * PLE / 8; i += NGT) { const f32x4 u0 = ((const f32x4*)a.p)[2 * i], u1 = ((const f32x4*)a.p)[2 * i + 1];
            v4u o; o.x = pk2(u0.x, u0.y); o.y = pk2(u0.z, u0.w); o.z = pk2(u1.x, u1.y); o.w = pk2(u1.z, u1.w); ((v4u*)PP)[i] = o; }
        for (int i = gt; i < NTOK * 8; i += NGT) { const float ang = (float)a.pos[i >> 3] * a.freq[i & 7]; cs[i] = cosf(ang); sn[i] = sinf(ang); }
        for (int r = gw; r < NTOK; r += NGW) nv::rms_row<false>(r, lane, a.x, a.norm_mix, XN);
    }
    }
    xcd_barrier(bar);
    if (PH_MASK & (1u << 1)) {
    { pg8::Gemm g{XN, WIN, NTOK, DIN, DM}; pg8::StaticOrder S; S.init(NTOK, DIN, G, bx); pg8::EpiInProj E{Q, cs, sn};
      pg8::gemm_phase<pg8::EpiInProj, pg8::StaticOrder, true, true>(lds + RING_OFF, g, S, E); }
    }
    xcd_barrier(bar);
    if (PH_MASK & (1u << 2)) {
    for (int i = gw; i < NTOK * NH; i += NGW) nv::attn_item(i, lane, Q, Kb, Vb, ATT);
    }
    xcd_barrier(bar);
    if (PH_MASK & (1u << 3)) {
    for (int t = gw; t < NTOK; t += NGW) nv::mix_token(t, lane, GLU, ATT, a.conv_w, a.conv_b, a.ln_g, a.ln_b, a.g_att, a.g_conv, Y);
    }
    xcd_barrier(bar);
    if (PH_MASK & (1u << 4)) {
    { pg8::Gemm g{Y, WOUT, NTOK, DM, DM}; pg8::StaticOrder S; S.init(NTOK, DM, G, bx); pg8::EpiResid E{a.x, H};
      pg8::gemm_phase<pg8::EpiResid, pg8::StaticOrder, false, true>(lds + RING_OFF, g, S, E); }
    }
    xcd_barrier(bar);
    if (PH_MASK & (1u << 5)) {
    for (int r = gw; r < NTOK; r += NGW) nv::rms_row<false>(r, lane, H, a.norm_ffn, XN);
    }
    xcd_barrier(bar);
    if (PH_MASK & (1u << 6)) {
    { pg8::Gemm g{XN, WQK, NTOK, 2048, DM}; pg8::StaticOrder S; S.init(NTOK, 2048, G, bx); pg8::EpiBf16<0> E{SC, 2048, nullptr, 0, 0, 1.f};
      pg8::gemm_phase<pg8::EpiBf16<0>, pg8::StaticOrder, true, true>(lds + RING_OFF, g, S, E); }
    }
    xcd_barrier(bar);
    if (PH_MASK & (1u << 7)) {
    for (int i = gt; i < NTOK * PH; i += NGT) nv::topk_item(i, SC, EID, GATE);
    }
    xcd_barrier(bar);
    if (PH_MASK & (1u << 8)) {
    for (int t = gw; t < NTOK; t += NGW) nv::peer_token(t, lane, XN, U, V, EID, GATE, H);
    }
    xcd_barrier(bar);
    if (PH_MASK & (1u << 9)) {
    for (int r = gw; r < NTOK; r += NGW) nv::rms_row<false>(r, lane, H, a.norm_ple, XN);
    }
    xcd_barrier(bar);
    if (PH_MASK & (1u << 10)) {
    { pg8::Gemm g{PP, WP, NTOK, DM, PLE}; pg8::StaticOrder S; S.init(NTOK, DM, G, bx); pg8::EpiBf16<0> E{Y, DM, nullptr, 0, 0, 1.f};
      pg8::gemm_phase<pg8::EpiBf16<0>, pg8::StaticOrder, false, true>(lds + RING_OFF, g, S, E); }
    VM_WAIT(); __syncthreads();
    { pg8::Gemm g{XN, WG, NTOK, DM, DM}; pg8::StaticOrder S; S.init(NTOK, DM, G, bx); pg8::EpiPle E{H, Y};
      pg8::gemm_phase<pg8::EpiPle, pg8::StaticOrder, false, true>(lds + RING_OFF, g, S, E); }
    }
    xcd_barrier(bar);
    if (PH_MASK & (1u << 11)) {
    for (int r = gw; r < NTOK; r += NGW) nv::rms_row<true>(r, lane, H, a.fin, H);
    }
#undef H
#undef cs
#undef sn
#undef WIN
#undef WOUT
#undef WQK
#undef WG
#undef WP
#undef U
#undef V
#undef XN
#undef Q
#undef Kb
#undef Vb
#undef GLU
#undef SC
#undef ATT
#undef Y
#undef EID
#undef GATE
#undef PP
}

extern "C" void kernel_launch(void* const* d_in, const int* in_sizes, int n_in, void* d_out, int out_size, void* d_ws, size_t ws_size, hipStream_t stream) {
    static int grid = 0;
    if (grid == 0) {
        if (n_in != 21 || out_size != NTOK * DM || ws_size < WS_END) { fprintf(stderr, "kernel_launch: unexpected shapes n_in %d out %d ws %zu\n", n_in, out_size, ws_size); grid = -1; return; }
        int dev = 0, cus = 0, per_cu = 0;
        if (hipGetDevice(&dev) != hipSuccess || hipDeviceGetAttribute(&cus, hipDeviceAttributeMultiprocessorCount, dev) != hipSuccess) { grid = -1; return; }
        if (hipFuncSetAttribute((const void*)mega, hipFuncAttributeMaxDynamicSharedMemorySize, LDS_BYTES) != hipSuccess) { fprintf(stderr, "kernel_launch: hipFuncSetAttribute failed\n"); grid = -1; return; }
        if (hipOccupancyMaxActiveBlocksPerMultiprocessor(&per_cu, (const void*)mega, NWAVES * 64, LDS_BYTES) != hipSuccess || per_cu < 1) { fprintf(stderr, "kernel_launch: occupancy query says %d\n", per_cu); }
        (void)hipGetLastError();
        grid = cus;
    }
    if (grid < 0) return;
    (void)hipMemsetAsync((char*)d_ws + WS_CTL, 0, 1 * MiB, stream);
    Params a{};
    a.x = (const float*)d_in[0]; a.p = (const float*)d_in[1]; a.pos = (const int*)d_in[2]; a.norm_mix = (const float*)d_in[3]; a.w_in = (const float*)d_in[4]; a.conv_w = (const float*)d_in[5];
    a.conv_b = (const float*)d_in[6]; a.ln_g = (const float*)d_in[7]; a.ln_b = (const float*)d_in[8]; a.g_att = (const float*)d_in[9]; a.g_conv = (const float*)d_in[10]; a.w_out = (const float*)d_in[11];
    a.norm_ffn = (const float*)d_in[12]; a.wq = (const float*)d_in[13]; a.keys = (const float*)d_in[14]; a.eu = (const float*)d_in[15]; a.ev = (const float*)d_in[16]; a.norm_ple = (const float*)d_in[17];
    a.wg = (const float*)d_in[18]; a.wp = (const float*)d_in[19]; a.fin = (const float*)d_in[20]; a.out = (float*)d_out; a.ws = (unsigned char*)d_ws;
    for (int i = 0; i < 8; ++i) a.freq[i] = (float)pow(500000.0, -(double)i / 8.0);
    hipLaunchKernelGGL(mega, dim3(grid), dim3(NWAVES * 64), LDS_BYTES, stream, a);
}
```

```cpp
#include <hip/hip_runtime.h>
#include <cstdio>
#include <cstdint>
#include <cmath>

constexpr int BATCH = 2, SEQ = 8192, DM = 1024, NTOK = BATCH * SEQ;
constexpr int PLE = 256, HD = 64, NH = 8, DATT = 512, DCONV = 512, DIN = 2560, CW = 31;
constexpr int NKEYS = 128, NEXP = 16384, PH = 8, TOPK = 16, HK = PH * TOPK;
constexpr float EPS = 1e-6f;
constexpr float QSCALE = 0.125f * 1.4426950408889634f;

typedef unsigned short bf16;
typedef unsigned v4u __attribute__((ext_vector_type(4)));
typedef unsigned v2u __attribute__((ext_vector_type(2)));
typedef float f32x4 __attribute__((ext_vector_type(4)));

constexpr size_t MiB = 1u << 20;
constexpr size_t WS_CTL = 0;
constexpr size_t WS_ROPE = 1 * MiB;
constexpr size_t WS_WIN = 2 * MiB;
constexpr size_t WS_WOUT = 7 * MiB;
constexpr size_t WS_WQK = 9 * MiB;
constexpr size_t WS_WG = 13 * MiB;
constexpr size_t WS_WP = 15 * MiB;
constexpr size_t WS_U = 16 * MiB;
constexpr size_t WS_V = 48 * MiB;
constexpr size_t WS_XN = 80 * MiB;
constexpr size_t WS_Q = 112 * MiB, WS_K = 128 * MiB, WS_VV = 144 * MiB, WS_GLU = 160 * MiB;
constexpr size_t WS_SC = 112 * MiB;
constexpr size_t WS_ATT = 176 * MiB;
constexpr size_t WS_Y = 192 * MiB;
constexpr size_t WS_EID = 224 * MiB;
constexpr size_t WS_GATE = 232 * MiB;
constexpr size_t WS_PP = 240 * MiB;
constexpr size_t WS_MISC = 248 * MiB;
constexpr size_t WS_END = 256 * MiB;

__device__ __forceinline__ unsigned f2bf(float f) { unsigned u = __float_as_uint(f); return (u + 0x7fffu + ((u >> 16) & 1u)) >> 16; }
__device__ __forceinline__ float bf2f(unsigned h) { return __uint_as_float(h << 16); }
__device__ __forceinline__ unsigned pk2(float lo, float hi) { return f2bf(lo) | (f2bf(hi) << 16); }
__device__ __forceinline__ float bflo(unsigned w) { return __uint_as_float(w << 16); }
__device__ __forceinline__ float bfhi(unsigned w) { return __uint_as_float(w & 0xffff0000u); }
__device__ __forceinline__ float wave_sum(float v) {
#pragma unroll
    for (int o = 1; o < 64; o <<= 1) v += __shfl_xor(v, o);
    return v;
}
__device__ __forceinline__ float sigmoidf_(float x) { return 1.f / (1.f + __expf(-x)); }
__device__ __forceinline__ float gelu_erf(float x) { return 0.5f * x * (1.f + erff(x * 0.70710678118654752f)); }

__device__ __forceinline__ unsigned f2key(float f) { unsigned u = __float_as_uint(f); return (u & 0x80000000u) ? ~u : (u | 0x80000000u); }
__device__ __forceinline__ float key2f(unsigned k) { unsigned u = (k & 0x80000000u) ? (k & 0x7fffffffu) : ~k; return __uint_as_float(u); }
__device__ __forceinline__ void ins16(unsigned (&L)[16], unsigned x) {
#pragma unroll
    for (int i = 0; i < 16; ++i) { const unsigned h = L[i] > x ? L[i] : x; x = L[i] > x ? x : L[i]; L[i] = h; }
}
#define INS16(L, xx) ins16(L, (xx))
__device__ __forceinline__ int sel16(const int (&a)[16], int i) {
    int v0 = a[0], v1 = a[1], v2 = a[2], v3 = a[3], v4 = a[4], v5 = a[5], v6 = a[6], v7 = a[7], v8 = a[8], v9 = a[9], v10 = a[10], v11 = a[11], v12 = a[12], v13 = a[13], v14 = a[14], v15 = a[15];
    asm volatile("" : "+v"(v0), "+v"(v1), "+v"(v2), "+v"(v3), "+v"(v4), "+v"(v5), "+v"(v6), "+v"(v7));
    asm volatile("" : "+v"(v8), "+v"(v9), "+v"(v10), "+v"(v11), "+v"(v12), "+v"(v13), "+v"(v14), "+v"(v15));
    const bool b0 = i & 1, b1 = i & 2, b2 = i & 4, b3 = i & 8;
    const int t0 = b0 ? v1 : v0, t1 = b0 ? v3 : v2, t2 = b0 ? v5 : v4, t3 = b0 ? v7 : v6, t4 = b0 ? v9 : v8, t5 = b0 ? v11 : v10, t6 = b0 ? v13 : v12, t7 = b0 ? v15 : v14;
    const int s0 = b1 ? t1 : t0, s1 = b1 ? t3 : t2, s2 = b1 ? t5 : t4, s3 = b1 ? t7 : t6;
    const int r0 = b2 ? s1 : s0, r1 = b2 ? s3 : s2;
    return b3 ? r1 : r0;
}
__device__ __forceinline__ void topk_combine(const unsigned (&La)[16], const unsigned (&Lb)[16], int* eid_out, float* gate_out) {
    float a[16], b[16]; int ia[16], ib[16];
#pragma unroll
    for (int i = 0; i < 16; ++i) { a[i] = key2f(La[i] & ~127u); ia[i] = 127 - (int)(La[i] & 127u); b[i] = key2f(Lb[i] & ~127u); ib[i] = 127 - (int)(Lb[i] & 127u);
        asm volatile("" : "+v"(ia[i]), "+v"(ib[i])); }
    unsigned Lc[16];
#pragma unroll
    for (int i = 0; i < 16; ++i) Lc[i] = 0u;
#define TK_CAND(i, j) do { const float s_ = a[i] + b[j]; const unsigned k_ = (f2key(s_) & ~255u) | (unsigned)(255 - ((i) * 16 + (j))); INS16(Lc, k_); } while (0)
    TK_CAND(0, 0); TK_CAND(0, 1); TK_CAND(0, 2); TK_CAND(0, 3); TK_CAND(0, 4); TK_CAND(0, 5); TK_CAND(0, 6); TK_CAND(0, 7);
    TK_CAND(0, 8); TK_CAND(0, 9); TK_CAND(0, 10); TK_CAND(0, 11); TK_CAND(0, 12); TK_CAND(0, 13); TK_CAND(0, 14); TK_CAND(0, 15);
    TK_CAND(1, 0); TK_CAND(1, 1); TK_CAND(1, 2); TK_CAND(1, 3); TK_CAND(1, 4); TK_CAND(1, 5); TK_CAND(1, 6); TK_CAND(1, 7);
    TK_CAND(2, 0); TK_CAND(2, 1); TK_CAND(2, 2); TK_CAND(2, 3); TK_CAND(2, 4);
    TK_CAND(3, 0); TK_CAND(3, 1); TK_CAND(3, 2); TK_CAND(3, 3);
    TK_CAND(4, 0); TK_CAND(4, 1); TK_CAND(4, 2);
    TK_CAND(5, 0); TK_CAND(5, 1); TK_CAND(6, 0); TK_CAND(6, 1); TK_CAND(7, 0); TK_CAND(7, 1);
    TK_CAND(8, 0); TK_CAND(9, 0); TK_CAND(10, 0); TK_CAND(11, 0); TK_CAND(12, 0); TK_CAND(13, 0); TK_CAND(14, 0); TK_CAND(15, 0);
#undef TK_CAND
    float sv[16]; float m = -3.0e38f;
#pragma unroll
    for (int r = 0; r < 16; ++r) { sv[r] = key2f(Lc[r] & ~255u); m = fmaxf(m, sv[r]); }
    float sum = 0.f;
#pragma unroll
    for (int r = 0; r < 16; ++r) { sv[r] = __expf(sv[r] - m); sum += sv[r]; }
    const float inv = 1.f / sum;
#pragma unroll
    for (int r = 0; r < 16; ++r) { const int c = 255 - (int)(Lc[r] & 255u); const int i1 = sel16(ia, c >> 4), i2 = sel16(ib, c & 15);
        eid_out[r] = i1 * NKEYS + i2; gate_out[r] = sv[r] * inv; }
}
namespace nv {
__device__ __forceinline__ int win_srccol(int n) { if (n < 1536) return n; const int j = n - 1536, u = j >> 8, r = j & 255; return r < 128 ? 1536 + 128 * u + r : 2048 + 128 * u + (r - 128); }
__global__ void transpose_w(const float* W, int K, int NW, int N, bf16* WT, int mode) {
    const size_t i = (size_t)blockIdx.x * blockDim.x + threadIdx.x; if (i >= (size_t)N * K) return;
    const int n = (int)(i / K), k = (int)(i % K); const int c = mode == 1 ? win_srccol(n) : n;
    WT[i] = (bf16)f2bf(W[(size_t)k * NW + c]);
}
__global__ void fold_wq(const float* wq, const float* keys, bf16* WQK) {
    const size_t i = (size_t)blockIdx.x * blockDim.x + threadIdx.x; if (i >= (size_t)2048 * 1024) return;
    const int n = (int)(i / 1024), d = (int)(i % 1024); const int hp = n >> 7, kk = n & 127, p = hp & 1;
    const float* w = wq + (size_t)d * 2048 + hp * 128; const float* kr = keys + ((size_t)p * 128 + kk) * 128; float s = 0.f;
    for (int c = 0; c < 128; ++c) s += w[c] * kr[c];
    WQK[i] = (bf16)f2bf(s);
}
__global__ void cvt_bf16(const float* src, bf16* dst, size_t n) { const size_t i = (size_t)blockIdx.x * blockDim.x + threadIdx.x; if (i < n) dst[i] = (bf16)f2bf(src[i]); }
struct Freq { float f[8]; };
__global__ void rope_table(const int* pos, float* cs, float* sn, Freq fr) {
    const int i = blockIdx.x * blockDim.x + threadIdx.x; if (i >= NTOK * 8) return;
    const float ang = (float)pos[i >> 3] * fr.f[i & 7]; cs[i] = cosf(ang); sn[i] = sinf(ang);
}
template <bool OUTF32> __device__ __forceinline__ void rms_row(int row, int lane, const float* in, const float* g, void* out) {
    const f32x4* xr = (const f32x4*)(in + (size_t)row * DM) + lane; f32x4 v[4]; float s = 0.f;
#pragma unroll
    for (int j = 0; j < 4; ++j) { v[j] = xr[64 * j]; s += v[j].x * v[j].x + v[j].y * v[j].y + v[j].z * v[j].z + v[j].w * v[j].w; }
    const float r = rsqrtf(wave_sum(s) * (1.f / DM) + EPS);
#pragma unroll
    for (int j = 0; j < 4; ++j) { const f32x4 gg = ((const f32x4*)g)[lane + 64 * j]; const f32x4 o = v[j] * r * gg;
        if (OUTF32) ((f32x4*)((float*)out + (size_t)row * DM))[lane + 64 * j] = o;
        else { v2u w; w.x = pk2(o.x, o.y); w.y = pk2(o.z, o.w); ((v2u*)((bf16*)out + (size_t)row * DM))[lane + 64 * j] = w; } }
}
template <bool OUTF32> __global__ void rms_rows(const float* in, const float* g, void* out) {
    const int row = blockIdx.x * 4 + (threadIdx.x >> 6); if (row >= NTOK) return; rms_row<OUTF32>(row, threadIdx.x & 63, in, g, out);
}
struct GP { const bf16* A; const bf16* Bt; const float* cs; const float* sn; bf16 *Q, *Kb, *Vb, *GLU; const float* x; float* H; bf16* O; const bf16* PPO; int M, N, K, pad; };
__device__ __forceinline__ void dot4(const bf16* A, const bf16* Bt, int K, int m0, int n, float (&acc)[4]) {
    const v4u* b = (const v4u*)(Bt + (size_t)n * K);
#pragma unroll
    for (int r = 0; r < 4; ++r) acc[r] = 0.f;
    for (int kc = 0; kc < K / 8; ++kc) { const v4u bw = b[kc];
#pragma unroll
        for (int r = 0; r < 4; ++r) { const v4u aw = ((const v4u*)(A + (size_t)(m0 + r) * K))[kc];
            acc[r] += bflo(aw.x) * bflo(bw.x) + bfhi(aw.x) * bfhi(bw.x) + bflo(aw.y) * bflo(bw.y) + bfhi(aw.y) * bfhi(bw.y) + bflo(aw.z) * bflo(bw.z) + bfhi(aw.z) * bfhi(bw.z) + bflo(aw.w) * bflo(bw.w) + bfhi(aw.w) * bfhi(bw.w); } }
}
template <int EPI> __global__ void gemm(GP p) {
    const int n = blockIdx.x * 256 + threadIdx.x, m0 = blockIdx.y * 4; if (n >= p.N) return;
    float acc[4];
    if (EPI == 1) {
        if (n < 1024) {
            dot4(p.A, p.Bt, p.K, m0, n, acc); const int hc = n & 63;
            if (hc < 16) { float pa[4]; dot4(p.A, p.Bt, p.K, m0, n ^ 8, pa);
#pragma unroll
                for (int r = 0; r < 4; ++r) { const float c = p.cs[(size_t)(m0 + r) * 8 + (hc & 7)], s = p.sn[(size_t)(m0 + r) * 8 + (hc & 7)];
                    acc[r] = (hc & 8) ? acc[r] * c + pa[r] * s : acc[r] * c - pa[r] * s; } }
#pragma unroll
            for (int r = 0; r < 4; ++r) { if (n < 512) p.Q[(size_t)(m0 + r) * 512 + n] = (bf16)f2bf(acc[r] * QSCALE); else p.Kb[(size_t)(m0 + r) * 512 + n - 512] = (bf16)f2bf(acc[r]); }
        } else if (n < 1536) { dot4(p.A, p.Bt, p.K, m0, n, acc);
#pragma unroll
            for (int r = 0; r < 4; ++r) p.Vb[(size_t)(m0 + r) * 512 + n - 1024] = (bf16)f2bf(acc[r]);
        } else { const int j = n - 1536, u = j >> 8, rr = j & 255; if (rr >= 128) return; float g[4]; dot4(p.A, p.Bt, p.K, m0, n, acc); dot4(p.A, p.Bt, p.K, m0, n + 128, g);
#pragma unroll
            for (int r = 0; r < 4; ++r) p.GLU[(size_t)(m0 + r) * 512 + 128 * u + rr] = (bf16)f2bf(acc[r] * sigmoidf_(g[r])); }
    } else {
        dot4(p.A, p.Bt, p.K, m0, n, acc);
#pragma unroll
        for (int r = 0; r < 4; ++r) { const size_t o = (size_t)(m0 + r) * p.N + n;
            if (EPI == 2) p.H[o] = p.x[o] + acc[r];
            if (EPI == 3) p.O[o] = (bf16)f2bf(acc[r]);
            if (EPI == 4) p.H[o] = p.H[o] + sigmoidf_(acc[r]) * bf2f(p.PPO[o]); }
    }
}
__device__ __forceinline__ void attn_item(int gw, int lane, const bf16* Q, const bf16* Kb, const bf16* Vb, bf16* ATT) {
    const int tok = gw >> 3, h = gw & 7, b = tok / SEQ, s = tok % SEQ;
    const float q = bf2f(Q[(size_t)tok * 512 + h * 64 + lane]);
    float o[3], lse[3]; const int dil[3] = {1, 4, 16};
#pragma unroll
    for (int p = 0; p < 3; ++p) { float m = -3.0e38f, l = 0.f, acc = 0.f;
        for (int j = 0; j <= 128; ++j) { const int tk = s - j * dil[p]; if (tk < 0) break; const size_t kr = ((size_t)b * SEQ + tk) * 512 + h * 64 + lane;
            const float sc = wave_sum(q * bf2f(Kb[kr])); const float mn = fmaxf(m, sc), al = exp2f(m - mn), pe = exp2f(sc - mn);
            l = l * al + pe; acc = acc * al + pe * bf2f(Vb[kr]); m = mn; }
        o[p] = acc / l; lse[p] = m + log2f(l); }
    const float M = fmaxf(lse[0], fmaxf(lse[1], lse[2])); const float w0 = exp2f(lse[0] - M), w1 = exp2f(lse[1] - M), w2 = exp2f(lse[2] - M);
    ATT[(size_t)tok * 512 + h * 64 + lane] = (bf16)f2bf((w0 * o[0] + w1 * o[1] + w2 * o[2]) / (w0 + w1 + w2));
}
__global__ void attn(const bf16* Q, const bf16* Kb, const bf16* Vb, bf16* ATT) {
    const int gw = blockIdx.x * 4 + (threadIdx.x >> 6); if (gw >= NTOK * NH) return; attn_item(gw, threadIdx.x & 63, Q, Kb, Vb, ATT);
}
__device__ __forceinline__ void mix_token(int tok, int lane, const bf16* GLU, const bf16* ATT, const float* cw, const float* cb, const float* lg, const float* lb, const float* ga, const float* gc, bf16* Y) {
    const int s = tok % SEQ, c0 = lane * 8; float acc[8];
    { const f32x4 b0 = *(const f32x4*)(cb + c0), b1 = *(const f32x4*)(cb + c0 + 4); acc[0] = b0.x; acc[1] = b0.y; acc[2] = b0.z; acc[3] = b0.w; acc[4] = b1.x; acc[5] = b1.y; acc[6] = b1.z; acc[7] = b1.w; }
    for (int j = 0; j < CW; ++j) { const int ts = s - (CW - 1) + j; if (ts < 0) continue;
        const v4u g = *(const v4u*)(GLU + (size_t)(tok - (CW - 1) + j) * 512 + c0); const f32x4 w0 = *(const f32x4*)(cw + j * 512 + c0), w1 = *(const f32x4*)(cw + j * 512 + c0 + 4);
        acc[0] += w0.x * bflo(g.x); acc[1] += w0.y * bfhi(g.x); acc[2] += w0.z * bflo(g.y); acc[3] += w0.w * bfhi(g.y); acc[4] += w1.x * bflo(g.z); acc[5] += w1.y * bfhi(g.z); acc[6] += w1.z * bflo(g.w); acc[7] += w1.w * bfhi(g.w); }
    float sm = 0.f;
#pragma unroll
    for (int i = 0; i < 8; ++i) sm += acc[i];
    const float mean = wave_sum(sm) * (1.f / 512.f); float sq = 0.f;
#pragma unroll
    for (int i = 0; i < 8; ++i) { acc[i] -= mean; sq += acc[i] * acc[i]; }
    const float rstd = rsqrtf(wave_sum(sq) * (1.f / 512.f) + EPS); float ss = 0.f;
#pragma unroll
    for (int i = 0; i < 8; ++i) { const float y = acc[i] * rstd * lg[c0 + i] + lb[c0 + i]; acc[i] = y * sigmoidf_(y); ss += acc[i] * acc[i]; }
    const float rc = rsqrtf(wave_sum(ss) * (1.f / 512.f) + EPS);
    v4u o; o.x = pk2(acc[0] * rc * gc[c0 + 0], acc[1] * rc * gc[c0 + 1]); o.y = pk2(acc[2] * rc * gc[c0 + 2], acc[3] * rc * gc[c0 + 3]); o.z = pk2(acc[4] * rc * gc[c0 + 4], acc[5] * rc * gc[c0 + 5]); o.w = pk2(acc[6] * rc * gc[c0 + 6], acc[7] * rc * gc[c0 + 7]);
    *(v4u*)(Y + (size_t)tok * 1024 + 512 + c0) = o;
    const v4u a = *(const v4u*)(ATT + (size_t)tok * 512 + c0); float av[8] = {bflo(a.x), bfhi(a.x), bflo(a.y), bfhi(a.y), bflo(a.z), bfhi(a.z), bflo(a.w), bfhi(a.w)}; float sa = 0.f;
#pragma unroll
    for (int i = 0; i < 8; ++i) sa += av[i] * av[i];
    const float ra = rsqrtf(wave_sum(sa) * (1.f / 512.f) + EPS);
    v4u oa; oa.x = pk2(av[0] * ra * ga[c0 + 0], av[1] * ra * ga[c0 + 1]); oa.y = pk2(av[2] * ra * ga[c0 + 2], av[3] * ra * ga[c0 + 3]); oa.z = pk2(av[4] * ra * ga[c0 + 4], av[5] * ra * ga[c0 + 5]); oa.w = pk2(av[6] * ra * ga[c0 + 6], av[7] * ra * ga[c0 + 7]);
    *(v4u*)(Y + (size_t)tok * 1024 + c0) = oa;
}
__global__ void mix_norm(const bf16* GLU, const bf16* ATT, const float* cw, const float* cb, const float* lg, const float* lb, const float* ga, const float* gc, bf16* Y) {
    const int tok = blockIdx.x * 4 + (threadIdx.x >> 6); if (tok >= NTOK) return; mix_token(tok, threadIdx.x & 63, GLU, ATT, cw, cb, lg, lb, ga, gc, Y);
}
__device__ __forceinline__ void topk_item(int i, const bf16* SC, int* EID, float* GATE) {
    const bf16* row = SC + (size_t)i * 256; unsigned La[16], Lb[16];
#pragma unroll
    for (int q = 0; q < 16; ++q) { La[q] = 0u; Lb[q] = 0u; }
    for (int c = 0; c < 128; ++c) { const unsigned k = (f2key(bf2f(row[c])) & ~127u) | (unsigned)(127 - c); INS16(La, k); }
    for (int c = 0; c < 128; ++c) { const unsigned k = (f2key(bf2f(row[128 + c])) & ~127u) | (unsigned)(127 - c); INS16(Lb, k); }
    int e[16]; float g[16]; topk_combine(La, Lb, e, g);
#pragma unroll
    for (int r = 0; r < 16; ++r) { EID[(size_t)i * 16 + r] = e[r]; GATE[(size_t)i * 16 + r] = g[r]; }
}
__global__ void topk(const bf16* SC, int* EID, float* GATE) {
    const int i = blockIdx.x * blockDim.x + threadIdx.x; if (i >= NTOK * PH) return; topk_item(i, SC, EID, GATE);
}
__device__ __forceinline__ void peer_token(int tok, int lane, const bf16* XN, const bf16* U, const bf16* V, const int* EID, const float* GATE, float* H) {
    float x[16], y[16];
    { const v4u a = ((const v4u*)(XN + (size_t)tok * 1024))[lane * 2], b = ((const v4u*)(XN + (size_t)tok * 1024))[lane * 2 + 1];
      x[0] = bflo(a.x); x[1] = bfhi(a.x); x[2] = bflo(a.y); x[3] = bfhi(a.y); x[4] = bflo(a.z); x[5] = bfhi(a.z); x[6] = bflo(a.w); x[7] = bfhi(a.w);
      x[8] = bflo(b.x); x[9] = bfhi(b.x); x[10] = bflo(b.y); x[11] = bfhi(b.y); x[12] = bflo(b.z); x[13] = bfhi(b.z); x[14] = bflo(b.w); x[15] = bfhi(b.w); }
#pragma unroll
    for (int i = 0; i < 16; ++i) y[i] = 0.f;
    for (int k = 0; k < HK; ++k) { const int e = EID[(size_t)tok * HK + k]; const float g = GATE[(size_t)tok * HK + k];
        const v4u a = ((const v4u*)(U + (size_t)e * 1024))[lane * 2], b = ((const v4u*)(U + (size_t)e * 1024))[lane * 2 + 1];
        float d = x[0] * bflo(a.x) + x[1] * bfhi(a.x) + x[2] * bflo(a.y) + x[3] * bfhi(a.y) + x[4] * bflo(a.z) + x[5] * bfhi(a.z) + x[6] * bflo(a.w) + x[7] * bfhi(a.w)
                + x[8] * bflo(b.x) + x[9] * bfhi(b.x) + x[10] * bflo(b.y) + x[11] * bfhi(b.y) + x[12] * bflo(b.z) + x[13] * bfhi(b.z) + x[14] * bflo(b.w) + x[15] * bfhi(b.w);
        d = wave_sum(d); const float act = gelu_erf(d) * g;
        const v4u c = ((const v4u*)(V + (size_t)e * 1024))[lane * 2], dd = ((const v4u*)(V + (size_t)e * 1024))[lane * 2 + 1];
        y[0] += act * bflo(c.x); y[1] += act * bfhi(c.x); y[2] += act * bflo(c.y); y[3] += act * bfhi(c.y); y[4] += act * bflo(c.z); y[5] += act * bfhi(c.z); y[6] += act * bflo(c.w); y[7] += act * bfhi(c.w);
        y[8] += act * bflo(dd.x); y[9] += act * bfhi(dd.x); y[10] += act * bflo(dd.y); y[11] += act * bfhi(dd.y); y[12] += act * bflo(dd.z); y[13] += act * bfhi(dd.z); y[14] += act * bflo(dd.w); y[15] += act * bfhi(dd.w); }
    float* hr = H + (size_t)tok * 1024 + lane * 16;
#pragma unroll
    for (int i = 0; i < 4; ++i) { f32x4 v = ((f32x4*)hr)[i]; v.x += y[4 * i]; v.y += y[4 * i + 1]; v.z += y[4 * i + 2]; v.w += y[4 * i + 3]; ((f32x4*)hr)[i] = v; }
}
__global__ void peer(const bf16* XN, const bf16* U, const bf16* V, const int* EID, const float* GATE, float* H) {
    const int tok = blockIdx.x * 4 + (threadIdx.x >> 6); if (tok >= NTOK) return; peer_token(tok, threadIdx.x & 63, XN, U, V, EID, GATE, H);
}
}
namespace pg8 {
#define PG8_LAS __attribute__((address_space(3)))
typedef unsigned short bf16_t;
typedef short bf16x8 __attribute__((ext_vector_type(8)));
typedef float f32x4 __attribute__((ext_vector_type(4)));
typedef unsigned u32x4 __attribute__((ext_vector_type(4)));
constexpr int BM = 256, BK = 64, HALF = 128, HTB = HALF * BK * 2  , STAGE_BYTES = 8 * HTB, NXCD = 8, WGM = 8;

__host__ __device__ __forceinline__ int lds_byte(int r, int c) { const int st = (r >> 4) * 2 + (c >> 5), rr = r & 15, cc = c & 31, ob = rr * 64 + cc * 2; return st * 1024 + (ob ^ (((ob >> 9) & 1) << 5)); }
__host__ __device__ __forceinline__ void stage_rc(int b, int& R, int& C) { const int st = b / 1024, sb = b % 1024, swz = sb ^ (((sb >> 9) & 1) << 5); R = (st >> 1) * 16 + swz / 64; C = (st & 1) * 32 + (swz % 64) / 2; }
__host__ __device__ __forceinline__ int perm32(int rho) { const int n = rho >> 4, i = rho & 15; return 8 * (i >> 2) + 4 * n + (i & 3); }

struct Unit { int pm, pn; };
struct Gemm { const bf16_t* A; const bf16_t* Bt; int M, N, K; };

struct StaticOrder {
    int nM, nN, nwg, G, c;
    __host__ __device__ void init(int M, int N, int G_, int c_) { nM = M / BM; nN = N / BM; nwg = nM * nN; G = G_; c = c_; }
    __host__ __device__ bool next(int i, Unit& u) const {
        const long L = (long)i * G + c; if (L >= nwg) return false;
        int wgid = (int)L; { const int q = nwg / NXCD, r = nwg % NXCD, xcd = wgid % NXCD, off = wgid / NXCD; wgid = (xcd < r ? xcd * (q + 1) : r * (q + 1) + (xcd - r) * q) + off; }
        const int nig = WGM * nN, gid = wgid / nig, fm = gid * WGM, gsz = (nM - fm) < WGM ? (nM - fm) : WGM;
        u.pm = fm + ((wgid % nig) % gsz); u.pn = (wgid % nig) / gsz; return true;
    }
    __device__ __forceinline__ void a_ready(const Unit&) const {}
    __device__ __forceinline__ void done(const Unit&) const {}
};

__device__ __forceinline__ unsigned cvt_pk_bf16(float lo, float hi) { unsigned r; asm volatile("v_cvt_pk_bf16_f32 %0, %1, %2" : "=v"(r) : "v"(lo), "v"(hi)); return r; }
typedef float f32x2 __attribute__((ext_vector_type(2)));
__device__ __forceinline__ f32x2 gelu_pk(f32x2 v) {
    const f32x2 av = __builtin_elementwise_abs(v), d = av * 0.2316418882f + 1.0f;
    f32x2 t; t.x = __builtin_amdgcn_rcpf(d.x); t.y = __builtin_amdgcn_rcpf(d.y);
    f32x2 q = t * 0.5307027145f + (-0.7265760135f); q = q * t + 0.7107068705f; q = q * t + (-0.142248368f); q = q * t + 0.127414796f; q = q * t;
    const f32x2 s = (v * v) * (-0.72134752044f);
    f32x2 e; e.x = __builtin_amdgcn_exp2f(s.x); e.y = __builtin_amdgcn_exp2f(s.y);
    const f32x2 m = v * (q * e), r = v - m;
    f32x2 o; o.x = v.x < 0.f ? m.x : r.x; o.y = v.y < 0.f ? m.y : r.y; return o;
}

template <int ACT  > struct EpiBf16 {
    static constexpr bool PERM = true, AFTER_DRAIN = false; static_assert(ACT == 0 || ACT == 1, "EpiBf16: ACT is 0 (none) or 1 (gelu_pk)");
    bf16_t* O; int ldc; const float* bias; int split_cols; size_t split_stride; float scale0;
    __device__ __forceinline__ void operator()(const f32x4 (&acc)[2][2][4][2], const Unit& u, int wr, int wc, int fr, int fq) const {
        const int row0 = u.pm * BM + wr * 64 + fr; int colt = u.pn * BM; bf16_t* base = O;
        float sc = 1.f; if (split_cols) { const int t = colt / split_cols; base += (size_t)t * split_stride; colt -= t * split_cols; if (t == 0) sc = scale0; }
        const int col0 = colt + wc * 32 + 8 * fq, bcol0 = u.pn * BM + wc * 32 + 8 * fq;
        f32x4 bv[2][2];
#pragma unroll
        for (int bj = 0; bj < 2; ++bj)
#pragma unroll
            for (int n = 0; n < 2; ++n) bv[bj][n] = bias ? *(const f32x4*)(bias + bcol0 + bj * HALF + 4 * n) : (f32x4){0.f, 0.f, 0.f, 0.f};
#pragma unroll
        for (int ai = 0; ai < 2; ++ai)
#pragma unroll
            for (int m = 0; m < 4; ++m) { bf16_t* rowp = base + (size_t)(row0 + ai * HALF + m * 16) * ldc + col0;
#pragma unroll
                for (int bj = 0; bj < 2; ++bj) { f32x4 v0 = acc[ai][bj][m][0] + bv[bj][0], v1 = acc[ai][bj][m][1] + bv[bj][1];
                    if (ACT == 1) { f32x2 a = gelu_pk((f32x2){v0[0], v0[1]}), b = gelu_pk((f32x2){v0[2], v0[3]}), c = gelu_pk((f32x2){v1[0], v1[1]}), d = gelu_pk((f32x2){v1[2], v1[3]});
                        v0 = (f32x4){a.x, a.y, b.x, b.y}; v1 = (f32x4){c.x, c.y, d.x, d.y}; }
                    v0 = v0 * sc; v1 = v1 * sc; u32x4 w; w.x = cvt_pk_bf16(v0[0], v0[1]); w.y = cvt_pk_bf16(v0[2], v0[3]); w.z = cvt_pk_bf16(v1[0], v1[1]); w.w = cvt_pk_bf16(v1[2], v1[3]);
                    *(u32x4*)(rowp + bj * HALF) = w; } }
    }
};
struct EpiInProj {
    static constexpr bool PERM = true, AFTER_DRAIN = false;
    bf16_t* QKVG; const float* cs; const float* sn;
    __device__ __forceinline__ void operator()(const f32x4 (&acc)[2][2][4][2], const Unit& u, int wr, int wc, int fr, int fq) const {
        const int row0 = u.pm * BM + wr * 64 + fr;
        if (u.pn < 6) {
            bf16_t* dst = QKVG + (size_t)(u.pn >> 1) * ((size_t)16384 * 512);
            const int col0 = (u.pn & 1) * 256 + wc * 32 + 8 * fq;
            const bool rope_wave = (u.pn < 4) && ((wc & 1) == 0);
            const float sc = u.pn < 2 ? 0.125f * 1.4426950408889634f : 1.f;
#pragma unroll
            for (int ai = 0; ai < 2; ++ai)
#pragma unroll
                for (int m = 0; m < 4; ++m) { const int row = row0 + ai * HALF + m * 16;
                    f32x4 c0 = {1.f, 1.f, 1.f, 1.f}, c1 = c0, s0 = {0.f, 0.f, 0.f, 0.f}, s1 = s0;
                    if (rope_wave) { c0 = *(const f32x4*)(cs + (size_t)row * 8); c1 = *(const f32x4*)(cs + (size_t)row * 8 + 4); s0 = *(const f32x4*)(sn + (size_t)row * 8); s1 = *(const f32x4*)(sn + (size_t)row * 8 + 4); }
#pragma unroll
                    for (int bj = 0; bj < 2; ++bj) { f32x4 v0 = acc[ai][bj][m][0], v1 = acc[ai][bj][m][1];
                        if (rope_wave) { f32x4 p0, p1;
                            p0.x = __shfl_xor(v0.x, 16); p0.y = __shfl_xor(v0.y, 16); p0.z = __shfl_xor(v0.z, 16); p0.w = __shfl_xor(v0.w, 16);
                            p1.x = __shfl_xor(v1.x, 16); p1.y = __shfl_xor(v1.y, 16); p1.z = __shfl_xor(v1.z, 16); p1.w = __shfl_xor(v1.w, 16);
                            if (fq == 0) { v0 = v0 * c0 - p0 * s0; v1 = v1 * c1 - p1 * s1; }
                            else if (fq == 1) { v0 = v0 * c0 + p0 * s0; v1 = v1 * c1 + p1 * s1; } }
                        v0 = v0 * sc; v1 = v1 * sc; u32x4 w; w.x = cvt_pk_bf16(v0[0], v0[1]); w.y = cvt_pk_bf16(v0[2], v0[3]); w.z = cvt_pk_bf16(v1[0], v1[1]); w.w = cvt_pk_bf16(v1[2], v1[3]);
                        *(u32x4*)(dst + (size_t)row * 512 + col0 + bj * HALF) = w; } }
        } else {
            const int ch0 = (u.pn - 6) * 128 + wc * 32 + 8 * fq;
#pragma unroll
            for (int ai = 0; ai < 2; ++ai)
#pragma unroll
                for (int m = 0; m < 4; ++m) { const int row = row0 + ai * HALF + m * 16;
                    const f32x4 a0 = acc[ai][0][m][0], g0 = acc[ai][1][m][0], a1 = acc[ai][0][m][1], g1 = acc[ai][1][m][1];
#define GLU1(av, gv) ((av) * __builtin_amdgcn_rcpf(1.f + __expf(-(gv))))
                    u32x4 w; w.x = cvt_pk_bf16(GLU1(a0.x, g0.x), GLU1(a0.y, g0.y)); w.y = cvt_pk_bf16(GLU1(a0.z, g0.z), GLU1(a0.w, g0.w)); w.z = cvt_pk_bf16(GLU1(a1.x, g1.x), GLU1(a1.y, g1.y)); w.w = cvt_pk_bf16(GLU1(a1.z, g1.z), GLU1(a1.w, g1.w));
#undef GLU1
                    *(u32x4*)(QKVG + (size_t)3 * 16384 * 512 + (size_t)row * 512 + ch0) = w; }
        }
    }
};
struct EpiResid {
    static constexpr bool PERM = false, AFTER_DRAIN = false;
    const float* base; float* H;
    __device__ __forceinline__ void operator()(const f32x4 (&acc)[2][2][4][2], const Unit& u, int wr, int wc, int fr, int fq) const {
        const int row0 = u.pm * BM + wr * 64 + fr, col0 = u.pn * BM + wc * 32 + 4 * fq;
#pragma unroll
        for (int ai = 0; ai < 2; ++ai)
#pragma unroll
            for (int m = 0; m < 4; ++m) { const size_t ro = (size_t)(row0 + ai * HALF + m * 16) * 1024 + col0;
#pragma unroll
                for (int bj = 0; bj < 2; ++bj)
#pragma unroll
                    for (int n = 0; n < 2; ++n) { const size_t o = ro + bj * HALF + n * 16; *(f32x4*)(H + o) = *(const f32x4*)(base + o) + acc[ai][bj][m][n]; } }
    }
};
struct EpiPle {
    static constexpr bool PERM = false, AFTER_DRAIN = false;
    float* H; const bf16_t* PPO;
    __device__ __forceinline__ void operator()(const f32x4 (&acc)[2][2][4][2], const Unit& u, int wr, int wc, int fr, int fq) const {
        typedef unsigned u32x2 __attribute__((ext_vector_type(2)));
        const int row0 = u.pm * BM + wr * 64 + fr, col0 = u.pn * BM + wc * 32 + 4 * fq;
#pragma unroll
        for (int ai = 0; ai < 2; ++ai)
#pragma unroll
            for (int m = 0; m < 4; ++m) { const size_t ro = (size_t)(row0 + ai * HALF + m * 16) * 1024 + col0;
#pragma unroll
                for (int bj = 0; bj < 2; ++bj)
#pragma unroll
                    for (int n = 0; n < 2; ++n) { const size_t o = ro + bj * HALF + n * 16; const u32x2 pw = *(const u32x2*)(PPO + o); const f32x4 a = acc[ai][bj][m][n]; f32x4 h = *(const f32x4*)(H + o);
                        h[0] += __builtin_amdgcn_rcpf(1.f + __expf(-a[0])) * __uint_as_float(pw.x << 16); h[1] += __builtin_amdgcn_rcpf(1.f + __expf(-a[1])) * __uint_as_float(pw.x & 0xffff0000u);
                        h[2] += __builtin_amdgcn_rcpf(1.f + __expf(-a[2])) * __uint_as_float(pw.y << 16); h[3] += __builtin_amdgcn_rcpf(1.f + __expf(-a[3])) * __uint_as_float(pw.y & 0xffff0000u);
                        *(f32x4*)(H + o) = h; } }
    }
};
template <class Epi, class Sched, bool ALIGN_EPI = false, bool SP2 = false>
__device__ __forceinline__ void gemm_phase(PG8_LAS unsigned char* lds, const Gemm g, const Sched& S, const Epi& E) {
    int tid_ = threadIdx.x; asm volatile("" : "+v"(tid_));
    const int tid = tid_, wid = __builtin_amdgcn_readfirstlane(tid >> 6), lane = tid & 63, wr = wid >> 2, wc = wid & 3, fr = lane & 15, fq = lane >> 4;
    const int K = g.K, nt = K / BK;
    unsigned voffA[2], voffB[2];
#pragma unroll
    for (int i = 0; i < 2; ++i) { int R, C; stage_rc(tid * 16 + i * 8192, R, C); const int Rb = Epi::PERM ? ((R & ~31) + perm32(R & 31)) : R;
        voffA[i] = (unsigned)(R * K + C) * 2u; voffB[i] = (unsigned)(Rb * K + C) * 2u; }
    const size_t kstep = (size_t)(BK * 2);
    const size_t hstep = (size_t)HALF * K * 2;
    const size_t tstep = 2 * hstep;
    const unsigned ldsw = (unsigned)wid * 1024u;
    const int aoff = lds_byte(wr * 64 + fr, fq * 8), boff = lds_byte(wc * 32 + fr, fq * 8);
#define PG8_SA(b, h) (((b) * 2 + (h)) * HTB)
#define PG8_SB(b, h) ((4 + (b) * 2 + (h)) * HTB)
#define PG8_STAGE(bufoff, gbase, voff) do { _Pragma("unroll") for (int _i = 0; _i < 2; ++_i) \
        __builtin_amdgcn_global_load_lds((const unsigned*)((const char*)(gbase) + (voff)[_i]), (PG8_LAS unsigned*)(lds + (bufoff) + ldsw + _i * 8192), 16, 0, 0); } while (0)
#define PG8_LDA(dst, b, h) do { _Pragma("unroll") for (int m = 0; m < 4; ++m) _Pragma("unroll") for (int k = 0; k < 2; ++k) dst[m][k] = *(const PG8_LAS bf16x8*)(lds + PG8_SA(b, h) + aoff + m * 2048 + k * 1024); } while (0)
#define PG8_LDB(dst, b, h) do { _Pragma("unroll") for (int n = 0; n < 2; ++n) _Pragma("unroll") for (int k = 0; k < 2; ++k) dst[n][k] = *(const PG8_LAS bf16x8*)(lds + PG8_SB(b, h) + boff + n * 2048 + k * 1024); } while (0)
#define PG8_MMA(ai, bj, At, Bt) do { __builtin_amdgcn_s_setprio(1); _Pragma("unroll") for (int m = 0; m < 4; ++m) _Pragma("unroll") for (int n = 0; n < 2; ++n) _Pragma("unroll") for (int k = 0; k < 2; ++k) \
        acc[ai][bj][m][n] = __builtin_amdgcn_mfma_f32_16x16x32_bf16(Bt[n][k], At[m][k], acc[ai][bj][m][n], 0, 0, 0); __builtin_amdgcn_s_setprio(0); } while (0)
#define PG8_WAIT_V(n) asm volatile("s_waitcnt vmcnt(" #n ")" ::: "memory")
#define PG8_WAIT_L(n) asm volatile("s_waitcnt lgkmcnt(" #n ")" ::: "memory")
#define PG8_BAR __builtin_amdgcn_s_barrier()
#define PG8_SCHED __builtin_amdgcn_sched_barrier(0)
    Unit cur, nxt; int ui = 0;
    if (!S.next(0, cur)) return;
    f32x4 acc[2][2][4][2];
#pragma unroll
    for (int a = 0; a < 2; ++a)
#pragma unroll
        for (int b = 0; b < 2; ++b)
#pragma unroll
            for (int m = 0; m < 4; ++m)
#pragma unroll
                for (int n = 0; n < 2; ++n) acc[a][b][m][n] = (f32x4){0.f, 0.f, 0.f, 0.f};
    bf16x8 At[4][2], B0[2][2], B1[2][2];
    const char* cA = (const char*)g.A + (size_t)cur.pm * tstep; const char* cB = (const char*)g.Bt + (size_t)cur.pn * tstep;
    S.a_ready(cur);
    if constexpr (SP2) {
        PG8_STAGE(PG8_SB(0, 0), cB, voffB); PG8_STAGE(PG8_SB(0, 1), cB + hstep, voffB); PG8_STAGE(PG8_SA(0, 0), cA, voffA); PG8_STAGE(PG8_SA(0, 1), cA + hstep, voffA);
        if (wr == 1) PG8_BAR;
        PG8_WAIT_V(2); PG8_BAR;
        PG8_STAGE(PG8_SB(1, 0), cB + kstep, voffB); PG8_STAGE(PG8_SA(1, 0), cA + kstep, voffA); PG8_STAGE(PG8_SB(1, 1), cB + hstep + kstep, voffB);
        PG8_WAIT_V(6); PG8_BAR;
    } else {
        PG8_STAGE(PG8_SB(0, 0), cB, voffB); PG8_STAGE(PG8_SA(0, 0), cA, voffA); PG8_STAGE(PG8_SB(0, 1), cB + hstep, voffB); PG8_STAGE(PG8_SA(0, 1), cA + hstep, voffA);
        if (wr == 1) PG8_BAR;
        PG8_WAIT_V(4); PG8_BAR;
        PG8_STAGE(PG8_SB(1, 0), cB + kstep, voffB); PG8_STAGE(PG8_SA(1, 0), cA + kstep, voffA); PG8_STAGE(PG8_SB(1, 1), cB + hstep + kstep, voffB);
        PG8_WAIT_V(6); PG8_BAR;
    }
    for (;;) {
        const bool has_next = S.next(ui + 1, nxt);
        const char* nA = has_next ? (const char*)g.A + (size_t)nxt.pm * tstep : cA; const char* nB = has_next ? (const char*)g.Bt + (size_t)nxt.pn * tstep : cB;
        for (int t = 0; t < nt; t += 2) {
            const bool last = (t == nt - 2);
            const char* a1 = cA + (size_t)(t + 1) * kstep;
            const char* a2 = last ? nA : cA + (size_t)(t + 2) * kstep; const char* b2 = last ? nB : cB + (size_t)(t + 2) * kstep;
            const char* a3 = a2 + kstep; const char* b3 = b2 + kstep;
            if (last && has_next) S.a_ready(nxt);
            if constexpr (SP2) {
            PG8_LDB(B0, 0, 0); PG8_LDB(B1, 0, 1); PG8_SCHED; PG8_LDA(At, 0, 0); PG8_STAGE(PG8_SA(1, 1), a1 + hstep, voffA);
            PG8_WAIT_V(8); PG8_WAIT_L(0); PG8_BAR; PG8_MMA(0, 0, At, B0); PG8_MMA(0, 1, At, B1); PG8_BAR; PG8_SCHED;
            PG8_LDA(At, 0, 1); PG8_STAGE(PG8_SB(0, 0), b2, voffB); PG8_STAGE(PG8_SB(0, 1), b2 + hstep, voffB); PG8_STAGE(PG8_SA(0, 0), a2, voffA);
            PG8_WAIT_V(8); PG8_WAIT_L(0); PG8_BAR; PG8_MMA(1, 0, At, B0); PG8_MMA(1, 1, At, B1); PG8_BAR; PG8_SCHED;
            PG8_LDB(B0, 1, 0); PG8_LDB(B1, 1, 1); PG8_SCHED; PG8_LDA(At, 1, 0); PG8_STAGE(PG8_SA(0, 1), a2 + hstep, voffA);
            PG8_WAIT_V(8); PG8_WAIT_L(0); PG8_BAR; PG8_MMA(0, 0, At, B0); PG8_MMA(0, 1, At, B1); PG8_BAR; PG8_SCHED;
            PG8_LDA(At, 1, 1); PG8_STAGE(PG8_SB(1, 0), b3, voffB); PG8_STAGE(PG8_SB(1, 1), b3 + hstep, voffB); PG8_STAGE(PG8_SA(1, 0), a3, voffA);
            PG8_WAIT_V(8); PG8_WAIT_L(0); PG8_BAR; PG8_MMA(1, 0, At, B0); PG8_MMA(1, 1, At, B1); PG8_BAR; PG8_SCHED;
            } else {
            PG8_LDB(B0, 0, 0); PG8_SCHED; PG8_LDA(At, 0, 0); PG8_STAGE(PG8_SA(1, 1), a1 + hstep, voffA);
            PG8_WAIT_L(8); PG8_BAR; PG8_WAIT_L(0); PG8_MMA(0, 0, At, B0); PG8_BAR; PG8_SCHED;
            PG8_LDB(B1, 0, 1); PG8_STAGE(PG8_SB(0, 0), b2, voffB);
            PG8_BAR; PG8_WAIT_L(0); PG8_MMA(0, 1, At, B1); PG8_BAR;
            PG8_LDA(At, 0, 1); PG8_STAGE(PG8_SA(0, 0), a2, voffA);
            PG8_BAR; PG8_WAIT_L(0); PG8_MMA(1, 0, At, B0); PG8_BAR; PG8_SCHED;
            PG8_STAGE(PG8_SB(0, 1), b2 + hstep, voffB);
            PG8_WAIT_V(6); PG8_BAR; PG8_MMA(1, 1, At, B1); PG8_BAR;
            PG8_LDB(B0, 1, 0); PG8_SCHED; PG8_LDA(At, 1, 0); PG8_STAGE(PG8_SA(0, 1), a2 + hstep, voffA);
            PG8_WAIT_L(8); PG8_BAR; PG8_WAIT_L(0); PG8_MMA(0, 0, At, B0); PG8_BAR; PG8_SCHED;
            PG8_LDB(B1, 1, 1); PG8_STAGE(PG8_SB(1, 0), b3, voffB);
            PG8_BAR; PG8_WAIT_L(0); PG8_MMA(0, 1, At, B1); PG8_BAR;
            PG8_LDA(At, 1, 1); PG8_STAGE(PG8_SA(1, 0), a3, voffA);
            PG8_BAR; PG8_WAIT_L(0); PG8_MMA(1, 0, At, B0); PG8_BAR; PG8_SCHED;
            PG8_STAGE(PG8_SB(1, 1), b3 + hstep, voffB);
            PG8_WAIT_V(6); PG8_BAR; PG8_MMA(1, 1, At, B1); PG8_BAR;
            }
        }
        if constexpr (ALIGN_EPI) { if (wr == 0) PG8_BAR; }
        if constexpr (!Epi::AFTER_DRAIN) { E(acc, cur, wr, wc, fr, fq); S.done(cur); }
        if (!has_next) break;
#pragma unroll
        for (int a = 0; a < 2; ++a)
#pragma unroll
            for (int b = 0; b < 2; ++b)
#pragma unroll
                for (int m = 0; m < 4; ++m)
#pragma unroll
                    for (int n = 0; n < 2; ++n) acc[a][b][m][n] = (f32x4){0.f, 0.f, 0.f, 0.f};
        cur = nxt; cA = nA; cB = nB; ++ui;
        if constexpr (ALIGN_EPI) { if (wr == 1) PG8_BAR; }
    }
    PG8_WAIT_V(0);
    if constexpr (!ALIGN_EPI) { if (wr == 0) PG8_BAR; }
    PG8_BAR;
    if constexpr (Epi::AFTER_DRAIN) { E.fused(acc, cur, wr, wc, fr, fq, lds, wid, lane); S.done(cur); }
#undef PG8_SA
#undef PG8_SB
#undef PG8_STAGE
#undef PG8_LDA
#undef PG8_LDB
#undef PG8_MMA
#undef PG8_WAIT_V
#undef PG8_WAIT_L
#undef PG8_BAR
#undef PG8_SCHED
}
}
#define GAS __attribute__((address_space(1)))
#define LAS __attribute__((address_space(3)))
typedef short bf16x8 __attribute__((ext_vector_type(8)));
typedef GAS unsigned gu32;
typedef GAS unsigned long long gu64;
#define RLX_AGENT __ATOMIC_RELAXED, __HIP_MEMORY_SCOPE_AGENT
#define LDS_WAIT() asm volatile("s_waitcnt lgkmcnt(0)" ::: "memory")
#define VM_WAIT() asm volatile("s_waitcnt vmcnt(0)" ::: "memory")
__device__ __forceinline__ unsigned long long rt() { return __builtin_amdgcn_s_memrealtime(); }

#define XB_TMO      128
#define XB_XCNT(j)  (256  + 64 * (j))
#define XB_XSUB(j)  (1280 + 64 * (j))
#define XB_XGEN(j)  (2304 + 64 * (j))
#define XB_TOP      3328
#define XB_TOPGEN   3392
#define XCD_BAR_WORDS 3456
#define XB_SPIN_CAP (1u << 18)

__device__ __forceinline__ unsigned xb_ld(unsigned* p)              { return __hip_atomic_load(p, __ATOMIC_RELAXED, __HIP_MEMORY_SCOPE_AGENT); }
__device__ __forceinline__ unsigned xb_add(unsigned* p, unsigned v) { return __hip_atomic_fetch_add(p, v, __ATOMIC_RELAXED, __HIP_MEMORY_SCOPE_AGENT); }
__device__ __forceinline__ unsigned xb_xcc_id() { return (unsigned)__builtin_amdgcn_s_getreg((3 << 11) | 20) & 0xFu; }
#define XB_SPIN(cond, bar) do { unsigned _sp = 0; while (cond) { __builtin_amdgcn_s_sleep(1); \
    if ((++_sp & 255u) == 0u) { if (xb_ld(&(bar)[XB_TMO])) break; if (_sp > XB_SPIN_CAP) { atomicAdd(&(bar)[XB_TMO], 1u); break; } } } } while (0)

struct XcdBarrier {
    unsigned* bar; unsigned x;
    volatile LAS unsigned* st;
};

__device__ __forceinline__ XcdBarrier xcd_barrier_post(unsigned* bar, volatile LAS unsigned* st) {
    XcdBarrier b; b.bar = bar; b.x = xb_xcc_id(); b.st = st;
    if (threadIdx.x == 0) (void)xb_add(&bar[XB_XCNT(b.x)], 1u);
    return b;
}
__device__ __forceinline__ void xcd_barrier_complete(unsigned* bar, unsigned x, unsigned& nloc, unsigned& nx) {
    const unsigned G = gridDim.x * gridDim.y * gridDim.z;
    unsigned sum, cnt, mine, sp = 0u;
    for (;;) {
        sum = 0u; cnt = 0u; mine = 0u;
#pragma unroll
        for (unsigned j = 0; j < 16; ++j) { const unsigned c = xb_ld(&bar[XB_XCNT(j)]); sum += c; cnt += (c > 0u) ? 1u : 0u; mine = (j == x) ? c : mine; }
        if (sum == G) break;
        __builtin_amdgcn_s_sleep(1);
        if ((++sp & 255u) == 0u) { if (xb_ld(&bar[XB_TMO])) break; if (sp > XB_SPIN_CAP) { atomicAdd(&bar[XB_TMO], 1u); break; } }
    }
    nloc = mine > 0u ? mine : 1u; nx = cnt > 0u ? cnt : 1u;
}

__device__ __forceinline__ void xcd_barrier(const XcdBarrier& b) {
    asm volatile("s_waitcnt vmcnt(0)" ::: "memory");
    __syncthreads();
    if (threadIdx.x == 0) {
        unsigned* bar = b.bar;
        __builtin_amdgcn_s_waitcnt(0);
        unsigned nloc = b.st[0], nx = b.st[1];
        if (nloc == 0u) { xcd_barrier_complete(bar, b.x, nloc, nx); b.st[0] = nloc; b.st[1] = nx; }
        const unsigned old = xb_add(&bar[XB_XSUB(b.x)], 1u);
        const unsigned gen = old / nloc;
        if (old + 1u == (gen + 1u) * nloc) {
            __builtin_amdgcn_fence(__ATOMIC_RELEASE, "agent");
            asm volatile("s_waitcnt vmcnt(0)" ::: "memory");
            const unsigned og = xb_add(&bar[XB_TOP], 1u);
            const unsigned tg = og / nx;
            if (og + 1u == (tg + 1u) * nx) xb_add(&bar[XB_TOPGEN], 1u);
            else XB_SPIN(xb_ld(&bar[XB_TOPGEN]) == tg, bar);
            __builtin_amdgcn_fence(__ATOMIC_ACQUIRE, "agent");
            xb_add(&bar[XB_XGEN(b.x)], 1u);
            asm volatile("s_waitcnt vmcnt(0)" ::: "memory");
        } else {
            XB_SPIN(xb_ld(&bar[XB_XGEN(b.x)]) == gen, bar);
            __builtin_amdgcn_fence(__ATOMIC_ACQUIRE, "agent");
            asm volatile("s_waitcnt vmcnt(0)" ::: "memory");
        }
    }
    __syncthreads();
}
namespace att {
typedef short s16x8 __attribute__((ext_vector_type(8)));
typedef short s16x4 __attribute__((ext_vector_type(4)));
constexpr int PITCH = 144;
constexpr int KOFF = 0, VOFF = 256 * PITCH;
typedef float f32x2_t __attribute__((ext_vector_type(2))); typedef __bf16 bf16x2_t __attribute__((ext_vector_type(2)));
__device__ __forceinline__ unsigned cvtpk(float lo, float hi) { f32x2_t v = {lo, hi}; bf16x2_t b = __builtin_convertvector(v, bf16x2_t); return __builtin_bit_cast(unsigned, b); }

struct QState { s16x8 q0, q1; f32x4 o[4]; float m, l; };

__device__ __forceinline__ void tile(QState& S, const s16x8 k0, const s16x8 k1, const s16x4 (&vf)[4], int base, int dq, unsigned limB, unsigned limC) {
    f32x4 s = {0.f, 0.f, 0.f, 0.f};
    s = __builtin_amdgcn_mfma_f32_16x16x32_bf16(k0, S.q0, s, 0, 0, 0);
    s = __builtin_amdgcn_mfma_f32_16x16x32_bf16(k1, S.q1, s, 0, 0, 0);
    float wf[4], sm[4];
#pragma unroll
    for (int j = 0; j < 4; ++j) { const unsigned ud = (unsigned)(base + dq - 16 * j); const int w = (ud < 129u ? 1 : 0) + (ud < limB ? 1 : 0) + (ud < limC ? 1 : 0);
        wf[j] = (float)w; sm[j] = w ? s[j] : -1.0e30f; }
    float tm = fmaxf(fmaxf(sm[0], sm[1]), fmaxf(sm[2], sm[3]));
    tm = fmaxf(tm, __shfl_xor(tm, 16)); tm = fmaxf(tm, __shfl_xor(tm, 32));
    const float mn = fmaxf(S.m, tm), al = __builtin_amdgcn_exp2f(S.m - mn); S.m = mn;
    float p[4], ps = 0.f;
#pragma unroll
    for (int j = 0; j < 4; ++j) { p[j] = wf[j] * __builtin_amdgcn_exp2f(sm[j] - mn); ps += p[j]; }
    S.l = S.l * al + ps;
    typedef unsigned u32x2 __attribute__((ext_vector_type(2)));
    u32x2 pw; pw.x = cvtpk(p[0], p[1]); pw.y = cvtpk(p[2], p[3]);
    const s16x4 pb = __builtin_bit_cast(s16x4, pw);
#pragma unroll
    for (int dt = 0; dt < 4; ++dt) { S.o[dt] = S.o[dt] * al; S.o[dt] = __builtin_amdgcn_mfma_f32_16x16x16bf16_1k(vf[dt], pb, S.o[dt], 0, 0, 0); }
}

__device__ __forceinline__ void phase(LAS unsigned char* lds, const bf16* Q, const bf16* Kb, const bf16* Vb, bf16* ATT, int vcu, int G) {
    int tid_ = threadIdx.x; asm volatile("" : "+v"(tid_));
    const int tid = tid_, lane = tid & 63, wave = __builtin_amdgcn_readfirstlane(tid >> 6), g = lane >> 4, i16 = lane & 15;
    const int klane = i16 * PITCH + 16 * g, vlane = (4 * g + (i16 >> 2)) * PITCH + 8 * (i16 & 3), dq = 16 * (i16 - 4 * g);
    for (int un = vcu; un < BATCH * NH * (SEQ / 256); un += G) {
        const int bh = un & 15, qblk = un >> 4, b = bh >> 3, h = bh & 7, t0 = qblk * 256;
        const bf16* Kg = Kb + (size_t)b * SEQ * 512 + h * 64; const bf16* Vg = Vb + (size_t)b * SEQ * 512 + h * 64;
        QState SA, SB; const int rA = 2 * wave, rB = 2 * wave + 1;
        { const bf16* qa = Q + ((size_t)b * SEQ + t0 + rA + 16 * i16) * 512 + h * 64 + 8 * g; SA.q0 = *(const s16x8*)qa; SA.q1 = *(const s16x8*)(qa + 32);
          const bf16* qb = qa + 512; SB.q0 = *(const s16x8*)qb; SB.q1 = *(const s16x8*)(qb + 32); }
#pragma unroll
        for (int dt = 0; dt < 4; ++dt) { SA.o[dt] = (f32x4){0.f, 0.f, 0.f, 0.f}; SB.o[dt] = (f32x4){0.f, 0.f, 0.f, 0.f}; }
        SA.m = -1.0e30f; SB.m = -1.0e30f; SA.l = 0.f; SB.l = 0.f;
        const int jc0 = qblk >= 8 ? 0 : 8 - qblk;
        v4u st[8];
#define ATT_LOAD(jc) do { const int c0_ = t0 - 2048 + 256 * (jc); _Pragma("unroll") for (int i_ = 0; i_ < 4; ++i_) { const int p_ = tid + 512 * i_; const size_t go_ = (size_t)(c0_ + (p_ >> 3)) * 512 + 8 * (p_ & 7); \
            st[i_] = *(const v4u*)(Kg + go_); st[4 + i_] = *(const v4u*)(Vg + go_); } } while (0)
#define ATT_STORE() do { _Pragma("unroll") for (int i_ = 0; i_ < 4; ++i_) { const int p_ = tid + 512 * i_, pos_ = p_ >> 3; const int off_ = ((pos_ & 15) * 16 + (pos_ >> 4)) * PITCH + 16 * (p_ & 7); \
            *(LAS v4u*)(lds + KOFF + off_) = st[i_]; *(LAS v4u*)(lds + VOFF + off_) = st[4 + i_]; } } while (0)
        ATT_LOAD(jc0); ATT_STORE();
        __syncthreads();
        for (int jc = jc0; jc <= 8; ++jc) {
            if (jc < 8) ATT_LOAD(jc + 1);
            const int D0 = 256 * (8 - jc);
            for (int rho = 0; rho < 16; ++rho) {
                const bool nA = (jc >= 7) || (rho == rA) || (jc == 6 && ((rA - rho) & 3) == 0);
                const bool nB = (jc >= 7) || (rho == rB) || (jc == 6 && ((rB - rho) & 3) == 0);
                if (!(nA || nB)) continue;
                const LAS unsigned char* kp = lds + KOFF + rho * (16 * PITCH) + klane; const LAS unsigned char* vp = lds + VOFF + rho * (16 * PITCH) + vlane;
                const s16x8 k0 = *(const LAS s16x8*)kp, k1 = *(const LAS s16x8*)(kp + 64);
                s16x4 vf[4];
#pragma unroll
                for (int dt = 0; dt < 4; ++dt) vf[dt] = __builtin_amdgcn_ds_read_tr16_b64_v4i16((LAS s16x4*)(vp + 32 * dt));
                if (nA) tile(SA, k0, k1, vf, D0 + rA - rho, dq, ((rA - rho) & 3) == 0 ? 513u : 0u, rho == rA ? 2049u : 0u);
                if (nB) tile(SB, k0, k1, vf, D0 + rB - rho, dq, ((rB - rho) & 3) == 0 ? 513u : 0u, rho == rB ? 2049u : 0u);
            }
            __syncthreads();
            if (jc < 8) { ATT_STORE(); }
            __syncthreads();
        }
#undef ATT_LOAD
#undef ATT_STORE
        typedef unsigned u32x2 __attribute__((ext_vector_type(2)));
        { float l = SA.l; l += __shfl_xor(l, 16); l += __shfl_xor(l, 32); const float inv = 1.f / l; bf16* op = ATT + ((size_t)b * SEQ + t0 + rA + 16 * i16) * 512 + h * 64 + 4 * g;
#pragma unroll
          for (int dt = 0; dt < 4; ++dt) { u32x2 w; w.x = cvtpk(SA.o[dt][0] * inv, SA.o[dt][1] * inv); w.y = cvtpk(SA.o[dt][2] * inv, SA.o[dt][3] * inv); *(u32x2*)(op + 16 * dt) = w; } }
        { float l = SB.l; l += __shfl_xor(l, 16); l += __shfl_xor(l, 32); const float inv = 1.f / l; bf16* op = ATT + ((size_t)b * SEQ + t0 + rB + 16 * i16) * 512 + h * 64 + 4 * g;
#pragma unroll
          for (int dt = 0; dt < 4; ++dt) { u32x2 w; w.x = cvtpk(SB.o[dt][0] * inv, SB.o[dt][1] * inv); w.y = cvtpk(SB.o[dt][2] * inv, SB.o[dt][3] * inv); *(u32x2*)(op + 16 * dt) = w; } }
    }
}
}
#ifndef PH_MASK
#define PH_MASK 0xFFFu
#endif
constexpr int NWAVES = 8;
constexpr int RING_OFF = 0, RING_BYTES = 131072;
constexpr int LDSCTL_OFF = RING_BYTES, MISC_OFF = LDSCTL_OFF + 320;
constexpr int LDS_BYTES = 147456;
constexpr int CW_BAR = 4096;

struct Params {
    const float *x, *p; const int* pos; const float *norm_mix, *w_in, *conv_w, *conv_b, *ln_g, *ln_b, *g_att, *g_conv, *w_out, *norm_ffn, *wq, *keys, *eu, *ev, *norm_ple, *wg, *wp, *fin;
    float* out; unsigned char* ws; float freq[8];
};

__device__ __forceinline__ void transpose_item(const float* W, int K, int NW, bf16* WT, int n_dst0, int n_src0, int k0, LAS float* scr, int lane) {
#pragma unroll 8
    for (int i = 0; i < 32; ++i) { const int kk = 2 * i + (lane >> 5); scr[kk * 33 + (lane & 31)] = W[(size_t)(k0 + kk) * NW + n_src0 + (lane & 31)]; }
    LDS_WAIT(); asm volatile("" ::: "memory");
    const int c = lane & 7;
#pragma unroll
    for (int j = 0; j < 4; ++j) { const int n = (lane >> 3) + 8 * j; const LAS float* s = scr + (8 * c) * 33 + n;
        v4u o; o.x = pk2(s[0 * 33], s[1 * 33]); o.y = pk2(s[2 * 33], s[3 * 33]); o.z = pk2(s[4 * 33], s[5 * 33]); o.w = pk2(s[6 * 33], s[7 * 33]);
        *(v4u*)(WT + (size_t)(n_dst0 + n) * K + k0 + 8 * c) = o; }
    LDS_WAIT(); asm volatile("" ::: "memory");
}

__global__ void __launch_bounds__(NWAVES * 64, 2) mega(Params a) {
    extern __shared__ __attribute__((aligned(16))) unsigned char lds_raw[];
    LAS unsigned char* lds = (LAS unsigned char*)lds_raw;
    volatile LAS unsigned* MISC = (volatile LAS unsigned*)(lds + MISC_OFF);
    const int tid = threadIdx.x, lane = tid & 63, wave = __builtin_amdgcn_readfirstlane(tid >> 6);
    const int G = gridDim.x, bx = blockIdx.x, vcu = (G % 8 == 0) ? (bx % 8) * (G / 8) + bx / 8 : bx;
    const int gw = vcu * NWAVES + wave, NGW = G * NWAVES, gt = vcu * (NWAVES * 64) + tid, NGT = G * NWAVES * 64;
    unsigned* ctl = (unsigned*)(a.ws + WS_CTL);
#define H ((float*)a.out)
#define cs ((float*)(a.ws + WS_ROPE))
#define sn ((float*)(a.ws + WS_ROPE) + NTOK * 8)
#define WIN ((bf16*)(a.ws + WS_WIN))
#define WOUT ((bf16*)(a.ws + WS_WOUT))
#define WQK ((bf16*)(a.ws + WS_WQK))
#define WG ((bf16*)(a.ws + WS_WG))
#define WP ((bf16*)(a.ws + WS_WP))
#define U ((bf16*)(a.ws + WS_U))
#define V ((bf16*)(a.ws + WS_V))
#define XN ((bf16*)(a.ws + WS_XN))
#define Q ((bf16*)(a.ws + WS_Q))
#define Kb ((bf16*)(a.ws + WS_K))
#define Vb ((bf16*)(a.ws + WS_VV))
#define GLU ((bf16*)(a.ws + WS_GLU))
#define SC ((bf16*)(a.ws + WS_SC))
#define ATT ((bf16*)(a.ws + WS_ATT))
#define Y ((bf16*)(a.ws + WS_Y))
#define EID ((int*)(a.ws + WS_EID))
#define GATE ((float*)(a.ws + WS_GATE))
#define PP ((bf16*)(a.ws + WS_PP))

    for (int u = tid; u < (LDS_BYTES - LDSCTL_OFF) / 4; u += NWAVES * 64) ((LAS unsigned*)(lds + LDSCTL_OFF))[u] = 0u;
    __syncthreads();
    XcdBarrier bar = xcd_barrier_post(ctl + CW_BAR, MISC + 8);

    if (PH_MASK & (1u << 0)) {
    {
        LAS float* scr = (LAS float*)(lds + RING_OFF + wave * 16384);
        constexpr int I_IN = (DM / 64) * (DIN / 32), I_SQ = (DM / 64) * (DM / 32), I_WP = (PLE / 64) * (DM / 32);
        for (int it = gw; it < I_IN + 2 * I_SQ + I_WP; it += NGW) {
            int r = it;
            if (r < I_IN) { const int nb = r % (DIN / 32), kb = r / (DIN / 32); transpose_item(a.w_in, DM, DIN, WIN, 32 * nb, nv::win_srccol(32 * nb), 64 * kb, scr, lane); continue; } r -= I_IN;
            if (r < I_SQ) { const int nb = r % (DM / 32), kb = r / (DM / 32); transpose_item(a.w_out, DM, DM, WOUT, 32 * nb, 32 * nb, 64 * kb, scr, lane); continue; } r -= I_SQ;
            if (r < I_SQ) { const int nb = r % (DM / 32), kb = r / (DM / 32); transpose_item(a.wg, DM, DM, WG, 32 * nb, 32 * nb, 64 * kb, scr, lane); continue; } r -= I_SQ;
            { const int nb = r % (DM / 32), kb = r / (DM / 32); transpose_item(a.wp, PLE, DM, WP, 32 * nb, 32 * nb, 64 * kb, scr, lane); }
        }
        for (int i = gt; i < 2048 * 1024; i += NGT) { const int n = i >> 10, d = i & 1023, hp = n >> 7, kk = n & 127, p = hp & 1;
            const float* w = a.wq + (size_t)d * 2048 + hp * 128; const float* kr = a.keys + ((size_t)p * 128 + kk) * 128; float s = 0.f;
            for (int c = 0; c < 128; c += 4) { const f32x4 wv = *(const f32x4*)(w + c), kv = *(const f32x4*)(kr + c); s += wv.x * kv.x + wv.y * kv.y + wv.z * kv.z + wv.w * kv.w; }
            WQK[i] = (bf16)f2bf(s); }
        for (size_t i = gt; i < (size_t)NEXP * DM / 8; i += NGT) { const f32x4 u0 = ((const f32x4*)a.eu)[2 * i], u1 = ((const f32x4*)a.eu)[2 * i + 1], v0 = ((const f32x4*)a.ev)[2 * i], v1 = ((const f32x4*)a.ev)[2 * i + 1];
            v4u o; o.x = pk2(u0.x, u0.y); o.y = pk2(u0.z, u0.w); o.z = pk2(u1.x, u1.y); o.w = pk2(u1.z, u1.w); ((v4u*)U)[i] = o;
            o.x = pk2(v0.x, v0.y); o.y = pk2(v0.z, v0.w); o.z = pk2(v1.x, v1.y); o.w = pk2(v1.z, v1.w); ((v4u*)V)[i] = o; }
        for (size_t i = gt; i < (size_t)NTOK * PLE / 8; i += NGT) { const f32x4 u0 = ((const f32x4*)a.p)[2 * i], u1 = ((const f32x4*)a.p)[2 * i + 1];
            v4u o; o.x = pk2(u0.x, u0.y); o.y = pk2(u0.z, u0.w); o.z = pk2(u1.x, u1.y); o.w = pk2(u1.z, u1.w); ((v4u*)PP)[i] = o; }
        for (int i = gt; i < NTOK * 8; i += NGT) { const float ang = (float)a.pos[i >> 3] * a.freq[i & 7]; cs[i] = cosf(ang); sn[i] = sinf(ang); }
        for (int r = gw; r < NTOK; r += NGW) nv::rms_row<false>(r, lane, a.x, a.norm_mix, XN);
    }
    }
    xcd_barrier(bar);
    if (PH_MASK & (1u << 1)) {
    { pg8::Gemm g{XN, WIN, NTOK, DIN, DM}; pg8::StaticOrder S; S.init(NTOK, DIN, G, bx); pg8::EpiInProj E{Q, cs, sn};
      pg8::gemm_phase<pg8::EpiInProj, pg8::StaticOrder, true, true>(lds + RING_OFF, g, S, E); }
    }
    xcd_barrier(bar);
    if (PH_MASK & (1u << 2)) {
    att::phase(lds, Q, Kb, Vb, ATT, vcu, G);
    }
    xcd_barrier(bar);
    if (PH_MASK & (1u << 3)) {
    for (int t = gw; t < NTOK; t += NGW) nv::mix_token(t, lane, GLU, ATT, a.conv_w, a.conv_b, a.ln_g, a.ln_b, a.g_att, a.g_conv, Y);
    }
    xcd_barrier(bar);
    if (PH_MASK & (1u << 4)) {
    { pg8::Gemm g{Y, WOUT, NTOK, DM, DM}; pg8::StaticOrder S; S.init(NTOK, DM, G, bx); pg8::EpiResid E{a.x, H};
      pg8::gemm_phase<pg8::EpiResid, pg8::StaticOrder, false, true>(lds + RING_OFF, g, S, E); }
    }
    xcd_barrier(bar);
    if (PH_MASK & (1u << 5)) {
    for (int r = gw; r < NTOK; r += NGW) nv::rms_row<false>(r, lane, H, a.norm_ffn, XN);
    }
    xcd_barrier(bar);
    if (PH_MASK & (1u << 6)) {
    { pg8::Gemm g{XN, WQK, NTOK, 2048, DM}; pg8::StaticOrder S; S.init(NTOK, 2048, G, bx); pg8::EpiBf16<0> E{SC, 2048, nullptr, 0, 0, 1.f};
      pg8::gemm_phase<pg8::EpiBf16<0>, pg8::StaticOrder, true, true>(lds + RING_OFF, g, S, E); }
    }
    xcd_barrier(bar);
    if (PH_MASK & (1u << 7)) {
    for (int i = gt; i < NTOK * PH; i += NGT) nv::topk_item(i, SC, EID, GATE);
    }
    xcd_barrier(bar);
    if (PH_MASK & (1u << 8)) {
    for (int t = gw; t < NTOK; t += NGW) nv::peer_token(t, lane, XN, U, V, EID, GATE, H);
    }
    xcd_barrier(bar);
    if (PH_MASK & (1u << 9)) {
    for (int r = gw; r < NTOK; r += NGW) nv::rms_row<false>(r, lane, H, a.norm_ple, XN);
    }
    xcd_barrier(bar);
    if (PH_MASK & (1u << 10)) {
    { pg8::Gemm g{PP, WP, NTOK, DM, PLE}; pg8::StaticOrder S; S.init(NTOK, DM, G, bx); pg8::EpiBf16<0> E{Y, DM, nullptr, 0, 0, 1.f};
      pg8::gemm_phase<pg8::EpiBf16<0>, pg8::StaticOrder, false, true>(lds + RING_OFF, g, S, E); }
    VM_WAIT(); __syncthreads();
    { pg8::Gemm g{XN, WG, NTOK, DM, DM}; pg8::StaticOrder S; S.init(NTOK, DM, G, bx); pg8::EpiPle E{H, Y};
      pg8::gemm_phase<pg8::EpiPle, pg8::StaticOrder, false, true>(lds + RING_OFF, g, S, E); }
    }
    xcd_barrier(bar);
    if (PH_MASK & (1u << 11)) {
    for (int r = gw; r < NTOK; r += NGW) nv::rms_row<true>(r, lane, H, a.fin, H);
    }
#undef H
#undef cs
#undef sn
#undef WIN
#undef WOUT
#undef WQK
#undef WG
#undef WP
#undef U
#undef V
#undef XN
#undef Q
#undef Kb
#undef Vb
#undef GLU
#undef SC
#undef ATT
#undef Y
#undef EID
#undef GATE
#undef PP
}

extern "C" void kernel_launch(void* const* d_in, const int* in_sizes, int n_in, void* d_out, int out_size, void* d_ws, size_t ws_size, hipStream_t stream) {
    static int grid = 0;
    if (grid == 0) {
        if (n_in != 21 || out_size != NTOK * DM || ws_size < WS_END) { fprintf(stderr, "kernel_launch: unexpected shapes n_in %d out %d ws %zu\n", n_in, out_size, ws_size); grid = -1; return; }
        int dev = 0, cus = 0, per_cu = 0;
        if (hipGetDevice(&dev) != hipSuccess || hipDeviceGetAttribute(&cus, hipDeviceAttributeMultiprocessorCount, dev) != hipSuccess) { grid = -1; return; }
        if (hipFuncSetAttribute((const void*)mega, hipFuncAttributeMaxDynamicSharedMemorySize, LDS_BYTES) != hipSuccess) { fprintf(stderr, "kernel_launch: hipFuncSetAttribute failed\n"); grid = -1; return; }
        if (hipOccupancyMaxActiveBlocksPerMultiprocessor(&per_cu, (const void*)mega, NWAVES * 64, LDS_BYTES) != hipSuccess || per_cu < 1) { fprintf(stderr, "kernel_launch: occupancy query says %d\n", per_cu); }
        (void)hipGetLastError();
        grid = cus;
    }
    if (grid < 0) return;
    (void)hipMemsetAsync((char*)d_ws + WS_CTL, 0, 1 * MiB, stream);
    Params a{};
    a.x = (const float*)d_in[0]; a.p = (const float*)d_in[1]; a.pos = (const int*)d_in[2]; a.norm_mix = (const float*)d_in[3]; a.w_in = (const float*)d_in[4]; a.conv_w = (const float*)d_in[5];
    a.conv_b = (const float*)d_in[6]; a.ln_g = (const float*)d_in[7]; a.ln_b = (const float*)d_in[8]; a.g_att = (const float*)d_in[9]; a.g_conv = (const float*)d_in[10]; a.w_out = (const float*)d_in[11];
    a.norm_ffn = (const float*)d_in[12]; a.wq = (const float*)d_in[13]; a.keys = (const float*)d_in[14]; a.eu = (const float*)d_in[15]; a.ev = (const float*)d_in[16]; a.norm_ple = (const float*)d_in[17];
    a.wg = (const float*)d_in[18]; a.wp = (const float*)d_in[19]; a.fin = (const float*)d_in[20]; a.out = (float*)d_out; a.ws = (unsigned char*)d_ws;
    for (int i = 0; i < 8; ++i) a.freq[i] = (float)pow(500000.0, -(double)i / 8.0);
    hipLaunchKernelGGL(mega, dim3(grid), dim3(NWAVES * 64), LDS_BYTES, stream, a);
}
```

```cpp
#include <hip/hip_runtime.h>
#include <cstdio>
#include <cstdint>
#include <cmath>

constexpr int BATCH = 2, SEQ = 8192, DM = 1024, NTOK = BATCH * SEQ;
constexpr int PLE = 256, HD = 64, NH = 8, DATT = 512, DCONV = 512, DIN = 2560, CW = 31;
constexpr int NKEYS = 128, NEXP = 16384, PH = 8, TOPK = 16, HK = PH * TOPK;
constexpr float EPS = 1e-6f;
constexpr float QSCALE = 0.125f * 1.4426950408889634f;

typedef unsigned short bf16;
typedef unsigned v4u __attribute__((ext_vector_type(4)));
typedef unsigned v2u __attribute__((ext_vector_type(2)));
typedef float f32x4 __attribute__((ext_vector_type(4)));

constexpr size_t MiB = 1u << 20;
constexpr size_t WS_CTL = 0;
constexpr size_t WS_ROPE = 1 * MiB;
constexpr size_t WS_WIN = 2 * MiB;
constexpr size_t WS_WOUT = 7 * MiB;
constexpr size_t WS_WQK = 9 * MiB;
constexpr size_t WS_WG = 13 * MiB;
constexpr size_t WS_WP = 15 * MiB;
constexpr size_t WS_U = 16 * MiB;
constexpr size_t WS_V = 48 * MiB;
constexpr size_t WS_XN = 80 * MiB;
constexpr size_t WS_Q = 112 * MiB, WS_K = 128 * MiB, WS_VV = 144 * MiB, WS_GLU = 160 * MiB;
constexpr size_t WS_SC = 112 * MiB;
constexpr size_t WS_ATT = 176 * MiB;
constexpr size_t WS_Y = 192 * MiB;
constexpr size_t WS_EID = 224 * MiB;
constexpr size_t WS_GATE = 232 * MiB;
constexpr size_t WS_PP = 240 * MiB;
constexpr size_t WS_MISC = 248 * MiB;
constexpr size_t WS_END = 256 * MiB;

__device__ __forceinline__ unsigned f2bf(float f) { unsigned u = __float_as_uint(f); return (u + 0x7fffu + ((u >> 16) & 1u)) >> 16; }
__device__ __forceinline__ float bf2f(unsigned h) { return __uint_as_float(h << 16); }
__device__ __forceinline__ unsigned pk2(float lo, float hi) { return f2bf(lo) | (f2bf(hi) << 16); }
__device__ __forceinline__ float bflo(unsigned w) { return __uint_as_float(w << 16); }
__device__ __forceinline__ float bfhi(unsigned w) { return __uint_as_float(w & 0xffff0000u); }
__device__ __forceinline__ float wave_sum(float v) {
#pragma unroll
    for (int o = 1; o < 64; o <<= 1) v += __shfl_xor(v, o);
    return v;
}
__device__ __forceinline__ float sigmoidf_(float x) { return 1.f / (1.f + __expf(-x)); }
__device__ __forceinline__ float gelu_erf(float x) { return 0.5f * x * (1.f + erff(x * 0.70710678118654752f)); }

__device__ __forceinline__ unsigned f2key(float f) { unsigned u = __float_as_uint(f); return (u & 0x80000000u) ? ~u : (u | 0x80000000u); }
__device__ __forceinline__ float key2f(unsigned k) { unsigned u = (k & 0x80000000u) ? (k & 0x7fffffffu) : ~k; return __uint_as_float(u); }
__device__ __forceinline__ void ins16(unsigned (&L)[16], unsigned x) {
#pragma unroll
    for (int i = 0; i < 16; ++i) { const unsigned h = L[i] > x ? L[i] : x; x = L[i] > x ? x : L[i]; L[i] = h; }
}
#define INS16(L, xx) ins16(L, (xx))
__device__ __forceinline__ int sel16(const int (&a)[16], int i) {
    int v0 = a[0], v1 = a[1], v2 = a[2], v3 = a[3], v4 = a[4], v5 = a[5], v6 = a[6], v7 = a[7], v8 = a[8], v9 = a[9], v10 = a[10], v11 = a[11], v12 = a[12], v13 = a[13], v14 = a[14], v15 = a[15];
    asm volatile("" : "+v"(v0), "+v"(v1), "+v"(v2), "+v"(v3), "+v"(v4), "+v"(v5), "+v"(v6), "+v"(v7));
    asm volatile("" : "+v"(v8), "+v"(v9), "+v"(v10), "+v"(v11), "+v"(v12), "+v"(v13), "+v"(v14), "+v"(v15));
    const bool b0 = i & 1, b1 = i & 2, b2 = i & 4, b3 = i & 8;
    const int t0 = b0 ? v1 : v0, t1 = b0 ? v3 : v2, t2 = b0 ? v5 : v4, t3 = b0 ? v7 : v6, t4 = b0 ? v9 : v8, t5 = b0 ? v11 : v10, t6 = b0 ? v13 : v12, t7 = b0 ? v15 : v14;
    const int s0 = b1 ? t1 : t0, s1 = b1 ? t3 : t2, s2 = b1 ? t5 : t4, s3 = b1 ? t7 : t6;
    const int r0 = b2 ? s1 : s0, r1 = b2 ? s3 : s2;
    return b3 ? r1 : r0;
}
__device__ __forceinline__ void topk_combine(const unsigned (&La)[16], const unsigned (&Lb)[16], int* eid_out, float* gate_out) {
    float a[16], b[16]; int ia[16], ib[16];
#pragma unroll
    for (int i = 0; i < 16; ++i) { a[i] = key2f(La[i] & ~127u); ia[i] = 127 - (int)(La[i] & 127u); b[i] = key2f(Lb[i] & ~127u); ib[i] = 127 - (int)(Lb[i] & 127u);
        asm volatile("" : "+v"(ia[i]), "+v"(ib[i])); }
    unsigned Lc[16];
#pragma unroll
    for (int i = 0; i < 16; ++i) Lc[i] = 0u;
#define TK_CAND(i, j) do { const float s_ = a[i] + b[j]; const unsigned k_ = (f2key(s_) & ~255u) | (unsigned)(255 - ((i) * 16 + (j))); INS16(Lc, k_); } while (0)
    TK_CAND(0, 0); TK_CAND(0, 1); TK_CAND(0, 2); TK_CAND(0, 3); TK_CAND(0, 4); TK_CAND(0, 5); TK_CAND(0, 6); TK_CAND(0, 7);
    TK_CAND(0, 8); TK_CAND(0, 9); TK_CAND(0, 10); TK_CAND(0, 11); TK_CAND(0, 12); TK_CAND(0, 13); TK_CAND(0, 14); TK_CAND(0, 15);
    TK_CAND(1, 0); TK_CAND(1, 1); TK_CAND(1, 2); TK_CAND(1, 3); TK_CAND(1, 4); TK_CAND(1, 5); TK_CAND(1, 6); TK_CAND(1, 7);
    TK_CAND(2, 0); TK_CAND(2, 1); TK_CAND(2, 2); TK_CAND(2, 3); TK_CAND(2, 4);
    TK_CAND(3, 0); TK_CAND(3, 1); TK_CAND(3, 2); TK_CAND(3, 3);
    TK_CAND(4, 0); TK_CAND(4, 1); TK_CAND(4, 2);
    TK_CAND(5, 0); TK_CAND(5, 1); TK_CAND(6, 0); TK_CAND(6, 1); TK_CAND(7, 0); TK_CAND(7, 1);
    TK_CAND(8, 0); TK_CAND(9, 0); TK_CAND(10, 0); TK_CAND(11, 0); TK_CAND(12, 0); TK_CAND(13, 0); TK_CAND(14, 0); TK_CAND(15, 0);
#undef TK_CAND
    float sv[16]; float m = -3.0e38f;
#pragma unroll
    for (int r = 0; r < 16; ++r) { sv[r] = key2f(Lc[r] & ~255u); m = fmaxf(m, sv[r]); }
    float sum = 0.f;
#pragma unroll
    for (int r = 0; r < 16; ++r) { sv[r] = __expf(sv[r] - m); sum += sv[r]; }
    const float inv = 1.f / sum;
#pragma unroll
    for (int r = 0; r < 16; ++r) { const int c = 255 - (int)(Lc[r] & 255u); const int i1 = sel16(ia, c >> 4), i2 = sel16(ib, c & 15);
        eid_out[r] = i1 * NKEYS + i2; gate_out[r] = sv[r] * inv; }
}
namespace nv {
__device__ __forceinline__ int win_srccol(int n) { if (n < 1536) return n; const int j = n - 1536, u = j >> 8, r = j & 255; return r < 128 ? 1536 + 128 * u + r : 2048 + 128 * u + (r - 128); }
__global__ void transpose_w(const float* W, int K, int NW, int N, bf16* WT, int mode) {
    const size_t i = (size_t)blockIdx.x * blockDim.x + threadIdx.x; if (i >= (size_t)N * K) return;
    const int n = (int)(i / K), k = (int)(i % K); const int c = mode == 1 ? win_srccol(n) : n;
    WT[i] = (bf16)f2bf(W[(size_t)k * NW + c]);
}
__global__ void fold_wq(const float* wq, const float* keys, bf16* WQK) {
    const size_t i = (size_t)blockIdx.x * blockDim.x + threadIdx.x; if (i >= (size_t)2048 * 1024) return;
    const int n = (int)(i / 1024), d = (int)(i % 1024); const int hp = n >> 7, kk = n & 127, p = hp & 1;
    const float* w = wq + (size_t)d * 2048 + hp * 128; const float* kr = keys + ((size_t)p * 128 + kk) * 128; float s = 0.f;
    for (int c = 0; c < 128; ++c) s += w[c] * kr[c];
    WQK[i] = (bf16)f2bf(s);
}
__global__ void cvt_bf16(const float* src, bf16* dst, size_t n) { const size_t i = (size_t)blockIdx.x * blockDim.x + threadIdx.x; if (i < n) dst[i] = (bf16)f2bf(src[i]); }
struct Freq { float f[8]; };
__global__ void rope_table(const int* pos, float* cs, float* sn, Freq fr) {
    const int i = blockIdx.x * blockDim.x + threadIdx.x; if (i >= NTOK * 8) return;
    const float ang = (float)pos[i >> 3] * fr.f[i & 7]; cs[i] = cosf(ang); sn[i] = sinf(ang);
}
template <bool OUTF32> __device__ __forceinline__ void rms_row(int row, int lane, const float* in, const float* g, void* out) {
    const f32x4* xr = (const f32x4*)(in + (size_t)row * DM) + lane; f32x4 v[4]; float s = 0.f;
#pragma unroll
    for (int j = 0; j < 4; ++j) { v[j] = xr[64 * j]; s += v[j].x * v[j].x + v[j].y * v[j].y + v[j].z * v[j].z + v[j].w * v[j].w; }
    const float r = rsqrtf(wave_sum(s) * (1.f / DM) + EPS);
#pragma unroll
    for (int j = 0; j < 4; ++j) { const f32x4 gg = ((const f32x4*)g)[lane + 64 * j]; const f32x4 o = v[j] * r * gg;
        if (OUTF32) ((f32x4*)((float*)out + (size_t)row * DM))[lane + 64 * j] = o;
        else { v2u w; w.x = pk2(o.x, o.y); w.y = pk2(o.z, o.w); ((v2u*)((bf16*)out + (size_t)row * DM))[lane + 64 * j] = w; } }
}
template <bool OUTF32> __global__ void rms_rows(const float* in, const float* g, void* out) {
    const int row = blockIdx.x * 4 + (threadIdx.x >> 6); if (row >= NTOK) return; rms_row<OUTF32>(row, threadIdx.x & 63, in, g, out);
}
struct GP { const bf16* A; const bf16* Bt; const float* cs; const float* sn; bf16 *Q, *Kb, *Vb, *GLU; const float* x; float* H; bf16* O; const bf16* PPO; int M, N, K, pad; };
__device__ __forceinline__ void dot4(const bf16* A, const bf16* Bt, int K, int m0, int n, float (&acc)[4]) {
    const v4u* b = (const v4u*)(Bt + (size_t)n * K);
#pragma unroll
    for (int r = 0; r < 4; ++r) acc[r] = 0.f;
    for (int kc = 0; kc < K / 8; ++kc) { const v4u bw = b[kc];
#pragma unroll
        for (int r = 0; r < 4; ++r) { const v4u aw = ((const v4u*)(A + (size_t)(m0 + r) * K))[kc];
            acc[r] += bflo(aw.x) * bflo(bw.x) + bfhi(aw.x) * bfhi(bw.x) + bflo(aw.y) * bflo(bw.y) + bfhi(aw.y) * bfhi(bw.y) + bflo(aw.z) * bflo(bw.z) + bfhi(aw.z) * bfhi(bw.z) + bflo(aw.w) * bflo(bw.w) + bfhi(aw.w) * bfhi(bw.w); } }
}
template <int EPI> __global__ void gemm(GP p) {
    const int n = blockIdx.x * 256 + threadIdx.x, m0 = blockIdx.y * 4; if (n >= p.N) return;
    float acc[4];
    if (EPI == 1) {
        if (n < 1024) {
            dot4(p.A, p.Bt, p.K, m0, n, acc); const int hc = n & 63;
            if (hc < 16) { float pa[4]; dot4(p.A, p.Bt, p.K, m0, n ^ 8, pa);
#pragma unroll
                for (int r = 0; r < 4; ++r) { const float c = p.cs[(size_t)(m0 + r) * 8 + (hc & 7)], s = p.sn[(size_t)(m0 + r) * 8 + (hc & 7)];
                    acc[r] = (hc & 8) ? acc[r] * c + pa[r] * s : acc[r] * c - pa[r] * s; } }
#pragma unroll
            for (int r = 0; r < 4; ++r) { if (n < 512) p.Q[(size_t)(m0 + r) * 512 + n] = (bf16)f2bf(acc[r] * QSCALE); else p.Kb[(size_t)(m0 + r) * 512 + n - 512] = (bf16)f2bf(acc[r]); }
        } else if (n < 1536) { dot4(p.A, p.Bt, p.K, m0, n, acc);
#pragma unroll
            for (int r = 0; r < 4; ++r) p.Vb[(size_t)(m0 + r) * 512 + n - 1024] = (bf16)f2bf(acc[r]);
        } else { const int j = n - 1536, u = j >> 8, rr = j & 255; if (rr >= 128) return; float g[4]; dot4(p.A, p.Bt, p.K, m0, n, acc); dot4(p.A, p.Bt, p.K, m0, n + 128, g);
#pragma unroll
            for (int r = 0; r < 4; ++r) p.GLU[(size_t)(m0 + r) * 512 + 128 * u + rr] = (bf16)f2bf(acc[r] * sigmoidf_(g[r])); }
    } else {
        dot4(p.A, p.Bt, p.K, m0, n, acc);
#pragma unroll
        for (int r = 0; r < 4; ++r) { const size_t o = (size_t)(m0 + r) * p.N + n;
            if (EPI == 2) p.H[o] = p.x[o] + acc[r];
            if (EPI == 3) p.O[o] = (bf16)f2bf(acc[r]);
            if (EPI == 4) p.H[o] = p.H[o] + sigmoidf_(acc[r]) * bf2f(p.PPO[o]); }
    }
}
__device__ __forceinline__ void attn_item(int gw, int lane, const bf16* Q, const bf16* Kb, const bf16* Vb, bf16* ATT) {
    const int tok = gw >> 3, h = gw & 7, b = tok / SEQ, s = tok % SEQ;
    const float q = bf2f(Q[(size_t)tok * 512 + h * 64 + lane]);
    float o[3], lse[3]; const int dil[3] = {1, 4, 16};
#pragma unroll
    for (int p = 0; p < 3; ++p) { float m = -3.0e38f, l = 0.f, acc = 0.f;
        for (int j = 0; j <= 128; ++j) { const int tk = s - j * dil[p]; if (tk < 0) break; const size_t kr = ((size_t)b * SEQ + tk) * 512 + h * 64 + lane;
            const float sc = wave_sum(q * bf2f(Kb[kr])); const float mn = fmaxf(m, sc), al = exp2f(m - mn), pe = exp2f(sc - mn);
            l = l * al + pe; acc = acc * al + pe * bf2f(Vb[kr]); m = mn; }
        o[p] = acc / l; lse[p] = m + log2f(l); }
    const float M = fmaxf(lse[0], fmaxf(lse[1], lse[2])); const float w0 = exp2f(lse[0] - M), w1 = exp2f(lse[1] - M), w2 = exp2f(lse[2] - M);
    ATT[(size_t)tok * 512 + h * 64 + lane] = (bf16)f2bf((w0 * o[0] + w1 * o[1] + w2 * o[2]) / (w0 + w1 + w2));
}
__global__ void attn(const bf16* Q, const bf16* Kb, const bf16* Vb, bf16* ATT) {
    const int gw = blockIdx.x * 4 + (threadIdx.x >> 6); if (gw >= NTOK * NH) return; attn_item(gw, threadIdx.x & 63, Q, Kb, Vb, ATT);
}
__device__ __forceinline__ void mix_token(int tok, int lane, const bf16* GLU, const bf16* ATT, const float* cw, const float* cb, const float* lg, const float* lb, const float* ga, const float* gc, bf16* Y) {
    const int s = tok % SEQ, c0 = lane * 8; float acc[8];
    { const f32x4 b0 = *(const f32x4*)(cb + c0), b1 = *(const f32x4*)(cb + c0 + 4); acc[0] = b0.x; acc[1] = b0.y; acc[2] = b0.z; acc[3] = b0.w; acc[4] = b1.x; acc[5] = b1.y; acc[6] = b1.z; acc[7] = b1.w; }
    for (int j = 0; j < CW; ++j) { const int ts = s - (CW - 1) + j; if (ts < 0) continue;
        const v4u g = *(const v4u*)(GLU + (size_t)(tok - (CW - 1) + j) * 512 + c0); const f32x4 w0 = *(const f32x4*)(cw + j * 512 + c0), w1 = *(const f32x4*)(cw + j * 512 + c0 + 4);
        acc[0] += w0.x * bflo(g.x); acc[1] += w0.y * bfhi(g.x); acc[2] += w0.z * bflo(g.y); acc[3] += w0.w * bfhi(g.y); acc[4] += w1.x * bflo(g.z); acc[5] += w1.y * bfhi(g.z); acc[6] += w1.z * bflo(g.w); acc[7] += w1.w * bfhi(g.w); }
    float sm = 0.f;
#pragma unroll
    for (int i = 0; i < 8; ++i) sm += acc[i];
    const float mean = wave_sum(sm) * (1.f / 512.f); float sq = 0.f;
#pragma unroll
    for (int i = 0; i < 8; ++i) { acc[i] -= mean; sq += acc[i] * acc[i]; }
    const float rstd = rsqrtf(wave_sum(sq) * (1.f / 512.f) + EPS); float ss = 0.f;
#pragma unroll
    for (int i = 0; i < 8; ++i) { const float y = acc[i] * rstd * lg[c0 + i] + lb[c0 + i]; acc[i] = y * sigmoidf_(y); ss += acc[i] * acc[i]; }
    const float rc = rsqrtf(wave_sum(ss) * (1.f / 512.f) + EPS);
    v4u o; o.x = pk2(acc[0] * rc * gc[c0 + 0], acc[1] * rc * gc[c0 + 1]); o.y = pk2(acc[2] * rc * gc[c0 + 2], acc[3] * rc * gc[c0 + 3]); o.z = pk2(acc[4] * rc * gc[c0 + 4], acc[5] * rc * gc[c0 + 5]); o.w = pk2(acc[6] * rc * gc[c0 + 6], acc[7] * rc * gc[c0 + 7]);
    *(v4u*)(Y + (size_t)tok * 1024 + 512 + c0) = o;
    const v4u a = *(const v4u*)(ATT + (size_t)tok * 512 + c0); float av[8] = {bflo(a.x), bfhi(a.x), bflo(a.y), bfhi(a.y), bflo(a.z), bfhi(a.z), bflo(a.w), bfhi(a.w)}; float sa = 0.f;
#pragma unroll
    for (int i = 0; i < 8; ++i) sa += av[i] * av[i];
    const float ra = rsqrtf(wave_sum(sa) * (1.f / 512.f) + EPS);
    v4u oa; oa.x = pk2(av[0] * ra * ga[c0 + 0], av[1] * ra * ga[c0 + 1]); oa.y = pk2(av[2] * ra * ga[c0 + 2], av[3] * ra * ga[c0 + 3]); oa.z = pk2(av[4] * ra * ga[c0 + 4], av[5] * ra * ga[c0 + 5]); oa.w = pk2(av[6] * ra * ga[c0 + 6], av[7] * ra * ga[c0 + 7]);
    *(v4u*)(Y + (size_t)tok * 1024 + c0) = oa;
}
__global__ void mix_norm(const bf16* GLU, const bf16* ATT, const float* cw, const float* cb, const float* lg, const float* lb, const float* ga, const float* gc, bf16* Y) {
    const int tok = blockIdx.x * 4 + (threadIdx.x >> 6); if (tok >= NTOK) return; mix_token(tok, threadIdx.x & 63, GLU, ATT, cw, cb, lg, lb, ga, gc, Y);
}
__device__ __forceinline__ void topk_item(int i, const bf16* SC, int* EID, float* GATE) {
    const bf16* row = SC + (size_t)i * 256; unsigned La[16], Lb[16];
#pragma unroll
    for (int q = 0; q < 16; ++q) { La[q] = 0u; Lb[q] = 0u; }
    for (int c = 0; c < 128; ++c) { const unsigned k = (f2key(bf2f(row[c])) & ~127u) | (unsigned)(127 - c); INS16(La, k); }
    for (int c = 0; c < 128; ++c) { const unsigned k = (f2key(bf2f(row[128 + c])) & ~127u) | (unsigned)(127 - c); INS16(Lb, k); }
    int e[16]; float g[16]; topk_combine(La, Lb, e, g);
#pragma unroll
    for (int r = 0; r < 16; ++r) { EID[(size_t)i * 16 + r] = e[r]; GATE[(size_t)i * 16 + r] = g[r]; }
}
__global__ void topk(const bf16* SC, int* EID, float* GATE) {
    const int i = blockIdx.x * blockDim.x + threadIdx.x; if (i >= NTOK * PH) return; topk_item(i, SC, EID, GATE);
}
__device__ __forceinline__ void peer_token(int tok, int lane, const bf16* XN, const bf16* U, const bf16* V, const int* EID, const float* GATE, float* H) {
    float x[16], y[16];
    { const v4u a = ((const v4u*)(XN + (size_t)tok * 1024))[lane * 2], b = ((const v4u*)(XN + (size_t)tok * 1024))[lane * 2 + 1];
      x[0] = bflo(a.x); x[1] = bfhi(a.x); x[2] = bflo(a.y); x[3] = bfhi(a.y); x[4] = bflo(a.z); x[5] = bfhi(a.z); x[6] = bflo(a.w); x[7] = bfhi(a.w);
      x[8] = bflo(b.x); x[9] = bfhi(b.x); x[10] = bflo(b.y); x[11] = bfhi(b.y); x[12] = bflo(b.z); x[13] = bfhi(b.z); x[14] = bflo(b.w); x[15] = bfhi(b.w); }
#pragma unroll
    for (int i = 0; i < 16; ++i) y[i] = 0.f;
    for (int k = 0; k < HK; ++k) { const int e = EID[(size_t)tok * HK + k]; const float g = GATE[(size_t)tok * HK + k];
        const v4u a = ((const v4u*)(U + (size_t)e * 1024))[lane * 2], b = ((const v4u*)(U + (size_t)e * 1024))[lane * 2 + 1];
        float d = x[0] * bflo(a.x) + x[1] * bfhi(a.x) + x[2] * bflo(a.y) + x[3] * bfhi(a.y) + x[4] * bflo(a.z) + x[5] * bfhi(a.z) + x[6] * bflo(a.w) + x[7] * bfhi(a.w)
                + x[8] * bflo(b.x) + x[9] * bfhi(b.x) + x[10] * bflo(b.y) + x[11] * bfhi(b.y) + x[12] * bflo(b.z) + x[13] * bfhi(b.z) + x[14] * bflo(b.w) + x[15] * bfhi(b.w);
        d = wave_sum(d); const float act = gelu_erf(d) * g;
        const v4u c = ((const v4u*)(V + (size_t)e * 1024))[lane * 2], dd = ((const v4u*)(V + (size_t)e * 1024))[lane * 2 + 1];
        y[0] += act * bflo(c.x); y[1] += act * bfhi(c.x); y[2] += act * bflo(c.y); y[3] += act * bfhi(c.y); y[4] += act * bflo(c.z); y[5] += act * bfhi(c.z); y[6] += act * bflo(c.w); y[7] += act * bfhi(c.w);
        y[8] += act * bflo(dd.x); y[9] += act * bfhi(dd.x); y[10] += act * bflo(dd.y); y[11] += act * bfhi(dd.y); y[12] += act * bflo(dd.z); y[13] += act * bfhi(dd.z); y[14] += act * bflo(dd.w); y[15] += act * bfhi(dd.w); }
    float* hr = H + (size_t)tok * 1024 + lane * 16;
#pragma unroll
    for (int i = 0; i < 4; ++i) { f32x4 v = ((f32x4*)hr)[i]; v.x += y[4 * i]; v.y += y[4 * i + 1]; v.z += y[4 * i + 2]; v.w += y[4 * i + 3]; ((f32x4*)hr)[i] = v; }
}
__global__ void peer(const bf16* XN, const bf16* U, const bf16* V, const int* EID, const float* GATE, float* H) {
    const int tok = blockIdx.x * 4 + (threadIdx.x >> 6); if (tok >= NTOK) return; peer_token(tok, threadIdx.x & 63, XN, U, V, EID, GATE, H);
}
}
namespace pg8 {
#define PG8_LAS __attribute__((address_space(3)))
typedef unsigned short bf16_t;
typedef short bf16x8 __attribute__((ext_vector_type(8)));
typedef float f32x4 __attribute__((ext_vector_type(4)));
typedef unsigned u32x4 __attribute__((ext_vector_type(4)));
constexpr int BM = 256, BK = 64, HALF = 128, HTB = HALF * BK * 2  , STAGE_BYTES = 8 * HTB, NXCD = 8, WGM = 8;

__host__ __device__ __forceinline__ int lds_byte(int r, int c) { const int st = (r >> 4) * 2 + (c >> 5), rr = r & 15, cc = c & 31, ob = rr * 64 + cc * 2; return st * 1024 + (ob ^ (((ob >> 9) & 1) << 5)); }
__host__ __device__ __forceinline__ void stage_rc(int b, int& R, int& C) { const int st = b / 1024, sb = b % 1024, swz = sb ^ (((sb >> 9) & 1) << 5); R = (st >> 1) * 16 + swz / 64; C = (st & 1) * 32 + (swz % 64) / 2; }
__host__ __device__ __forceinline__ int perm32(int rho) { const int n = rho >> 4, i = rho & 15; return 8 * (i >> 2) + 4 * n + (i & 3); }

struct Unit { int pm, pn; };
struct Gemm { const bf16_t* A; const bf16_t* Bt; int M, N, K; };

struct StaticOrder {
    int nM, nN, nwg, G, c;
    __host__ __device__ void init(int M, int N, int G_, int c_) { nM = M / BM; nN = N / BM; nwg = nM * nN; G = G_; c = c_; }
    __host__ __device__ bool next(int i, Unit& u) const {
        const long L = (long)i * G + c; if (L >= nwg) return false;
        int wgid = (int)L; { const int q = nwg / NXCD, r = nwg % NXCD, xcd = wgid % NXCD, off = wgid / NXCD; wgid = (xcd < r ? xcd * (q + 1) : r * (q + 1) + (xcd - r) * q) + off; }
        const int nig = WGM * nN, gid = wgid / nig, fm = gid * WGM, gsz = (nM - fm) < WGM ? (nM - fm) : WGM;
        u.pm = fm + ((wgid % nig) % gsz); u.pn = (wgid % nig) / gsz; return true;
    }
    __device__ __forceinline__ void a_ready(const Unit&) const {}
    __device__ __forceinline__ void done(const Unit&) const {}
};

__device__ __forceinline__ unsigned cvt_pk_bf16(float lo, float hi) { unsigned r; asm volatile("v_cvt_pk_bf16_f32 %0, %1, %2" : "=v"(r) : "v"(lo), "v"(hi)); return r; }
typedef float f32x2 __attribute__((ext_vector_type(2)));
__device__ __forceinline__ f32x2 gelu_pk(f32x2 v) {
    const f32x2 av = __builtin_elementwise_abs(v), d = av * 0.2316418882f + 1.0f;
    f32x2 t; t.x = __builtin_amdgcn_rcpf(d.x); t.y = __builtin_amdgcn_rcpf(d.y);
    f32x2 q = t * 0.5307027145f + (-0.7265760135f); q = q * t + 0.7107068705f; q = q * t + (-0.142248368f); q = q * t + 0.127414796f; q = q * t;
    const f32x2 s = (v * v) * (-0.72134752044f);
    f32x2 e; e.x = __builtin_amdgcn_exp2f(s.x); e.y = __builtin_amdgcn_exp2f(s.y);
    const f32x2 m = v * (q * e), r = v - m;
    f32x2 o; o.x = v.x < 0.f ? m.x : r.x; o.y = v.y < 0.f ? m.y : r.y; return o;
}

template <int ACT  > struct EpiBf16 {
    static constexpr bool PERM = true, AFTER_DRAIN = false; static_assert(ACT == 0 || ACT == 1, "EpiBf16: ACT is 0 (none) or 1 (gelu_pk)");
    bf16_t* O; int ldc; const float* bias; int split_cols; size_t split_stride; float scale0;
    __device__ __forceinline__ void operator()(const f32x4 (&acc)[2][2][4][2], const Unit& u, int wr, int wc, int fr, int fq) const {
        const int row0 = u.pm * BM + wr * 64 + fr; int colt = u.pn * BM; bf16_t* base = O;
        float sc = 1.f; if (split_cols) { const int t = colt / split_cols; base += (size_t)t * split_stride; colt -= t * split_cols; if (t == 0) sc = scale0; }
        const int col0 = colt + wc * 32 + 8 * fq, bcol0 = u.pn * BM + wc * 32 + 8 * fq;
        f32x4 bv[2][2];
#pragma unroll
        for (int bj = 0; bj < 2; ++bj)
#pragma unroll
            for (int n = 0; n < 2; ++n) bv[bj][n] = bias ? *(const f32x4*)(bias + bcol0 + bj * HALF + 4 * n) : (f32x4){0.f, 0.f, 0.f, 0.f};
#pragma unroll
        for (int ai = 0; ai < 2; ++ai)
#pragma unroll
            for (int m = 0; m < 4; ++m) { bf16_t* rowp = base + (size_t)(row0 + ai * HALF + m * 16) * ldc + col0;
#pragma unroll
                for (int bj = 0; bj < 2; ++bj) { f32x4 v0 = acc[ai][bj][m][0] + bv[bj][0], v1 = acc[ai][bj][m][1] + bv[bj][1];
                    if (ACT == 1) { f32x2 a = gelu_pk((f32x2){v0[0], v0[1]}), b = gelu_pk((f32x2){v0[2], v0[3]}), c = gelu_pk((f32x2){v1[0], v1[1]}), d = gelu_pk((f32x2){v1[2], v1[3]});
                        v0 = (f32x4){a.x, a.y, b.x, b.y}; v1 = (f32x4){c.x, c.y, d.x, d.y}; }
                    v0 = v0 * sc; v1 = v1 * sc; u32x4 w; w.x = cvt_pk_bf16(v0[0], v0[1]); w.y = cvt_pk_bf16(v0[2], v0[3]); w.z = cvt_pk_bf16(v1[0], v1[1]); w.w = cvt_pk_bf16(v1[2], v1[3]);
                    *(u32x4*)(rowp + bj * HALF) = w; } }
    }
};
struct EpiInProj {
    static constexpr bool PERM = true, AFTER_DRAIN = false;
    bf16_t* QKVG; const float* cs; const float* sn;
    __device__ __forceinline__ void operator()(const f32x4 (&acc)[2][2][4][2], const Unit& u, int wr, int wc, int fr, int fq) const {
        const int row0 = u.pm * BM + wr * 64 + fr;
        if (u.pn < 6) {
            bf16_t* dst = QKVG + (size_t)(u.pn >> 1) * ((size_t)16384 * 512);
            const int col0 = (u.pn & 1) * 256 + wc * 32 + 8 * fq;
            const bool rope_wave = (u.pn < 4) && ((wc & 1) == 0);
            const float sc = u.pn < 2 ? 0.125f * 1.4426950408889634f : 1.f;
#pragma unroll
            for (int ai = 0; ai < 2; ++ai)
#pragma unroll
                for (int m = 0; m < 4; ++m) { const int row = row0 + ai * HALF + m * 16;
                    f32x4 c0 = {1.f, 1.f, 1.f, 1.f}, c1 = c0, s0 = {0.f, 0.f, 0.f, 0.f}, s1 = s0;
                    if (rope_wave) { c0 = *(const f32x4*)(cs + (size_t)row * 8); c1 = *(const f32x4*)(cs + (size_t)row * 8 + 4); s0 = *(const f32x4*)(sn + (size_t)row * 8); s1 = *(const f32x4*)(sn + (size_t)row * 8 + 4); }
#pragma unroll
                    for (int bj = 0; bj < 2; ++bj) { f32x4 v0 = acc[ai][bj][m][0], v1 = acc[ai][bj][m][1];
                        if (rope_wave) { f32x4 p0, p1;
                            p0.x = __shfl_xor(v0.x, 16); p0.y = __shfl_xor(v0.y, 16); p0.z = __shfl_xor(v0.z, 16); p0.w = __shfl_xor(v0.w, 16);
                            p1.x = __shfl_xor(v1.x, 16); p1.y = __shfl_xor(v1.y, 16); p1.z = __shfl_xor(v1.z, 16); p1.w = __shfl_xor(v1.w, 16);
                            if (fq == 0) { v0 = v0 * c0 - p0 * s0; v1 = v1 * c1 - p1 * s1; }
                            else if (fq == 1) { v0 = v0 * c0 + p0 * s0; v1 = v1 * c1 + p1 * s1; } }
                        v0 = v0 * sc; v1 = v1 * sc; u32x4 w; w.x = cvt_pk_bf16(v0[0], v0[1]); w.y = cvt_pk_bf16(v0[2], v0[3]); w.z = cvt_pk_bf16(v1[0], v1[1]); w.w = cvt_pk_bf16(v1[2], v1[3]);
                        *(u32x4*)(dst + (size_t)row * 512 + col0 + bj * HALF) = w; } }
        } else {
            const int ch0 = (u.pn - 6) * 128 + wc * 32 + 8 * fq;
#pragma unroll
            for (int ai = 0; ai < 2; ++ai)
#pragma unroll
                for (int m = 0; m < 4; ++m) { const int row = row0 + ai * HALF + m * 16;
                    const f32x4 a0 = acc[ai][0][m][0], g0 = acc[ai][1][m][0], a1 = acc[ai][0][m][1], g1 = acc[ai][1][m][1];
#define GLU1(av, gv) ((av) * __builtin_amdgcn_rcpf(1.f + __expf(-(gv))))
                    u32x4 w; w.x = cvt_pk_bf16(GLU1(a0.x, g0.x), GLU1(a0.y, g0.y)); w.y = cvt_pk_bf16(GLU1(a0.z, g0.z), GLU1(a0.w, g0.w)); w.z = cvt_pk_bf16(GLU1(a1.x, g1.x), GLU1(a1.y, g1.y)); w.w = cvt_pk_bf16(GLU1(a1.z, g1.z), GLU1(a1.w, g1.w));
#undef GLU1
                    *(u32x4*)(QKVG + (size_t)3 * 16384 * 512 + (size_t)row * 512 + ch0) = w; }
        }
    }
};
struct EpiResid {
    static constexpr bool PERM = false, AFTER_DRAIN = false;
    const float* base; float* H;
    __device__ __forceinline__ void operator()(const f32x4 (&acc)[2][2][4][2], const Unit& u, int wr, int wc, int fr, int fq) const {
        const int row0 = u.pm * BM + wr * 64 + fr, col0 = u.pn * BM + wc * 32 + 4 * fq;
#pragma unroll
        for (int ai = 0; ai < 2; ++ai)
#pragma unroll
            for (int m = 0; m < 4; ++m) { const size_t ro = (size_t)(row0 + ai * HALF + m * 16) * 1024 + col0;
#pragma unroll
                for (int bj = 0; bj < 2; ++bj)
#pragma unroll
                    for (int n = 0; n < 2; ++n) { const size_t o = ro + bj * HALF + n * 16; *(f32x4*)(H + o) = *(const f32x4*)(base + o) + acc[ai][bj][m][n]; }
                if (m & 1) asm volatile("" ::: "memory"); }
    }
};
struct EpiPle {
    static constexpr bool PERM = false, AFTER_DRAIN = false;
    float* H; const bf16_t* PPO;
    __device__ __forceinline__ void operator()(const f32x4 (&acc)[2][2][4][2], const Unit& u, int wr, int wc, int fr, int fq) const {
        typedef unsigned u32x2 __attribute__((ext_vector_type(2)));
        const int row0 = u.pm * BM + wr * 64 + fr, col0 = u.pn * BM + wc * 32 + 4 * fq;
#pragma unroll
        for (int ai = 0; ai < 2; ++ai)
#pragma unroll
            for (int m = 0; m < 4; ++m) { const size_t ro = (size_t)(row0 + ai * HALF + m * 16) * 1024 + col0;
#pragma unroll
                for (int bj = 0; bj < 2; ++bj)
#pragma unroll
                    for (int n = 0; n < 2; ++n) { const size_t o = ro + bj * HALF + n * 16; const u32x2 pw = *(const u32x2*)(PPO + o); const f32x4 a = acc[ai][bj][m][n]; f32x4 h = *(const f32x4*)(H + o);
                        h[0] += __builtin_amdgcn_rcpf(1.f + __expf(-a[0])) * __uint_as_float(pw.x << 16); h[1] += __builtin_amdgcn_rcpf(1.f + __expf(-a[1])) * __uint_as_float(pw.x & 0xffff0000u);
                        h[2] += __builtin_amdgcn_rcpf(1.f + __expf(-a[2])) * __uint_as_float(pw.y << 16); h[3] += __builtin_amdgcn_rcpf(1.f + __expf(-a[3])) * __uint_as_float(pw.y & 0xffff0000u);
                        *(f32x4*)(H + o) = h; }
                if (m & 1) asm volatile("" ::: "memory"); }
    }
};
template <class Epi, class Sched, bool ALIGN_EPI = false, bool SP2 = false>
__device__ __forceinline__ void gemm_phase(PG8_LAS unsigned char* lds, const Gemm g, const Sched& S, const Epi& E) {
    int tid_ = threadIdx.x; asm volatile("" : "+v"(tid_));
    const int tid = tid_, wid = __builtin_amdgcn_readfirstlane(tid >> 6), lane = tid & 63, wr = wid >> 2, wc = wid & 3, fr = lane & 15, fq = lane >> 4;
    const int K = g.K, nt = K / BK;
    unsigned voffA[2], voffB[2];
#pragma unroll
    for (int i = 0; i < 2; ++i) { int R, C; stage_rc(tid * 16 + i * 8192, R, C); const int Rb = Epi::PERM ? ((R & ~31) + perm32(R & 31)) : R;
        voffA[i] = (unsigned)(R * K + C) * 2u; voffB[i] = (unsigned)(Rb * K + C) * 2u; }
    const size_t kstep = (size_t)(BK * 2);
    const size_t hstep = (size_t)HALF * K * 2;
    const size_t tstep = 2 * hstep;
    const unsigned ldsw = (unsigned)wid * 1024u;
    const int aoff = lds_byte(wr * 64 + fr, fq * 8), boff = lds_byte(wc * 32 + fr, fq * 8);
#define PG8_SA(b, h) (((b) * 2 + (h)) * HTB)
#define PG8_SB(b, h) ((4 + (b) * 2 + (h)) * HTB)
#define PG8_STAGE(bufoff, gbase, voff) do { _Pragma("unroll") for (int _i = 0; _i < 2; ++_i) \
        __builtin_amdgcn_global_load_lds((const unsigned*)((const char*)(gbase) + (voff)[_i]), (PG8_LAS unsigned*)(lds + (bufoff) + ldsw + _i * 8192), 16, 0, 0); } while (0)
#define PG8_LDA(dst, b, h) do { _Pragma("unroll") for (int m = 0; m < 4; ++m) _Pragma("unroll") for (int k = 0; k < 2; ++k) dst[m][k] = *(const PG8_LAS bf16x8*)(lds + PG8_SA(b, h) + aoff + m * 2048 + k * 1024); } while (0)
#define PG8_LDB(dst, b, h) do { _Pragma("unroll") for (int n = 0; n < 2; ++n) _Pragma("unroll") for (int k = 0; k < 2; ++k) dst[n][k] = *(const PG8_LAS bf16x8*)(lds + PG8_SB(b, h) + boff + n * 2048 + k * 1024); } while (0)
#define PG8_MMA(ai, bj, At, Bt) do { __builtin_amdgcn_s_setprio(1); _Pragma("unroll") for (int m = 0; m < 4; ++m) _Pragma("unroll") for (int n = 0; n < 2; ++n) _Pragma("unroll") for (int k = 0; k < 2; ++k) \
        acc[ai][bj][m][n] = __builtin_amdgcn_mfma_f32_16x16x32_bf16(Bt[n][k], At[m][k], acc[ai][bj][m][n], 0, 0, 0); __builtin_amdgcn_s_setprio(0); } while (0)
#define PG8_WAIT_V(n) asm volatile("s_waitcnt vmcnt(" #n ")" ::: "memory")
#define PG8_WAIT_L(n) asm volatile("s_waitcnt lgkmcnt(" #n ")" ::: "memory")
#define PG8_BAR __builtin_amdgcn_s_barrier()
#define PG8_SCHED __builtin_amdgcn_sched_barrier(0)
    Unit cur, nxt; int ui = 0;
    if (!S.next(0, cur)) return;
    f32x4 acc[2][2][4][2];
#pragma unroll
    for (int a = 0; a < 2; ++a)
#pragma unroll
        for (int b = 0; b < 2; ++b)
#pragma unroll
            for (int m = 0; m < 4; ++m)
#pragma unroll
                for (int n = 0; n < 2; ++n) acc[a][b][m][n] = (f32x4){0.f, 0.f, 0.f, 0.f};
    bf16x8 At[4][2], B0[2][2], B1[2][2];
    const char* cA = (const char*)g.A + (size_t)cur.pm * tstep; const char* cB = (const char*)g.Bt + (size_t)cur.pn * tstep;
    S.a_ready(cur);
    if constexpr (SP2) {
        PG8_STAGE(PG8_SB(0, 0), cB, voffB); PG8_STAGE(PG8_SB(0, 1), cB + hstep, voffB); PG8_STAGE(PG8_SA(0, 0), cA, voffA); PG8_STAGE(PG8_SA(0, 1), cA + hstep, voffA);
        if (wr == 1) PG8_BAR;
        PG8_WAIT_V(2); PG8_BAR;
        PG8_STAGE(PG8_SB(1, 0), cB + kstep, voffB); PG8_STAGE(PG8_SA(1, 0), cA + kstep, voffA); PG8_STAGE(PG8_SB(1, 1), cB + hstep + kstep, voffB);
        PG8_WAIT_V(6); PG8_BAR;
    } else {
        PG8_STAGE(PG8_SB(0, 0), cB, voffB); PG8_STAGE(PG8_SA(0, 0), cA, voffA); PG8_STAGE(PG8_SB(0, 1), cB + hstep, voffB); PG8_STAGE(PG8_SA(0, 1), cA + hstep, voffA);
        if (wr == 1) PG8_BAR;
        PG8_WAIT_V(4); PG8_BAR;
        PG8_STAGE(PG8_SB(1, 0), cB + kstep, voffB); PG8_STAGE(PG8_SA(1, 0), cA + kstep, voffA); PG8_STAGE(PG8_SB(1, 1), cB + hstep + kstep, voffB);
        PG8_WAIT_V(6); PG8_BAR;
    }
    for (;;) {
        const bool has_next = S.next(ui + 1, nxt);
        const char* nA = has_next ? (const char*)g.A + (size_t)nxt.pm * tstep : cA; const char* nB = has_next ? (const char*)g.Bt + (size_t)nxt.pn * tstep : cB;
        for (int t = 0; t < nt; t += 2) {
            const bool last = (t == nt - 2);
            const char* a1 = cA + (size_t)(t + 1) * kstep;
            const char* a2 = last ? nA : cA + (size_t)(t + 2) * kstep; const char* b2 = last ? nB : cB + (size_t)(t + 2) * kstep;
            const char* a3 = a2 + kstep; const char* b3 = b2 + kstep;
            if (last && has_next) S.a_ready(nxt);
            if constexpr (SP2) {
            PG8_LDB(B0, 0, 0); PG8_LDB(B1, 0, 1); PG8_SCHED; PG8_LDA(At, 0, 0); PG8_STAGE(PG8_SA(1, 1), a1 + hstep, voffA);
            PG8_WAIT_V(8); PG8_WAIT_L(0); PG8_BAR; PG8_MMA(0, 0, At, B0); PG8_MMA(0, 1, At, B1); PG8_BAR; PG8_SCHED;
            PG8_LDA(At, 0, 1); PG8_STAGE(PG8_SB(0, 0), b2, voffB); PG8_STAGE(PG8_SB(0, 1), b2 + hstep, voffB); PG8_STAGE(PG8_SA(0, 0), a2, voffA);
            PG8_WAIT_V(8); PG8_WAIT_L(0); PG8_BAR; PG8_MMA(1, 0, At, B0); PG8_MMA(1, 1, At, B1); PG8_BAR; PG8_SCHED;
            PG8_LDB(B0, 1, 0); PG8_LDB(B1, 1, 1); PG8_SCHED; PG8_LDA(At, 1, 0); PG8_STAGE(PG8_SA(0, 1), a2 + hstep, voffA);
            PG8_WAIT_V(8); PG8_WAIT_L(0); PG8_BAR; PG8_MMA(0, 0, At, B0); PG8_MMA(0, 1, At, B1); PG8_BAR; PG8_SCHED;
            PG8_LDA(At, 1, 1); PG8_STAGE(PG8_SB(1, 0), b3, voffB); PG8_STAGE(PG8_SB(1, 1), b3 + hstep, voffB); PG8_STAGE(PG8_SA(1, 0), a3, voffA);
            PG8_WAIT_V(8); PG8_WAIT_L(0); PG8_BAR; PG8_MMA(1, 0, At, B0); PG8_MMA(1, 1, At, B1); PG8_BAR; PG8_SCHED;
            } else {
            PG8_LDB(B0, 0, 0); PG8_SCHED; PG8_LDA(At, 0, 0); PG8_STAGE(PG8_SA(1, 1), a1 + hstep, voffA);
            PG8_WAIT_L(8); PG8_BAR; PG8_WAIT_L(0); PG8_MMA(0, 0, At, B0); PG8_BAR; PG8_SCHED;
            PG8_LDB(B1, 0, 1); PG8_STAGE(PG8_SB(0, 0), b2, voffB);
            PG8_BAR; PG8_WAIT_L(0); PG8_MMA(0, 1, At, B1); PG8_BAR;
            PG8_LDA(At, 0, 1); PG8_STAGE(PG8_SA(0, 0), a2, voffA);
            PG8_BAR; PG8_WAIT_L(0); PG8_MMA(1, 0, At, B0); PG8_BAR; PG8_SCHED;
            PG8_STAGE(PG8_SB(0, 1), b2 + hstep, voffB);
            PG8_WAIT_V(6); PG8_BAR; PG8_MMA(1, 1, At, B1); PG8_BAR;
            PG8_LDB(B0, 1, 0); PG8_SCHED; PG8_LDA(At, 1, 0); PG8_STAGE(PG8_SA(0, 1), a2 + hstep, voffA);
            PG8_WAIT_L(8); PG8_BAR; PG8_WAIT_L(0); PG8_MMA(0, 0, At, B0); PG8_BAR; PG8_SCHED;
            PG8_LDB(B1, 1, 1); PG8_STAGE(PG8_SB(1, 0), b3, voffB);
            PG8_BAR; PG8_WAIT_L(0); PG8_MMA(0, 1, At, B1); PG8_BAR;
            PG8_LDA(At, 1, 1); PG8_STAGE(PG8_SA(1, 0), a3, voffA);
            PG8_BAR; PG8_WAIT_L(0); PG8_MMA(1, 0, At, B0); PG8_BAR; PG8_SCHED;
            PG8_STAGE(PG8_SB(1, 1), b3 + hstep, voffB);
            PG8_WAIT_V(6); PG8_BAR; PG8_MMA(1, 1, At, B1); PG8_BAR;
            }
        }
        if constexpr (ALIGN_EPI) { if (wr == 0) PG8_BAR; }
        if constexpr (!Epi::AFTER_DRAIN) { E(acc, cur, wr, wc, fr, fq); S.done(cur); }
        if (!has_next) break;
#pragma unroll
        for (int a = 0; a < 2; ++a)
#pragma unroll
            for (int b = 0; b < 2; ++b)
#pragma unroll
                for (int m = 0; m < 4; ++m)
#pragma unroll
                    for (int n = 0; n < 2; ++n) acc[a][b][m][n] = (f32x4){0.f, 0.f, 0.f, 0.f};
        cur = nxt; cA = nA; cB = nB; ++ui;
        if constexpr (ALIGN_EPI) { if (wr == 1) PG8_BAR; }
    }
    PG8_WAIT_V(0);
    if constexpr (!ALIGN_EPI) { if (wr == 0) PG8_BAR; }
    PG8_BAR;
    if constexpr (Epi::AFTER_DRAIN) { E.fused(acc, cur, wr, wc, fr, fq, lds, wid, lane); S.done(cur); }
#undef PG8_SA
#undef PG8_SB
#undef PG8_STAGE
#undef PG8_LDA
#undef PG8_LDB
#undef PG8_MMA
#undef PG8_WAIT_V
#undef PG8_WAIT_L
#undef PG8_BAR
#undef PG8_SCHED
}
}
#define GAS __attribute__((address_space(1)))
#define LAS __attribute__((address_space(3)))
typedef short bf16x8 __attribute__((ext_vector_type(8)));
typedef GAS unsigned gu32;
typedef GAS unsigned long long gu64;
#define RLX_AGENT __ATOMIC_RELAXED, __HIP_MEMORY_SCOPE_AGENT
#define LDS_WAIT() asm volatile("s_waitcnt lgkmcnt(0)" ::: "memory")
#define VM_WAIT() asm volatile("s_waitcnt vmcnt(0)" ::: "memory")
__device__ __forceinline__ unsigned long long rt() { return __builtin_amdgcn_s_memrealtime(); }

#define XB_TMO      128
#define XB_XCNT(j)  (256  + 64 * (j))
#define XB_XSUB(j)  (1280 + 64 * (j))
#define XB_XGEN(j)  (2304 + 64 * (j))
#define XB_TOP      3328
#define XB_TOPGEN   3392
#define XCD_BAR_WORDS 3456
#define XB_SPIN_CAP (1u << 18)

__device__ __forceinline__ unsigned xb_ld(unsigned* p)              { return __hip_atomic_load(p, __ATOMIC_RELAXED, __HIP_MEMORY_SCOPE_AGENT); }
__device__ __forceinline__ unsigned xb_add(unsigned* p, unsigned v) { return __hip_atomic_fetch_add(p, v, __ATOMIC_RELAXED, __HIP_MEMORY_SCOPE_AGENT); }
__device__ __forceinline__ unsigned xb_xcc_id() { return (unsigned)__builtin_amdgcn_s_getreg((3 << 11) | 20) & 0xFu; }
#define XB_SPIN(cond, bar) do { unsigned _sp = 0; while (cond) { __builtin_amdgcn_s_sleep(1); \
    if ((++_sp & 255u) == 0u) { if (xb_ld(&(bar)[XB_TMO])) break; if (_sp > XB_SPIN_CAP) { atomicAdd(&(bar)[XB_TMO], 1u); break; } } } } while (0)

struct XcdBarrier {
    unsigned* bar; unsigned x;
    volatile LAS unsigned* st;
};

__device__ __forceinline__ XcdBarrier xcd_barrier_post(unsigned* bar, volatile LAS unsigned* st) {
    XcdBarrier b; b.bar = bar; b.x = xb_xcc_id(); b.st = st;
    if (threadIdx.x == 0) (void)xb_add(&bar[XB_XCNT(b.x)], 1u);
    return b;
}
__device__ __forceinline__ void xcd_barrier_complete(unsigned* bar, unsigned x, unsigned& nloc, unsigned& nx) {
    const unsigned G = gridDim.x * gridDim.y * gridDim.z;
    unsigned sum, cnt, mine, sp = 0u;
    for (;;) {
        sum = 0u; cnt = 0u; mine = 0u;
#pragma unroll
        for (unsigned j = 0; j < 16; ++j) { const unsigned c = xb_ld(&bar[XB_XCNT(j)]); sum += c; cnt += (c > 0u) ? 1u : 0u; mine = (j == x) ? c : mine; }
        if (sum == G) break;
        __builtin_amdgcn_s_sleep(1);
        if ((++sp & 255u) == 0u) { if (xb_ld(&bar[XB_TMO])) break; if (sp > XB_SPIN_CAP) { atomicAdd(&bar[XB_TMO], 1u); break; } }
    }
    nloc = mine > 0u ? mine : 1u; nx = cnt > 0u ? cnt : 1u;
}

__device__ __forceinline__ void xcd_barrier(const XcdBarrier& b) {
    asm volatile("s_waitcnt vmcnt(0)" ::: "memory");
    __syncthreads();
    if (threadIdx.x == 0) {
        unsigned* bar = b.bar;
        __builtin_amdgcn_s_waitcnt(0);
        unsigned nloc = b.st[0], nx = b.st[1];
        if (nloc == 0u) { xcd_barrier_complete(bar, b.x, nloc, nx); b.st[0] = nloc; b.st[1] = nx; }
        const unsigned old = xb_add(&bar[XB_XSUB(b.x)], 1u);
        const unsigned gen = old / nloc;
        if (old + 1u == (gen + 1u) * nloc) {
            __builtin_amdgcn_fence(__ATOMIC_RELEASE, "agent");
            asm volatile("s_waitcnt vmcnt(0)" ::: "memory");
            const unsigned og = xb_add(&bar[XB_TOP], 1u);
            const unsigned tg = og / nx;
            if (og + 1u == (tg + 1u) * nx) xb_add(&bar[XB_TOPGEN], 1u);
            else XB_SPIN(xb_ld(&bar[XB_TOPGEN]) == tg, bar);
            __builtin_amdgcn_fence(__ATOMIC_ACQUIRE, "agent");
            xb_add(&bar[XB_XGEN(b.x)], 1u);
            asm volatile("s_waitcnt vmcnt(0)" ::: "memory");
        } else {
            XB_SPIN(xb_ld(&bar[XB_XGEN(b.x)]) == gen, bar);
            __builtin_amdgcn_fence(__ATOMIC_ACQUIRE, "agent");
            asm volatile("s_waitcnt vmcnt(0)" ::: "memory");
        }
    }
    __syncthreads();
}
namespace att {
typedef short s16x8 __attribute__((ext_vector_type(8)));
typedef short s16x4 __attribute__((ext_vector_type(4)));
constexpr int PITCH = 144;
constexpr int KOFF = 0, VOFF = 256 * PITCH;
typedef float f32x2_t __attribute__((ext_vector_type(2))); typedef __bf16 bf16x2_t __attribute__((ext_vector_type(2)));
__device__ __forceinline__ unsigned cvtpk(float lo, float hi) { f32x2_t v = {lo, hi}; bf16x2_t b = __builtin_convertvector(v, bf16x2_t); return __builtin_bit_cast(unsigned, b); }

struct QState { s16x8 q0, q1; f32x4 o[4]; float m, l; };

__device__ __forceinline__ void tile(QState& S, const s16x8 k0, const s16x8 k1, const s16x4 (&vf)[4], int base, int dq, unsigned limB, unsigned limC) {
    f32x4 s = {0.f, 0.f, 0.f, 0.f};
    s = __builtin_amdgcn_mfma_f32_16x16x32_bf16(k0, S.q0, s, 0, 0, 0);
    s = __builtin_amdgcn_mfma_f32_16x16x32_bf16(k1, S.q1, s, 0, 0, 0);
    float wf[4], sm[4];
#pragma unroll
    for (int j = 0; j < 4; ++j) { const unsigned ud = (unsigned)(base + dq - 16 * j); const int w = (ud < 129u ? 1 : 0) + (ud < limB ? 1 : 0) + (ud < limC ? 1 : 0);
        wf[j] = (float)w; sm[j] = w ? s[j] : -1.0e30f; }
    float tm = fmaxf(fmaxf(sm[0], sm[1]), fmaxf(sm[2], sm[3]));
    tm = fmaxf(tm, __shfl_xor(tm, 16)); tm = fmaxf(tm, __shfl_xor(tm, 32));
    const float mn = fmaxf(S.m, tm), al = __builtin_amdgcn_exp2f(S.m - mn); S.m = mn;
    float p[4], ps = 0.f;
#pragma unroll
    for (int j = 0; j < 4; ++j) { p[j] = wf[j] * __builtin_amdgcn_exp2f(sm[j] - mn); ps += p[j]; }
    S.l = S.l * al + ps;
    typedef unsigned u32x2 __attribute__((ext_vector_type(2)));
    u32x2 pw; pw.x = cvtpk(p[0], p[1]); pw.y = cvtpk(p[2], p[3]);
    const s16x4 pb = __builtin_bit_cast(s16x4, pw);
#pragma unroll
    for (int dt = 0; dt < 4; ++dt) { S.o[dt] = S.o[dt] * al; S.o[dt] = __builtin_amdgcn_mfma_f32_16x16x16bf16_1k(vf[dt], pb, S.o[dt], 0, 0, 0); }
}

__device__ __forceinline__ void phase(LAS unsigned char* lds, const bf16* Q, const bf16* Kb, const bf16* Vb, bf16* ATT, int vcu, int G) {
    int tid_ = threadIdx.x; asm volatile("" : "+v"(tid_));
    const int tid = tid_, lane = tid & 63, wave = __builtin_amdgcn_readfirstlane(tid >> 6), g = lane >> 4, i16 = lane & 15;
    const int klane = i16 * PITCH + 16 * g, vlane = (4 * g + (i16 >> 2)) * PITCH + 8 * (i16 & 3), dq = 16 * (i16 - 4 * g);
    for (int un = vcu; un < BATCH * NH * (SEQ / 256); un += G) {
        const int bh = un & 15, qblk = un >> 4, b = bh >> 3, h = bh & 7, t0 = qblk * 256;
        const bf16* Kg = Kb + (size_t)b * SEQ * 512 + h * 64; const bf16* Vg = Vb + (size_t)b * SEQ * 512 + h * 64;
        QState SA, SB; const int rA = 2 * wave, rB = 2 * wave + 1;
        { const bf16* qa = Q + ((size_t)b * SEQ + t0 + rA + 16 * i16) * 512 + h * 64 + 8 * g; SA.q0 = *(const s16x8*)qa; SA.q1 = *(const s16x8*)(qa + 32);
          const bf16* qb = qa + 512; SB.q0 = *(const s16x8*)qb; SB.q1 = *(const s16x8*)(qb + 32); }
#pragma unroll
        for (int dt = 0; dt < 4; ++dt) { SA.o[dt] = (f32x4){0.f, 0.f, 0.f, 0.f}; SB.o[dt] = (f32x4){0.f, 0.f, 0.f, 0.f}; }
        SA.m = -1.0e30f; SB.m = -1.0e30f; SA.l = 0.f; SB.l = 0.f;
        const int jc0 = qblk >= 8 ? 0 : 8 - qblk;
        v4u st[8];
#define ATT_LOAD(jc) do { const int c0_ = t0 - 2048 + 256 * (jc); _Pragma("unroll") for (int i_ = 0; i_ < 4; ++i_) { const int p_ = tid + 512 * i_; const size_t go_ = (size_t)(c0_ + (p_ >> 3)) * 512 + 8 * (p_ & 7); \
            st[i_] = *(const v4u*)(Kg + go_); st[4 + i_] = *(const v4u*)(Vg + go_); } } while (0)
#define ATT_STORE() do { _Pragma("unroll") for (int i_ = 0; i_ < 4; ++i_) { const int p_ = tid + 512 * i_, pos_ = p_ >> 3; const int off_ = ((pos_ & 15) * 16 + (pos_ >> 4)) * PITCH + 16 * (p_ & 7); \
            *(LAS v4u*)(lds + KOFF + off_) = st[i_]; *(LAS v4u*)(lds + VOFF + off_) = st[4 + i_]; } } while (0)
        ATT_LOAD(jc0); ATT_STORE();
        __syncthreads();
        for (int jc = jc0; jc <= 8; ++jc) {
            if (jc < 8) ATT_LOAD(jc + 1);
            const int D0 = 256 * (8 - jc);
            for (int rho = 0; rho < 16; ++rho) {
                const bool nA = (jc >= 7) || (rho == rA) || (jc == 6 && ((rA - rho) & 3) == 0);
                const bool nB = (jc >= 7) || (rho == rB) || (jc == 6 && ((rB - rho) & 3) == 0);
                if (!(nA || nB)) continue;
                const LAS unsigned char* kp = lds + KOFF + rho * (16 * PITCH) + klane; const LAS unsigned char* vp = lds + VOFF + rho * (16 * PITCH) + vlane;
                const s16x8 k0 = *(const LAS s16x8*)kp, k1 = *(const LAS s16x8*)(kp + 64);
                s16x4 vf[4];
#pragma unroll
                for (int dt = 0; dt < 4; ++dt) vf[dt] = __builtin_amdgcn_ds_read_tr16_b64_v4i16((LAS s16x4*)(vp + 32 * dt));
                if (nA) tile(SA, k0, k1, vf, D0 + rA - rho, dq, ((rA - rho) & 3) == 0 ? 513u : 0u, rho == rA ? 2049u : 0u);
                if (nB) tile(SB, k0, k1, vf, D0 + rB - rho, dq, ((rB - rho) & 3) == 0 ? 513u : 0u, rho == rB ? 2049u : 0u);
            }
            __syncthreads();
            if (jc < 8) { ATT_STORE(); }
            __syncthreads();
        }
#undef ATT_LOAD
#undef ATT_STORE
        typedef unsigned u32x2 __attribute__((ext_vector_type(2)));
        { float l = SA.l; l += __shfl_xor(l, 16); l += __shfl_xor(l, 32); const float inv = 1.f / l; bf16* op = ATT + ((size_t)b * SEQ + t0 + rA + 16 * i16) * 512 + h * 64 + 4 * g;
#pragma unroll
          for (int dt = 0; dt < 4; ++dt) { u32x2 w; w.x = cvtpk(SA.o[dt][0] * inv, SA.o[dt][1] * inv); w.y = cvtpk(SA.o[dt][2] * inv, SA.o[dt][3] * inv); *(u32x2*)(op + 16 * dt) = w; } }
        { float l = SB.l; l += __shfl_xor(l, 16); l += __shfl_xor(l, 32); const float inv = 1.f / l; bf16* op = ATT + ((size_t)b * SEQ + t0 + rB + 16 * i16) * 512 + h * 64 + 4 * g;
#pragma unroll
          for (int dt = 0; dt < 4; ++dt) { u32x2 w; w.x = cvtpk(SB.o[dt][0] * inv, SB.o[dt][1] * inv); w.y = cvtpk(SB.o[dt][2] * inv, SB.o[dt][3] * inv); *(u32x2*)(op + 16 * dt) = w; } }
    }
}
}
namespace peer {
typedef __bf16 bf2 __attribute__((ext_vector_type(2)));
__device__ __forceinline__ float dot2(unsigned a, unsigned b, float acc) { return __builtin_amdgcn_fdot2_f32_bf16(__builtin_bit_cast(bf2, a), __builtin_bit_cast(bf2, b), acc, false); }
__device__ __forceinline__ float dot8(const v4u a, const v4u b, float acc) {
    const unsigned a0 = a.x, a1 = a.y, a2 = a.z, a3 = a.w, b0 = b.x, b1 = b.y, b2 = b.z, b3 = b.w;
    acc = dot2(a0, b0, acc); acc = dot2(a1, b1, acc); acc = dot2(a2, b2, acc); acc = dot2(a3, b3, acc);
    return acc;
}
__device__ __forceinline__ int next_bit(unsigned long long& lo, unsigned long long& hi) {
    if (lo) { const int k = __builtin_ctzll(lo); lo &= lo - 1; return k; }
    const int k = __builtin_ctzll(hi); hi &= hi - 1; return 64 + k;
}
__device__ __forceinline__ void phase_u(const bf16* XN, const bf16* U, const int* EID, float* GATE, int bx, int G) {
    int tid_ = threadIdx.x; asm volatile("" : "+v"(tid_));
    const int tid = tid_, lane = tid & 63, wave = __builtin_amdgcn_readfirstlane(tid >> 6);
    const int xslot = bx & 7, member = bx >> 3, nmem = (G - xslot + 7) >> 3;
    for (int sp = 0; sp < 2; ++sp) {
        const int slice = xslot + 8 * sp;
        for (int t = member * 8 + wave; t < NTOK; t += nmem * 8) {
            const int e0 = EID[(size_t)t * HK + lane], e1 = EID[(size_t)t * HK + 64 + lane];
            const bool in0 = (e0 >> 10) == slice, in1 = (e1 >> 10) == slice;
            unsigned long long m0 = __ballot(in0), m1 = __ballot(in1);
            if ((m0 | m1) == 0ull) continue;
            const v4u xa = ((const v4u*)(XN + (size_t)t * DM))[lane], xb = ((const v4u*)(XN + (size_t)t * DM))[64 + lane];
            float h0 = 0.f, h1 = 0.f;
            while (m0 | m1) {
                int k[4], e[4];
                k[0] = next_bit(m0, m1);
#pragma unroll
                for (int j = 1; j < 4; ++j) k[j] = (m0 | m1) ? next_bit(m0, m1) : -1;
#pragma unroll
                for (int j = 0; j < 4; ++j) { const int kk = k[j] < 0 ? k[0] : k[j]; e[j] = kk < 64 ? __builtin_amdgcn_readlane(e0, kk) : __builtin_amdgcn_readlane(e1, kk - 64); }
                v4u ua[4], ub[4];
#pragma unroll
                for (int j = 0; j < 4; ++j) { const v4u* row = (const v4u*)(U + (size_t)e[j] * DM); ua[j] = row[lane]; ub[j] = row[64 + lane]; }
#pragma unroll
                for (int j = 0; j < 4; ++j) { float d = dot8(xa, ua[j], 0.f); d = dot8(xb, ub[j], d); d = wave_sum(d);
                    if (k[j] >= 0) { if (k[j] < 64) { if (lane == k[j]) h0 = d; } else { if (lane == k[j] - 64) h1 = d; } } }
            }
            if (in0) GATE[(size_t)t * HK + lane] = gelu_erf(h0) * GATE[(size_t)t * HK + lane];
            if (in1) GATE[(size_t)t * HK + 64 + lane] = gelu_erf(h1) * GATE[(size_t)t * HK + 64 + lane];
        }
    }
}
__device__ __forceinline__ void phase_v(const bf16* V, const int* EID, const float* ACT, float* H, int bx, int G) {
    int tid_ = threadIdx.x; asm volatile("" : "+v"(tid_));
    const int tid = tid_, lane = tid & 63, wave = __builtin_amdgcn_readfirstlane(tid >> 6), g8 = lane >> 3, c8 = lane & 7;
    const int xslot = bx & 7, member = bx >> 3, nmem = (G - xslot + 7) >> 3;
    for (int sp = 0; sp < 2; ++sp) {
        const int slice = xslot + 8 * sp; const bf16* Vs = V + slice * 64 + c8 * 8;
        for (int t = member * 8 + wave; t < NTOK; t += nmem * 8) {
            const int e0 = EID[(size_t)t * HK + lane], e1 = EID[(size_t)t * HK + 64 + lane];
            const float a0 = ACT[(size_t)t * HK + lane], a1 = ACT[(size_t)t * HK + 64 + lane];
            v4u r[16]; float av[16];
#pragma unroll
            for (int i = 0; i < 16; ++i) { const int src = ((8 * i) & 63) + g8; const int e = __shfl(i < 8 ? e0 : e1, src); av[i] = __shfl(i < 8 ? a0 : a1, src);
                r[i] = *(const v4u*)(Vs + (size_t)e * DM); }
            float acc[8];
#pragma unroll
            for (int q = 0; q < 8; ++q) acc[q] = 0.f;
#pragma unroll
            for (int i = 0; i < 16; ++i) { const float a = av[i];
                acc[0] += a * bflo(r[i].x); acc[1] += a * bfhi(r[i].x); acc[2] += a * bflo(r[i].y); acc[3] += a * bfhi(r[i].y);
                acc[4] += a * bflo(r[i].z); acc[5] += a * bfhi(r[i].z); acc[6] += a * bflo(r[i].w); acc[7] += a * bfhi(r[i].w); }
#pragma unroll
            for (int q = 0; q < 8; ++q) { float v = acc[q]; v += __shfl_xor(v, 8); v += __shfl_xor(v, 16); v += __shfl_xor(v, 32); acc[q] = v; }
            if (g8 == 0) { float* hp = H + (size_t)t * DM + slice * 64 + c8 * 8; f32x4 v0 = *(f32x4*)hp, v1 = *(f32x4*)(hp + 4);
                v0.x += acc[0]; v0.y += acc[1]; v0.z += acc[2]; v0.w += acc[3]; v1.x += acc[4]; v1.y += acc[5]; v1.z += acc[6]; v1.w += acc[7];
                *(f32x4*)hp = v0; *(f32x4*)(hp + 4) = v1; }
        }
    }
}

__device__ __forceinline__ void naive_u_token(int tok, int lane, const bf16* XN, const bf16* U, const int* EID, float* GATE) {
    const v4u xa = ((const v4u*)(XN + (size_t)tok * DM))[lane], xb = ((const v4u*)(XN + (size_t)tok * DM))[64 + lane];
    for (int k = 0; k < HK; ++k) { const int e = EID[(size_t)tok * HK + k]; const v4u* row = (const v4u*)(U + (size_t)e * DM);
        float d = dot8(xa, row[lane], 0.f); d = dot8(xb, row[64 + lane], d); d = wave_sum(d);
        if (lane == 0) GATE[(size_t)tok * HK + k] = gelu_erf(d) * GATE[(size_t)tok * HK + k]; }
}
__device__ __forceinline__ void naive_v_token(int tok, int lane, const bf16* V, const int* EID, const float* ACT, float* H) {
    float y[16];
#pragma unroll
    for (int i = 0; i < 16; ++i) y[i] = 0.f;
    for (int k = 0; k < HK; ++k) { const int e = EID[(size_t)tok * HK + k]; const float act = ACT[(size_t)tok * HK + k];
        const v4u c = ((const v4u*)(V + (size_t)e * 1024))[lane * 2], dd = ((const v4u*)(V + (size_t)e * 1024))[lane * 2 + 1];
        y[0] += act * bflo(c.x); y[1] += act * bfhi(c.x); y[2] += act * bflo(c.y); y[3] += act * bfhi(c.y); y[4] += act * bflo(c.z); y[5] += act * bfhi(c.z); y[6] += act * bflo(c.w); y[7] += act * bfhi(c.w);
        y[8] += act * bflo(dd.x); y[9] += act * bfhi(dd.x); y[10] += act * bflo(dd.y); y[11] += act * bfhi(dd.y); y[12] += act * bflo(dd.z); y[13] += act * bfhi(dd.z); y[14] += act * bflo(dd.w); y[15] += act * bfhi(dd.w); }
    float* hr = H + (size_t)tok * 1024 + lane * 16;
#pragma unroll
    for (int i = 0; i < 4; ++i) { f32x4 v = ((f32x4*)hr)[i]; v.x += y[4 * i]; v.y += y[4 * i + 1]; v.z += y[4 * i + 2]; v.w += y[4 * i + 3]; ((f32x4*)hr)[i] = v; }
}
}
#ifndef PH_MASK
#define PH_MASK 0xFFFu
#endif
constexpr int NWAVES = 8;
constexpr int RING_OFF = 0, RING_BYTES = 131072;
constexpr int LDSCTL_OFF = RING_BYTES, MISC_OFF = LDSCTL_OFF + 320;
constexpr int LDS_BYTES = 147456;
constexpr int CW_BAR = 4096;

struct Params {
    const float *x, *p; const int* pos; const float *norm_mix, *w_in, *conv_w, *conv_b, *ln_g, *ln_b, *g_att, *g_conv, *w_out, *norm_ffn, *wq, *keys, *eu, *ev, *norm_ple, *wg, *wp, *fin;
    float* out; unsigned char* ws; float freq[8];
};

__device__ __forceinline__ void transpose_item(const float* W, int K, int NW, bf16* WT, int n_dst0, int n_src0, int k0, LAS float* scr, int lane) {
#pragma unroll 8
    for (int i = 0; i < 32; ++i) { const int kk = 2 * i + (lane >> 5); scr[kk * 33 + (lane & 31)] = W[(size_t)(k0 + kk) * NW + n_src0 + (lane & 31)]; }
    LDS_WAIT(); asm volatile("" ::: "memory");
    const int c = lane & 7;
#pragma unroll
    for (int j = 0; j < 4; ++j) { const int n = (lane >> 3) + 8 * j; const LAS float* s = scr + (8 * c) * 33 + n;
        v4u o; o.x = pk2(s[0 * 33], s[1 * 33]); o.y = pk2(s[2 * 33], s[3 * 33]); o.z = pk2(s[4 * 33], s[5 * 33]); o.w = pk2(s[6 * 33], s[7 * 33]);
        *(v4u*)(WT + (size_t)(n_dst0 + n) * K + k0 + 8 * c) = o; }
    LDS_WAIT(); asm volatile("" ::: "memory");
}

__global__ void __launch_bounds__(NWAVES * 64, 2) mega(Params a) {
    extern __shared__ __attribute__((aligned(16))) unsigned char lds_raw[];
    LAS unsigned char* lds = (LAS unsigned char*)lds_raw;
    volatile LAS unsigned* MISC = (volatile LAS unsigned*)(lds + MISC_OFF);
    const int tid = threadIdx.x, lane = tid & 63, wave = __builtin_amdgcn_readfirstlane(tid >> 6);
    const int G = gridDim.x, bx = blockIdx.x, vcu = (G % 8 == 0) ? (bx % 8) * (G / 8) + bx / 8 : bx;
    const int gw = vcu * NWAVES + wave, NGW = G * NWAVES, gt = vcu * (NWAVES * 64) + tid, NGT = G * NWAVES * 64;
    unsigned* ctl = (unsigned*)(a.ws + WS_CTL);
#define H ((float*)a.out)
#define cs ((float*)(a.ws + WS_ROPE))
#define sn ((float*)(a.ws + WS_ROPE) + NTOK * 8)
#define WIN ((bf16*)(a.ws + WS_WIN))
#define WOUT ((bf16*)(a.ws + WS_WOUT))
#define WQK ((bf16*)(a.ws + WS_WQK))
#define WG ((bf16*)(a.ws + WS_WG))
#define WP ((bf16*)(a.ws + WS_WP))
#define U ((bf16*)(a.ws + WS_U))
#define V ((bf16*)(a.ws + WS_V))
#define XN ((bf16*)(a.ws + WS_XN))
#define Q ((bf16*)(a.ws + WS_Q))
#define Kb ((bf16*)(a.ws + WS_K))
#define Vb ((bf16*)(a.ws + WS_VV))
#define GLU ((bf16*)(a.ws + WS_GLU))
#define SC ((bf16*)(a.ws + WS_SC))
#define ATT ((bf16*)(a.ws + WS_ATT))
#define Y ((bf16*)(a.ws + WS_Y))
#define EID ((int*)(a.ws + WS_EID))
#define GATE ((float*)(a.ws + WS_GATE))
#define PP ((bf16*)(a.ws + WS_PP))

    for (int u = tid; u < (LDS_BYTES - LDSCTL_OFF) / 4; u += NWAVES * 64) ((LAS unsigned*)(lds + LDSCTL_OFF))[u] = 0u;
    __syncthreads();
    XcdBarrier bar = xcd_barrier_post(ctl + CW_BAR, MISC + 8);

    if (PH_MASK & (1u << 0)) {
    {
        LAS float* scr = (LAS float*)(lds + RING_OFF + wave * 16384);
        constexpr int I_IN = (DM / 64) * (DIN / 32), I_SQ = (DM / 64) * (DM / 32), I_WP = (PLE / 64) * (DM / 32);
        for (int it = gw; it < I_IN + 2 * I_SQ + I_WP; it += NGW) {
            int r = it;
            if (r < I_IN) { const int nb = r % (DIN / 32), kb = r / (DIN / 32); transpose_item(a.w_in, DM, DIN, WIN, 32 * nb, nv::win_srccol(32 * nb), 64 * kb, scr, lane); continue; } r -= I_IN;
            if (r < I_SQ) { const int nb = r % (DM / 32), kb = r / (DM / 32); transpose_item(a.w_out, DM, DM, WOUT, 32 * nb, 32 * nb, 64 * kb, scr, lane); continue; } r -= I_SQ;
            if (r < I_SQ) { const int nb = r % (DM / 32), kb = r / (DM / 32); transpose_item(a.wg, DM, DM, WG, 32 * nb, 32 * nb, 64 * kb, scr, lane); continue; } r -= I_SQ;
            { const int nb = r % (DM / 32), kb = r / (DM / 32); transpose_item(a.wp, PLE, DM, WP, 32 * nb, 32 * nb, 64 * kb, scr, lane); }
        }
        for (int i = gt; i < 2048 * 1024; i += NGT) { const int n = i >> 10, d = i & 1023, hp = n >> 7, kk = n & 127, p = hp & 1;
            const float* w = a.wq + (size_t)d * 2048 + hp * 128; const float* kr = a.keys + ((size_t)p * 128 + kk) * 128; float s = 0.f;
            for (int c = 0; c < 128; c += 4) { const f32x4 wv = *(const f32x4*)(w + c), kv = *(const f32x4*)(kr + c); s += wv.x * kv.x + wv.y * kv.y + wv.z * kv.z + wv.w * kv.w; }
            WQK[i] = (bf16)f2bf(s); }
        for (size_t i = gt; i < (size_t)NEXP * DM / 8; i += NGT) { const f32x4 u0 = ((const f32x4*)a.eu)[2 * i], u1 = ((const f32x4*)a.eu)[2 * i + 1], v0 = ((const f32x4*)a.ev)[2 * i], v1 = ((const f32x4*)a.ev)[2 * i + 1];
            v4u o; o.x = pk2(u0.x, u0.y); o.y = pk2(u0.z, u0.w); o.z = pk2(u1.x, u1.y); o.w = pk2(u1.z, u1.w); ((v4u*)U)[i] = o;
            o.x = pk2(v0.x, v0.y); o.y = pk2(v0.z, v0.w); o.z = pk2(v1.x, v1.y); o.w = pk2(v1.z, v1.w); ((v4u*)V)[i] = o; }
        for (size_t i = gt; i < (size_t)NTOK * PLE / 8; i += NGT) { const f32x4 u0 = ((const f32x4*)a.p)[2 * i], u1 = ((const f32x4*)a.p)[2 * i + 1];
            v4u o; o.x = pk2(u0.x, u0.y); o.y = pk2(u0.z, u0.w); o.z = pk2(u1.x, u1.y); o.w = pk2(u1.z, u1.w); ((v4u*)PP)[i] = o; }
        for (int i = gt; i < NTOK * 8; i += NGT) { const float ang = (float)a.pos[i >> 3] * a.freq[i & 7]; cs[i] = cosf(ang); sn[i] = sinf(ang); }
        for (int r = gw; r < NTOK; r += NGW) nv::rms_row<false>(r, lane, a.x, a.norm_mix, XN);
    }
    }
    xcd_barrier(bar);
    if (PH_MASK & (1u << 1)) {
    { pg8::Gemm g{XN, WIN, NTOK, DIN, DM}; pg8::StaticOrder S; S.init(NTOK, DIN, G, bx); pg8::EpiInProj E{Q, cs, sn};
      pg8::gemm_phase<pg8::EpiInProj, pg8::StaticOrder, true, true>(lds + RING_OFF, g, S, E); }
    }
    xcd_barrier(bar);
    if (PH_MASK & (1u << 2)) {
    att::phase(lds, Q, Kb, Vb, ATT, vcu, G);
    }
    xcd_barrier(bar);
    if (PH_MASK & (1u << 3)) {
    for (int t = gw; t < NTOK; t += NGW) nv::mix_token(t, lane, GLU, ATT, a.conv_w, a.conv_b, a.ln_g, a.ln_b, a.g_att, a.g_conv, Y);
    }
    xcd_barrier(bar);
    if (PH_MASK & (1u << 4)) {
    { pg8::Gemm g{Y, WOUT, NTOK, DM, DM}; pg8::StaticOrder S; S.init(NTOK, DM, G, bx); pg8::EpiResid E{a.x, H};
      pg8::gemm_phase<pg8::EpiResid, pg8::StaticOrder, false, true>(lds + RING_OFF, g, S, E); }
    }
    xcd_barrier(bar);
    if (PH_MASK & (1u << 5)) {
    for (int r = gw; r < NTOK; r += NGW) nv::rms_row<false>(r, lane, H, a.norm_ffn, XN);
    }
    xcd_barrier(bar);
    if (PH_MASK & (1u << 6)) {
    { pg8::Gemm g{XN, WQK, NTOK, 2048, DM}; pg8::StaticOrder S; S.init(NTOK, 2048, G, bx); pg8::EpiBf16<0> E{SC, 2048, nullptr, 0, 0, 1.f};
      pg8::gemm_phase<pg8::EpiBf16<0>, pg8::StaticOrder, true, true>(lds + RING_OFF, g, S, E); }
    }
    xcd_barrier(bar);
    if (PH_MASK & (1u << 7)) {
    for (int i = gt; i < NTOK * PH; i += NGT) nv::topk_item(i, SC, EID, GATE);
    }
    xcd_barrier(bar);
    if (PH_MASK & (1u << 8)) {
#ifndef PEER_DBG
#define PEER_DBG 0
#endif
    if (PEER_DBG == 2) { for (int t = gw; t < NTOK; t += NGW) peer::naive_u_token(t, lane, XN, U, EID, GATE); } else peer::phase_u(XN, U, EID, GATE, bx, G);
    xcd_barrier(bar);
    if (PEER_DBG == 1) { for (int t = gw; t < NTOK; t += NGW) peer::naive_v_token(t, lane, V, EID, GATE, H); } else peer::phase_v(V, EID, GATE, H, bx, G);
    }
    xcd_barrier(bar);
    if (PH_MASK & (1u << 9)) {
    for (int r = gw; r < NTOK; r += NGW) nv::rms_row<false>(r, lane, H, a.norm_ple, XN);
    }
    xcd_barrier(bar);
    if (PH_MASK & (1u << 10)) {
    { int kple = PLE; asm volatile("" : "+s"(kple));
      pg8::Gemm g{PP, WP, NTOK, DM, kple}; pg8::StaticOrder S; S.init(NTOK, DM, G, bx); pg8::EpiBf16<0> E{Y, DM, nullptr, 0, 0, 1.f};
      pg8::gemm_phase<pg8::EpiBf16<0>, pg8::StaticOrder, false, true>(lds + RING_OFF, g, S, E); }
    VM_WAIT(); __syncthreads();
    { pg8::Gemm g{XN, WG, NTOK, DM, DM}; pg8::StaticOrder S; S.init(NTOK, DM, G, bx); pg8::EpiPle E{H, Y};
      pg8::gemm_phase<pg8::EpiPle, pg8::StaticOrder, false, true>(lds + RING_OFF, g, S, E); }
    }
    xcd_barrier(bar);
    if (PH_MASK & (1u << 11)) {
    for (int r = gw; r < NTOK; r += NGW) nv::rms_row<true>(r, lane, H, a.fin, H);
    }
#undef H
#undef cs
#undef sn
#undef WIN
#undef WOUT
#undef WQK
#undef WG
#undef WP
#undef U
#undef V
#undef XN
#undef Q
#undef Kb
#undef Vb
#undef GLU
#undef SC
#undef ATT
#undef Y
#undef EID
#undef GATE
#undef PP
}

extern "C" void kernel_launch(void* const* d_in, const int* in_sizes, int n_in, void* d_out, int out_size, void* d_ws, size_t ws_size, hipStream_t stream) {
    static int grid = 0;
    if (grid == 0) {
        if (n_in != 21 || out_size != NTOK * DM || ws_size < WS_END) { fprintf(stderr, "kernel_launch: unexpected shapes n_in %d out %d ws %zu\n", n_in, out_size, ws_size); grid = -1; return; }
        int dev = 0, cus = 0, per_cu = 0;
        if (hipGetDevice(&dev) != hipSuccess || hipDeviceGetAttribute(&cus, hipDeviceAttributeMultiprocessorCount, dev) != hipSuccess) { grid = -1; return; }
        if (hipFuncSetAttribute((const void*)mega, hipFuncAttributeMaxDynamicSharedMemorySize, LDS_BYTES) != hipSuccess) { fprintf(stderr, "kernel_launch: hipFuncSetAttribute failed\n"); grid = -1; return; }
        if (hipOccupancyMaxActiveBlocksPerMultiprocessor(&per_cu, (const void*)mega, NWAVES * 64, LDS_BYTES) != hipSuccess || per_cu < 1) { fprintf(stderr, "kernel_launch: occupancy query says %d\n", per_cu); }
        (void)hipGetLastError();
        grid = cus;
    }
    if (grid < 0) return;
    (void)hipMemsetAsync((char*)d_ws + WS_CTL, 0, 1 * MiB, stream);
    Params a{};
    a.x = (const float*)d_in[0]; a.p = (const float*)d_in[1]; a.pos = (const int*)d_in[2]; a.norm_mix = (const float*)d_in[3]; a.w_in = (const float*)d_in[4]; a.conv_w = (const float*)d_in[5];
    a.conv_b = (const float*)d_in[6]; a.ln_g = (const float*)d_in[7]; a.ln_b = (const float*)d_in[8]; a.g_att = (const float*)d_in[9]; a.g_conv = (const float*)d_in[10]; a.w_out = (const float*)d_in[11];
    a.norm_ffn = (const float*)d_in[12]; a.wq = (const float*)d_in[13]; a.keys = (const float*)d_in[14]; a.eu = (const float*)d_in[15]; a.ev = (const float*)d_in[16]; a.norm_ple = (const float*)d_in[17];
    a.wg = (const float*)d_in[18]; a.wp = (const float*)d_in[19]; a.fin = (const float*)d_in[20]; a.out = (float*)d_out; a.ws = (unsigned char*)d_ws;
    for (int i = 0; i < 8; ++i) a.freq[i] = (float)pow(500000.0, -(double)i / 8.0);
    hipLaunchKernelGGL(mega, dim3(grid), dim3(NWAVES * 64), LDS_BYTES, stream, a);
}
```

```cpp
#include <hip/hip_runtime.h>
#include <cstdio>
#include <cstdint>
#include <cmath>

constexpr int BATCH = 2, SEQ = 8192, DM = 1024, NTOK = BATCH * SEQ;
constexpr int PLE = 256, HD = 64, NH = 8, DATT = 512, DCONV = 512, DIN = 2560, CW = 31;
constexpr int NKEYS = 128, NEXP = 16384, PH = 8, TOPK = 16, HK = PH * TOPK;
constexpr float EPS = 1e-6f;
constexpr float QSCALE = 0.125f * 1.4426950408889634f;

typedef unsigned short bf16;
typedef unsigned v4u __attribute__((ext_vector_type(4)));
typedef unsigned v2u __attribute__((ext_vector_type(2)));
typedef float f32x4 __attribute__((ext_vector_type(4)));

constexpr size_t MiB = 1u << 20;
constexpr size_t WS_CTL = 0;
constexpr size_t WS_ROPE = 1 * MiB;
constexpr size_t WS_WIN = 2 * MiB;
constexpr size_t WS_WOUT = 7 * MiB;
constexpr size_t WS_WQK = 9 * MiB;
constexpr size_t WS_WG = 13 * MiB;
constexpr size_t WS_WP = 15 * MiB;
constexpr size_t WS_U = 16 * MiB;
constexpr size_t WS_V = 48 * MiB;
constexpr size_t WS_XN = 80 * MiB;
constexpr size_t WS_Q = 112 * MiB, WS_K = 128 * MiB, WS_VV = 144 * MiB, WS_GLU = 160 * MiB;
constexpr size_t WS_SC = 112 * MiB;
constexpr size_t WS_ATT = 176 * MiB;
constexpr size_t WS_Y = 192 * MiB;
constexpr size_t WS_EID = 224 * MiB;
constexpr size_t WS_GATE = 232 * MiB;
constexpr size_t WS_PP = 240 * MiB;
constexpr size_t WS_MISC = 248 * MiB;
constexpr size_t WS_END = 256 * MiB;

__device__ __forceinline__ unsigned f2bf(float f) { unsigned u = __float_as_uint(f); return (u + 0x7fffu + ((u >> 16) & 1u)) >> 16; }
__device__ __forceinline__ float bf2f(unsigned h) { return __uint_as_float(h << 16); }
__device__ __forceinline__ unsigned pk2(float lo, float hi) { return f2bf(lo) | (f2bf(hi) << 16); }
__device__ __forceinline__ float bflo(unsigned w) { return __uint_as_float(w << 16); }
__device__ __forceinline__ float bfhi(unsigned w) { return __uint_as_float(w & 0xffff0000u); }
__device__ __forceinline__ float wave_sum(float v) {
#pragma unroll
    for (int o = 1; o < 64; o <<= 1) v += __shfl_xor(v, o);
    return v;
}
__device__ __forceinline__ float sigmoidf_(float x) { return 1.f / (1.f + __expf(-x)); }
__device__ __forceinline__ float gelu_erf(float x) { return 0.5f * x * (1.f + erff(x * 0.70710678118654752f)); }

__device__ __forceinline__ unsigned f2key(float f) { unsigned u = __float_as_uint(f); return (u & 0x80000000u) ? ~u : (u | 0x80000000u); }
__device__ __forceinline__ float key2f(unsigned k) { unsigned u = (k & 0x80000000u) ? (k & 0x7fffffffu) : ~k; return __uint_as_float(u); }
__device__ __forceinline__ void ins16(unsigned (&L)[16], unsigned x) {
#pragma unroll
    for (int i = 0; i < 16; ++i) { const unsigned h = L[i] > x ? L[i] : x; x = L[i] > x ? x : L[i]; L[i] = h; }
}
#define INS16(L, xx) ins16(L, (xx))
__device__ __forceinline__ int sel16(const int (&a)[16], int i) {
    int v0 = a[0], v1 = a[1], v2 = a[2], v3 = a[3], v4 = a[4], v5 = a[5], v6 = a[6], v7 = a[7], v8 = a[8], v9 = a[9], v10 = a[10], v11 = a[11], v12 = a[12], v13 = a[13], v14 = a[14], v15 = a[15];
    asm volatile("" : "+v"(v0), "+v"(v1), "+v"(v2), "+v"(v3), "+v"(v4), "+v"(v5), "+v"(v6), "+v"(v7));
    asm volatile("" : "+v"(v8), "+v"(v9), "+v"(v10), "+v"(v11), "+v"(v12), "+v"(v13), "+v"(v14), "+v"(v15));
    const bool b0 = i & 1, b1 = i & 2, b2 = i & 4, b3 = i & 8;
    const int t0 = b0 ? v1 : v0, t1 = b0 ? v3 : v2, t2 = b0 ? v5 : v4, t3 = b0 ? v7 : v6, t4 = b0 ? v9 : v8, t5 = b0 ? v11 : v10, t6 = b0 ? v13 : v12, t7 = b0 ? v15 : v14;
    const int s0 = b1 ? t1 : t0, s1 = b1 ? t3 : t2, s2 = b1 ? t5 : t4, s3 = b1 ? t7 : t6;
    const int r0 = b2 ? s1 : s0, r1 = b2 ? s3 : s2;
    return b3 ? r1 : r0;
}
__device__ __forceinline__ void topk_combine(const unsigned (&La)[16], const unsigned (&Lb)[16], int* eid_out, float* gate_out) {
    float a[16], b[16]; int ia[16], ib[16];
#pragma unroll
    for (int i = 0; i < 16; ++i) { a[i] = key2f(La[i] & ~127u); ia[i] = 127 - (int)(La[i] & 127u); b[i] = key2f(Lb[i] & ~127u); ib[i] = 127 - (int)(Lb[i] & 127u);
        asm volatile("" : "+v"(ia[i]), "+v"(ib[i])); }
    unsigned Lc[16];
#pragma unroll
    for (int i = 0; i < 16; ++i) Lc[i] = 0u;
#define TK_CAND(i, j) do { const float s_ = a[i] + b[j]; const unsigned k_ = (f2key(s_) & ~255u) | (unsigned)(255 - ((i) * 16 + (j))); INS16(Lc, k_); } while (0)
    TK_CAND(0, 0); TK_CAND(0, 1); TK_CAND(0, 2); TK_CAND(0, 3); TK_CAND(0, 4); TK_CAND(0, 5); TK_CAND(0, 6); TK_CAND(0, 7);
    TK_CAND(0, 8); TK_CAND(0, 9); TK_CAND(0, 10); TK_CAND(0, 11); TK_CAND(0, 12); TK_CAND(0, 13); TK_CAND(0, 14); TK_CAND(0, 15);
    TK_CAND(1, 0); TK_CAND(1, 1); TK_CAND(1, 2); TK_CAND(1, 3); TK_CAND(1, 4); TK_CAND(1, 5); TK_CAND(1, 6); TK_CAND(1, 7);
    TK_CAND(2, 0); TK_CAND(2, 1); TK_CAND(2, 2); TK_CAND(2, 3); TK_CAND(2, 4);
    TK_CAND(3, 0); TK_CAND(3, 1); TK_CAND(3, 2); TK_CAND(3, 3);
    TK_CAND(4, 0); TK_CAND(4, 1); TK_CAND(4, 2);
    TK_CAND(5, 0); TK_CAND(5, 1); TK_CAND(6, 0); TK_CAND(6, 1); TK_CAND(7, 0); TK_CAND(7, 1);
    TK_CAND(8, 0); TK_CAND(9, 0); TK_CAND(10, 0); TK_CAND(11, 0); TK_CAND(12, 0); TK_CAND(13, 0); TK_CAND(14, 0); TK_CAND(15, 0);
#undef TK_CAND
    float sv[16]; float m = -3.0e38f;
#pragma unroll
    for (int r = 0; r < 16; ++r) { sv[r] = key2f(Lc[r] & ~255u); m = fmaxf(m, sv[r]); }
    float sum = 0.f;
#pragma unroll
    for (int r = 0; r < 16; ++r) { sv[r] = __expf(sv[r] - m); sum += sv[r]; }
    const float inv = 1.f / sum;
#pragma unroll
    for (int r = 0; r < 16; ++r) { const int c = 255 - (int)(Lc[r] & 255u); const int i1 = sel16(ia, c >> 4), i2 = sel16(ib, c & 15);
        eid_out[r] = i1 * NKEYS + i2; gate_out[r] = sv[r] * inv; }
}
namespace nv {
__device__ __forceinline__ int win_srccol(int n) { if (n < 1536) return n; const int j = n - 1536, u = j >> 8, r = j & 255; return r < 128 ? 1536 + 128 * u + r : 2048 + 128 * u + (r - 128); }
__global__ void transpose_w(const float* W, int K, int NW, int N, bf16* WT, int mode) {
    const size_t i = (size_t)blockIdx.x * blockDim.x + threadIdx.x; if (i >= (size_t)N * K) return;
    const int n = (int)(i / K), k = (int)(i % K); const int c = mode == 1 ? win_srccol(n) : n;
    WT[i] = (bf16)f2bf(W[(size_t)k * NW + c]);
}
__global__ void fold_wq(const float* wq, const float* keys, bf16* WQK) {
    const size_t i = (size_t)blockIdx.x * blockDim.x + threadIdx.x; if (i >= (size_t)2048 * 1024) return;
    const int n = (int)(i / 1024), d = (int)(i % 1024); const int hp = n >> 7, kk = n & 127, p = hp & 1;
    const float* w = wq + (size_t)d * 2048 + hp * 128; const float* kr = keys + ((size_t)p * 128 + kk) * 128; float s = 0.f;
    for (int c = 0; c < 128; ++c) s += w[c] * kr[c];
    WQK[i] = (bf16)f2bf(s);
}
__global__ void cvt_bf16(const float* src, bf16* dst, size_t n) { const size_t i = (size_t)blockIdx.x * blockDim.x + threadIdx.x; if (i < n) dst[i] = (bf16)f2bf(src[i]); }
struct Freq { float f[8]; };
__global__ void rope_table(const int* pos, float* cs, float* sn, Freq fr) {
    const int i = blockIdx.x * blockDim.x + threadIdx.x; if (i >= NTOK * 8) return;
    const float ang = (float)pos[i >> 3] * fr.f[i & 7]; cs[i] = cosf(ang); sn[i] = sinf(ang);
}
template <bool OUTF32> __device__ __forceinline__ void rms_row(int row, int lane, const float* in, const float* g, void* out) {
    const f32x4* xr = (const f32x4*)(in + (size_t)row * DM) + lane; f32x4 v[4]; float s = 0.f;
#pragma unroll
    for (int j = 0; j < 4; ++j) { v[j] = xr[64 * j]; s += v[j].x * v[j].x + v[j].y * v[j].y + v[j].z * v[j].z + v[j].w * v[j].w; }
    const float r = rsqrtf(wave_sum(s) * (1.f / DM) + EPS);
#pragma unroll
    for (int j = 0; j < 4; ++j) { const f32x4 gg = ((const f32x4*)g)[lane + 64 * j]; const f32x4 o = v[j] * r * gg;
        if (OUTF32) ((f32x4*)((float*)out + (size_t)row * DM))[lane + 64 * j] = o;
        else { v2u w; w.x = pk2(o.x, o.y); w.y = pk2(o.z, o.w); ((v2u*)((bf16*)out + (size_t)row * DM))[lane + 64 * j] = w; } }
}
template <bool OUTF32> __global__ void rms_rows(const float* in, const float* g, void* out) {
    const int row = blockIdx.x * 4 + (threadIdx.x >> 6); if (row >= NTOK) return; rms_row<OUTF32>(row, threadIdx.x & 63, in, g, out);
}
struct GP { const bf16* A; const bf16* Bt; const float* cs; const float* sn; bf16 *Q, *Kb, *Vb, *GLU; const float* x; float* H; bf16* O; const bf16* PPO; int M, N, K, pad; };
__device__ __forceinline__ void dot4(const bf16* A, const bf16* Bt, int K, int m0, int n, float (&acc)[4]) {
    const v4u* b = (const v4u*)(Bt + (size_t)n * K);
#pragma unroll
    for (int r = 0; r < 4; ++r) acc[r] = 0.f;
    for (int kc = 0; kc < K / 8; ++kc) { const v4u bw = b[kc];
#pragma unroll
        for (int r = 0; r < 4; ++r) { const v4u aw = ((const v4u*)(A + (size_t)(m0 + r) * K))[kc];
            acc[r] += bflo(aw.x) * bflo(bw.x) + bfhi(aw.x) * bfhi(bw.x) + bflo(aw.y) * bflo(bw.y) + bfhi(aw.y) * bfhi(bw.y) + bflo(aw.z) * bflo(bw.z) + bfhi(aw.z) * bfhi(bw.z) + bflo(aw.w) * bflo(bw.w) + bfhi(aw.w) * bfhi(bw.w); } }
}
template <int EPI> __global__ void gemm(GP p) {
    const int n = blockIdx.x * 256 + threadIdx.x, m0 = blockIdx.y * 4; if (n >= p.N) return;
    float acc[4];
    if (EPI == 1) {
        if (n < 1024) {
            dot4(p.A, p.Bt, p.K, m0, n, acc); const int hc = n & 63;
            if (hc < 16) { float pa[4]; dot4(p.A, p.Bt, p.K, m0, n ^ 8, pa);
#pragma unroll
                for (int r = 0; r < 4; ++r) { const float c = p.cs[(size_t)(m0 + r) * 8 + (hc & 7)], s = p.sn[(size_t)(m0 + r) * 8 + (hc & 7)];
                    acc[r] = (hc & 8) ? acc[r] * c + pa[r] * s : acc[r] * c - pa[r] * s; } }
#pragma unroll
            for (int r = 0; r < 4; ++r) { if (n < 512) p.Q[(size_t)(m0 + r) * 512 + n] = (bf16)f2bf(acc[r] * QSCALE); else p.Kb[(size_t)(m0 + r) * 512 + n - 512] = (bf16)f2bf(acc[r]); }
        } else if (n < 1536) { dot4(p.A, p.Bt, p.K, m0, n, acc);
#pragma unroll
            for (int r = 0; r < 4; ++r) p.Vb[(size_t)(m0 + r) * 512 + n - 1024] = (bf16)f2bf(acc[r]);
        } else { const int j = n - 1536, u = j >> 8, rr = j & 255; if (rr >= 128) return; float g[4]; dot4(p.A, p.Bt, p.K, m0, n, acc); dot4(p.A, p.Bt, p.K, m0, n + 128, g);
#pragma unroll
            for (int r = 0; r < 4; ++r) p.GLU[(size_t)(m0 + r) * 512 + 128 * u + rr] = (bf16)f2bf(acc[r] * sigmoidf_(g[r])); }
    } else {
        dot4(p.A, p.Bt, p.K, m0, n, acc);
#pragma unroll
        for (int r = 0; r < 4; ++r) { const size_t o = (size_t)(m0 + r) * p.N + n;
            if (EPI == 2) p.H[o] = p.x[o] + acc[r];
            if (EPI == 3) p.O[o] = (bf16)f2bf(acc[r]);
            if (EPI == 4) p.H[o] = p.H[o] + sigmoidf_(acc[r]) * bf2f(p.PPO[o]); }
    }
}
__device__ __forceinline__ void attn_item(int gw, int lane, const bf16* Q, const bf16* Kb, const bf16* Vb, bf16* ATT) {
    const int tok = gw >> 3, h = gw & 7, b = tok / SEQ, s = tok % SEQ;
    const float q = bf2f(Q[(size_t)tok * 512 + h * 64 + lane]);
    float o[3], lse[3]; const int dil[3] = {1, 4, 16};
#pragma unroll
    for (int p = 0; p < 3; ++p) { float m = -3.0e38f, l = 0.f, acc = 0.f;
        for (int j = 0; j <= 128; ++j) { const int tk = s - j * dil[p]; if (tk < 0) break; const size_t kr = ((size_t)b * SEQ + tk) * 512 + h * 64 + lane;
            const float sc = wave_sum(q * bf2f(Kb[kr])); const float mn = fmaxf(m, sc), al = exp2f(m - mn), pe = exp2f(sc - mn);
            l = l * al + pe; acc = acc * al + pe * bf2f(Vb[kr]); m = mn; }
        o[p] = acc / l; lse[p] = m + log2f(l); }
    const float M = fmaxf(lse[0], fmaxf(lse[1], lse[2])); const float w0 = exp2f(lse[0] - M), w1 = exp2f(lse[1] - M), w2 = exp2f(lse[2] - M);
    ATT[(size_t)tok * 512 + h * 64 + lane] = (bf16)f2bf((w0 * o[0] + w1 * o[1] + w2 * o[2]) / (w0 + w1 + w2));
}
__global__ void attn(const bf16* Q, const bf16* Kb, const bf16* Vb, bf16* ATT) {
    const int gw = blockIdx.x * 4 + (threadIdx.x >> 6); if (gw >= NTOK * NH) return; attn_item(gw, threadIdx.x & 63, Q, Kb, Vb, ATT);
}
__device__ __forceinline__ void mix_token(int tok, int lane, const bf16* GLU, const bf16* ATT, const float* cw, const float* cb, const float* lg, const float* lb, const float* ga, const float* gc, bf16* Y) {
    const int s = tok % SEQ, c0 = lane * 8; float acc[8];
    { const f32x4 b0 = *(const f32x4*)(cb + c0), b1 = *(const f32x4*)(cb + c0 + 4); acc[0] = b0.x; acc[1] = b0.y; acc[2] = b0.z; acc[3] = b0.w; acc[4] = b1.x; acc[5] = b1.y; acc[6] = b1.z; acc[7] = b1.w; }
    for (int j = 0; j < CW; ++j) { const int ts = s - (CW - 1) + j; if (ts < 0) continue;
        const v4u g = *(const v4u*)(GLU + (size_t)(tok - (CW - 1) + j) * 512 + c0); const f32x4 w0 = *(const f32x4*)(cw + j * 512 + c0), w1 = *(const f32x4*)(cw + j * 512 + c0 + 4);
        acc[0] += w0.x * bflo(g.x); acc[1] += w0.y * bfhi(g.x); acc[2] += w0.z * bflo(g.y); acc[3] += w0.w * bfhi(g.y); acc[4] += w1.x * bflo(g.z); acc[5] += w1.y * bfhi(g.z); acc[6] += w1.z * bflo(g.w); acc[7] += w1.w * bfhi(g.w); }
    float sm = 0.f;
#pragma unroll
    for (int i = 0; i < 8; ++i) sm += acc[i];
    const float mean = wave_sum(sm) * (1.f / 512.f); float sq = 0.f;
#pragma unroll
    for (int i = 0; i < 8; ++i) { acc[i] -= mean; sq += acc[i] * acc[i]; }
    const float rstd = rsqrtf(wave_sum(sq) * (1.f / 512.f) + EPS); float ss = 0.f;
#pragma unroll
    for (int i = 0; i < 8; ++i) { const float y = acc[i] * rstd * lg[c0 + i] + lb[c0 + i]; acc[i] = y * sigmoidf_(y); ss += acc[i] * acc[i]; }
    const float rc = rsqrtf(wave_sum(ss) * (1.f / 512.f) + EPS);
    v4u o; o.x = pk2(acc[0] * rc * gc[c0 + 0], acc[1] * rc * gc[c0 + 1]); o.y = pk2(acc[2] * rc * gc[c0 + 2], acc[3] * rc * gc[c0 + 3]); o.z = pk2(acc[4] * rc * gc[c0 + 4], acc[5] * rc * gc[c0 + 5]); o.w = pk2(acc[6] * rc * gc[c0 + 6], acc[7] * rc * gc[c0 + 7]);
    *(v4u*)(Y + (size_t)tok * 1024 + 512 + c0) = o;
    const v4u a = *(const v4u*)(ATT + (size_t)tok * 512 + c0); float av[8] = {bflo(a.x), bfhi(a.x), bflo(a.y), bfhi(a.y), bflo(a.z), bfhi(a.z), bflo(a.w), bfhi(a.w)}; float sa = 0.f;
#pragma unroll
    for (int i = 0; i < 8; ++i) sa += av[i] * av[i];
    const float ra = rsqrtf(wave_sum(sa) * (1.f / 512.f) + EPS);
    v4u oa; oa.x = pk2(av[0] * ra * ga[c0 + 0], av[1] * ra * ga[c0 + 1]); oa.y = pk2(av[2] * ra * ga[c0 + 2], av[3] * ra * ga[c0 + 3]); oa.z = pk2(av[4] * ra * ga[c0 + 4], av[5] * ra * ga[c0 + 5]); oa.w = pk2(av[6] * ra * ga[c0 + 6], av[7] * ra * ga[c0 + 7]);
    *(v4u*)(Y + (size_t)tok * 1024 + c0) = oa;
}
__global__ void mix_norm(const bf16* GLU, const bf16* ATT, const float* cw, const float* cb, const float* lg, const float* lb, const float* ga, const float* gc, bf16* Y) {
    const int tok = blockIdx.x * 4 + (threadIdx.x >> 6); if (tok >= NTOK) return; mix_token(tok, threadIdx.x & 63, GLU, ATT, cw, cb, lg, lb, ga, gc, Y);
}
__device__ __forceinline__ void topk_item(int i, const bf16* SC, int* EID, float* GATE) {
    const bf16* row = SC + (size_t)i * 256; unsigned La[16], Lb[16];
#pragma unroll
    for (int q = 0; q < 16; ++q) { La[q] = 0u; Lb[q] = 0u; }
    for (int c = 0; c < 128; ++c) { const unsigned k = (f2key(bf2f(row[c])) & ~127u) | (unsigned)(127 - c); INS16(La, k); }
    for (int c = 0; c < 128; ++c) { const unsigned k = (f2key(bf2f(row[128 + c])) & ~127u) | (unsigned)(127 - c); INS16(Lb, k); }
    int e[16]; float g[16]; topk_combine(La, Lb, e, g);
#pragma unroll
    for (int r = 0; r < 16; ++r) { EID[(size_t)i * 16 + r] = e[r]; GATE[(size_t)i * 16 + r] = g[r]; }
}
__global__ void topk(const bf16* SC, int* EID, float* GATE) {
    const int i = blockIdx.x * blockDim.x + threadIdx.x; if (i >= NTOK * PH) return; topk_item(i, SC, EID, GATE);
}
__device__ __forceinline__ void peer_token(int tok, int lane, const bf16* XN, const bf16* U, const bf16* V, const int* EID, const float* GATE, float* H) {
    float x[16], y[16];
    { const v4u a = ((const v4u*)(XN + (size_t)tok * 1024))[lane * 2], b = ((const v4u*)(XN + (size_t)tok * 1024))[lane * 2 + 1];
      x[0] = bflo(a.x); x[1] = bfhi(a.x); x[2] = bflo(a.y); x[3] = bfhi(a.y); x[4] = bflo(a.z); x[5] = bfhi(a.z); x[6] = bflo(a.w); x[7] = bfhi(a.w);
      x[8] = bflo(b.x); x[9] = bfhi(b.x); x[10] = bflo(b.y); x[11] = bfhi(b.y); x[12] = bflo(b.z); x[13] = bfhi(b.z); x[14] = bflo(b.w); x[15] = bfhi(b.w); }
#pragma unroll
    for (int i = 0; i < 16; ++i) y[i] = 0.f;
    for (int k = 0; k < HK; ++k) { const int e = EID[(size_t)tok * HK + k]; const float g = GATE[(size_t)tok * HK + k];
        const v4u a = ((const v4u*)(U + (size_t)e * 1024))[lane * 2], b = ((const v4u*)(U + (size_t)e * 1024))[lane * 2 + 1];
        float d = x[0] * bflo(a.x) + x[1] * bfhi(a.x) + x[2] * bflo(a.y) + x[3] * bfhi(a.y) + x[4] * bflo(a.z) + x[5] * bfhi(a.z) + x[6] * bflo(a.w) + x[7] * bfhi(a.w)
                + x[8] * bflo(b.x) + x[9] * bfhi(b.x) + x[10] * bflo(b.y) + x[11] * bfhi(b.y) + x[12] * bflo(b.z) + x[13] * bfhi(b.z) + x[14] * bflo(b.w) + x[15] * bfhi(b.w);
        d = wave_sum(d); const float act = gelu_erf(d) * g;
        const v4u c = ((const v4u*)(V + (size_t)e * 1024))[lane * 2], dd = ((const v4u*)(V + (size_t)e * 1024))[lane * 2 + 1];
        y[0] += act * bflo(c.x); y[1] += act * bfhi(c.x); y[2] += act * bflo(c.y); y[3] += act * bfhi(c.y); y[4] += act * bflo(c.z); y[5] += act * bfhi(c.z); y[6] += act * bflo(c.w); y[7] += act * bfhi(c.w);
        y[8] += act * bflo(dd.x); y[9] += act * bfhi(dd.x); y[10] += act * bflo(dd.y); y[11] += act * bfhi(dd.y); y[12] += act * bflo(dd.z); y[13] += act * bfhi(dd.z); y[14] += act * bflo(dd.w); y[15] += act * bfhi(dd.w); }
    float* hr = H + (size_t)tok * 1024 + lane * 16;
#pragma unroll
    for (int i = 0; i < 4; ++i) { f32x4 v = ((f32x4*)hr)[i]; v.x += y[4 * i]; v.y += y[4 * i + 1]; v.z += y[4 * i + 2]; v.w += y[4 * i + 3]; ((f32x4*)hr)[i] = v; }
}
__global__ void peer(const bf16* XN, const bf16* U, const bf16* V, const int* EID, const float* GATE, float* H) {
    const int tok = blockIdx.x * 4 + (threadIdx.x >> 6); if (tok >= NTOK) return; peer_token(tok, threadIdx.x & 63, XN, U, V, EID, GATE, H);
}
}
namespace pg8 {
#define PG8_LAS __attribute__((address_space(3)))
typedef unsigned short bf16_t;
typedef short bf16x8 __attribute__((ext_vector_type(8)));
typedef float f32x4 __attribute__((ext_vector_type(4)));
typedef unsigned u32x4 __attribute__((ext_vector_type(4)));
constexpr int BM = 256, BK = 64, HALF = 128, HTB = HALF * BK * 2  , STAGE_BYTES = 8 * HTB, NXCD = 8, WGM = 8;

__host__ __device__ __forceinline__ int lds_byte(int r, int c) { const int st = (r >> 4) * 2 + (c >> 5), rr = r & 15, cc = c & 31, ob = rr * 64 + cc * 2; return st * 1024 + (ob ^ (((ob >> 9) & 1) << 5)); }
__host__ __device__ __forceinline__ void stage_rc(int b, int& R, int& C) { const int st = b / 1024, sb = b % 1024, swz = sb ^ (((sb >> 9) & 1) << 5); R = (st >> 1) * 16 + swz / 64; C = (st & 1) * 32 + (swz % 64) / 2; }
__host__ __device__ __forceinline__ int perm32(int rho) { const int n = rho >> 4, i = rho & 15; return 8 * (i >> 2) + 4 * n + (i & 3); }

struct Unit { int pm, pn; };
struct Gemm { const bf16_t* A; const bf16_t* Bt; int M, N, K; };

struct StaticOrder {
    int nM, nN, nwg, G, c;
    __host__ __device__ void init(int M, int N, int G_, int c_) { nM = M / BM; nN = N / BM; nwg = nM * nN; G = G_; c = c_; }
    __host__ __device__ bool next(int i, Unit& u) const {
        const long L = (long)i * G + c; if (L >= nwg) return false;
        int wgid = (int)L; { const int q = nwg / NXCD, r = nwg % NXCD, xcd = wgid % NXCD, off = wgid / NXCD; wgid = (xcd < r ? xcd * (q + 1) : r * (q + 1) + (xcd - r) * q) + off; }
        const int nig = WGM * nN, gid = wgid / nig, fm = gid * WGM, gsz = (nM - fm) < WGM ? (nM - fm) : WGM;
        u.pm = fm + ((wgid % nig) % gsz); u.pn = (wgid % nig) / gsz; return true;
    }
    __device__ __forceinline__ void a_ready(const Unit&) const {}
    __device__ __forceinline__ void done(const Unit&) const {}
};

__device__ __forceinline__ unsigned cvt_pk_bf16(float lo, float hi) { unsigned r; asm volatile("v_cvt_pk_bf16_f32 %0, %1, %2" : "=v"(r) : "v"(lo), "v"(hi)); return r; }
typedef float f32x2 __attribute__((ext_vector_type(2)));
__device__ __forceinline__ f32x2 gelu_pk(f32x2 v) {
    const f32x2 av = __builtin_elementwise_abs(v), d = av * 0.2316418882f + 1.0f;
    f32x2 t; t.x = __builtin_amdgcn_rcpf(d.x); t.y = __builtin_amdgcn_rcpf(d.y);
    f32x2 q = t * 0.5307027145f + (-0.7265760135f); q = q * t + 0.7107068705f; q = q * t + (-0.142248368f); q = q * t + 0.127414796f; q = q * t;
    const f32x2 s = (v * v) * (-0.72134752044f);
    f32x2 e; e.x = __builtin_amdgcn_exp2f(s.x); e.y = __builtin_amdgcn_exp2f(s.y);
    const f32x2 m = v * (q * e), r = v - m;
    f32x2 o; o.x = v.x < 0.f ? m.x : r.x; o.y = v.y < 0.f ? m.y : r.y; return o;
}

template <int ACT  > struct EpiBf16 {
    static constexpr bool PERM = true, AFTER_DRAIN = false; static_assert(ACT == 0 || ACT == 1, "EpiBf16: ACT is 0 (none) or 1 (gelu_pk)");
    bf16_t* O; int ldc; const float* bias; int split_cols; size_t split_stride; float scale0;
    __device__ __forceinline__ void operator()(const f32x4 (&acc)[2][2][4][2], const Unit& u, int wr, int wc, int fr, int fq) const {
        const int row0 = u.pm * BM + wr * 64 + fr; int colt = u.pn * BM; bf16_t* base = O;
        float sc = 1.f; if (split_cols) { const int t = colt / split_cols; base += (size_t)t * split_stride; colt -= t * split_cols; if (t == 0) sc = scale0; }
        const int col0 = colt + wc * 32 + 8 * fq, bcol0 = u.pn * BM + wc * 32 + 8 * fq;
        f32x4 bv[2][2];
#pragma unroll
        for (int bj = 0; bj < 2; ++bj)
#pragma unroll
            for (int n = 0; n < 2; ++n) bv[bj][n] = bias ? *(const f32x4*)(bias + bcol0 + bj * HALF + 4 * n) : (f32x4){0.f, 0.f, 0.f, 0.f};
#pragma unroll
        for (int ai = 0; ai < 2; ++ai)
#pragma unroll
            for (int m = 0; m < 4; ++m) { bf16_t* rowp = base + (size_t)(row0 + ai * HALF + m * 16) * ldc + col0;
#pragma unroll
                for (int bj = 0; bj < 2; ++bj) { f32x4 v0 = acc[ai][bj][m][0] + bv[bj][0], v1 = acc[ai][bj][m][1] + bv[bj][1];
                    if (ACT == 1) { f32x2 a = gelu_pk((f32x2){v0[0], v0[1]}), b = gelu_pk((f32x2){v0[2], v0[3]}), c = gelu_pk((f32x2){v1[0], v1[1]}), d = gelu_pk((f32x2){v1[2], v1[3]});
                        v0 = (f32x4){a.x, a.y, b.x, b.y}; v1 = (f32x4){c.x, c.y, d.x, d.y}; }
                    v0 = v0 * sc; v1 = v1 * sc; u32x4 w; w.x = cvt_pk_bf16(v0[0], v0[1]); w.y = cvt_pk_bf16(v0[2], v0[3]); w.z = cvt_pk_bf16(v1[0], v1[1]); w.w = cvt_pk_bf16(v1[2], v1[3]);
                    *(u32x4*)(rowp + bj * HALF) = w; } }
    }
};
struct EpiInProj {
    static constexpr bool PERM = true, AFTER_DRAIN = false;
    bf16_t* QKVG; const float* cs; const float* sn;
    __device__ __forceinline__ void operator()(const f32x4 (&acc)[2][2][4][2], const Unit& u, int wr, int wc, int fr, int fq) const {
        const int row0 = u.pm * BM + wr * 64 + fr;
        if (u.pn < 6) {
            bf16_t* dst = QKVG + (size_t)(u.pn >> 1) * ((size_t)16384 * 512);
            const int col0 = (u.pn & 1) * 256 + wc * 32 + 8 * fq;
            const bool rope_wave = (u.pn < 4) && ((wc & 1) == 0);
            const float sc = u.pn < 2 ? 0.125f * 1.4426950408889634f : 1.f;
#pragma unroll
            for (int ai = 0; ai < 2; ++ai)
#pragma unroll
                for (int m = 0; m < 4; ++m) { const int row = row0 + ai * HALF + m * 16;
                    f32x4 c0 = {1.f, 1.f, 1.f, 1.f}, c1 = c0, s0 = {0.f, 0.f, 0.f, 0.f}, s1 = s0;
                    if (rope_wave) { c0 = *(const f32x4*)(cs + (size_t)row * 8); c1 = *(const f32x4*)(cs + (size_t)row * 8 + 4); s0 = *(const f32x4*)(sn + (size_t)row * 8); s1 = *(const f32x4*)(sn + (size_t)row * 8 + 4); }
#pragma unroll
                    for (int bj = 0; bj < 2; ++bj) { f32x4 v0 = acc[ai][bj][m][0], v1 = acc[ai][bj][m][1];
                        if (rope_wave) { f32x4 p0, p1;
                            p0.x = __shfl_xor(v0.x, 16); p0.y = __shfl_xor(v0.y, 16); p0.z = __shfl_xor(v0.z, 16); p0.w = __shfl_xor(v0.w, 16);
                            p1.x = __shfl_xor(v1.x, 16); p1.y = __shfl_xor(v1.y, 16); p1.z = __shfl_xor(v1.z, 16); p1.w = __shfl_xor(v1.w, 16);
                            if (fq == 0) { v0 = v0 * c0 - p0 * s0; v1 = v1 * c1 - p1 * s1; }
                            else if (fq == 1) { v0 = v0 * c0 + p0 * s0; v1 = v1 * c1 + p1 * s1; } }
                        v0 = v0 * sc; v1 = v1 * sc; u32x4 w; w.x = cvt_pk_bf16(v0[0], v0[1]); w.y = cvt_pk_bf16(v0[2], v0[3]); w.z = cvt_pk_bf16(v1[0], v1[1]); w.w = cvt_pk_bf16(v1[2], v1[3]);
                        *(u32x4*)(dst + (size_t)row * 512 + col0 + bj * HALF) = w; } }
        } else {
            const int ch0 = (u.pn - 6) * 128 + wc * 32 + 8 * fq;
#pragma unroll
            for (int ai = 0; ai < 2; ++ai)
#pragma unroll
                for (int m = 0; m < 4; ++m) { const int row = row0 + ai * HALF + m * 16;
                    const f32x4 a0 = acc[ai][0][m][0], g0 = acc[ai][1][m][0], a1 = acc[ai][0][m][1], g1 = acc[ai][1][m][1];
#define GLU1(av, gv) ((av) * __builtin_amdgcn_rcpf(1.f + __expf(-(gv))))
                    u32x4 w; w.x = cvt_pk_bf16(GLU1(a0.x, g0.x), GLU1(a0.y, g0.y)); w.y = cvt_pk_bf16(GLU1(a0.z, g0.z), GLU1(a0.w, g0.w)); w.z = cvt_pk_bf16(GLU1(a1.x, g1.x), GLU1(a1.y, g1.y)); w.w = cvt_pk_bf16(GLU1(a1.z, g1.z), GLU1(a1.w, g1.w));
#undef GLU1
                    *(u32x4*)(QKVG + (size_t)3 * 16384 * 512 + (size_t)row * 512 + ch0) = w; }
        }
    }
};
struct EpiResid {
    static constexpr bool PERM = false, AFTER_DRAIN = false;
    const float* base; float* H;
    __device__ __forceinline__ void operator()(const f32x4 (&acc)[2][2][4][2], const Unit& u, int wr, int wc, int fr, int fq) const {
        const int row0 = u.pm * BM + wr * 64 + fr, col0 = u.pn * BM + wc * 32 + 4 * fq;
#pragma unroll
        for (int ai = 0; ai < 2; ++ai)
#pragma unroll
            for (int m = 0; m < 4; ++m) { const size_t ro = (size_t)(row0 + ai * HALF + m * 16) * 1024 + col0;
#pragma unroll
                for (int bj = 0; bj < 2; ++bj)
#pragma unroll
                    for (int n = 0; n < 2; ++n) { const size_t o = ro + bj * HALF + n * 16; *(f32x4*)(H + o) = *(const f32x4*)(base + o) + acc[ai][bj][m][n]; }
                if (m & 1) asm volatile("" ::: "memory"); }
    }
};
struct EpiPle {
    static constexpr bool PERM = false, AFTER_DRAIN = false;
    float* H; const bf16_t* PPO;
    __device__ __forceinline__ void operator()(const f32x4 (&acc)[2][2][4][2], const Unit& u, int wr, int wc, int fr, int fq) const {
        typedef unsigned u32x2 __attribute__((ext_vector_type(2)));
        const int row0 = u.pm * BM + wr * 64 + fr, col0 = u.pn * BM + wc * 32 + 4 * fq;
#pragma unroll
        for (int ai = 0; ai < 2; ++ai)
#pragma unroll
            for (int m = 0; m < 4; ++m) { const size_t ro = (size_t)(row0 + ai * HALF + m * 16) * 1024 + col0;
#pragma unroll
                for (int bj = 0; bj < 2; ++bj)
#pragma unroll
                    for (int n = 0; n < 2; ++n) { const size_t o = ro + bj * HALF + n * 16; const u32x2 pw = *(const u32x2*)(PPO + o); const f32x4 a = acc[ai][bj][m][n]; f32x4 h = *(const f32x4*)(H + o);
                        h[0] += __builtin_amdgcn_rcpf(1.f + __expf(-a[0])) * __uint_as_float(pw.x << 16); h[1] += __builtin_amdgcn_rcpf(1.f + __expf(-a[1])) * __uint_as_float(pw.x & 0xffff0000u);
                        h[2] += __builtin_amdgcn_rcpf(1.f + __expf(-a[2])) * __uint_as_float(pw.y << 16); h[3] += __builtin_amdgcn_rcpf(1.f + __expf(-a[3])) * __uint_as_float(pw.y & 0xffff0000u);
                        *(f32x4*)(H + o) = h; }
                if (m & 1) asm volatile("" ::: "memory"); }
    }
};
template <class Epi, class Sched, bool ALIGN_EPI = false, bool SP2 = false>
__device__ __forceinline__ void gemm_phase(PG8_LAS unsigned char* lds, const Gemm g, const Sched& S, const Epi& E) {
    int tid_ = threadIdx.x; asm volatile("" : "+v"(tid_));
    const int tid = tid_, wid = __builtin_amdgcn_readfirstlane(tid >> 6), lane = tid & 63, wr = wid >> 2, wc = wid & 3, fr = lane & 15, fq = lane >> 4;
    const int K = g.K, nt = K / BK;
    unsigned voffA[2], voffB[2];
#pragma unroll
    for (int i = 0; i < 2; ++i) { int R, C; stage_rc(tid * 16 + i * 8192, R, C); const int Rb = Epi::PERM ? ((R & ~31) + perm32(R & 31)) : R;
        voffA[i] = (unsigned)(R * K + C) * 2u; voffB[i] = (unsigned)(Rb * K + C) * 2u; }
    const size_t kstep = (size_t)(BK * 2);
    const size_t hstep = (size_t)HALF * K * 2;
    const size_t tstep = 2 * hstep;
    const unsigned ldsw = (unsigned)wid * 1024u;
    const int aoff = lds_byte(wr * 64 + fr, fq * 8), boff = lds_byte(wc * 32 + fr, fq * 8);
#define PG8_SA(b, h) (((b) * 2 + (h)) * HTB)
#define PG8_SB(b, h) ((4 + (b) * 2 + (h)) * HTB)
#define PG8_STAGE(bufoff, gbase, voff) do { _Pragma("unroll") for (int _i = 0; _i < 2; ++_i) \
        __builtin_amdgcn_global_load_lds((const unsigned*)((const char*)(gbase) + (voff)[_i]), (PG8_LAS unsigned*)(lds + (bufoff) + ldsw + _i * 8192), 16, 0, 0); } while (0)
#define PG8_LDA(dst, b, h) do { _Pragma("unroll") for (int m = 0; m < 4; ++m) _Pragma("unroll") for (int k = 0; k < 2; ++k) dst[m][k] = *(const PG8_LAS bf16x8*)(lds + PG8_SA(b, h) + aoff + m * 2048 + k * 1024); } while (0)
#define PG8_LDB(dst, b, h) do { _Pragma("unroll") for (int n = 0; n < 2; ++n) _Pragma("unroll") for (int k = 0; k < 2; ++k) dst[n][k] = *(const PG8_LAS bf16x8*)(lds + PG8_SB(b, h) + boff + n * 2048 + k * 1024); } while (0)
#define PG8_MMA(ai, bj, At, Bt) do { __builtin_amdgcn_s_setprio(1); _Pragma("unroll") for (int m = 0; m < 4; ++m) _Pragma("unroll") for (int n = 0; n < 2; ++n) _Pragma("unroll") for (int k = 0; k < 2; ++k) \
        acc[ai][bj][m][n] = __builtin_amdgcn_mfma_f32_16x16x32_bf16(Bt[n][k], At[m][k], acc[ai][bj][m][n], 0, 0, 0); __builtin_amdgcn_s_setprio(0); } while (0)
#define PG8_WAIT_V(n) asm volatile("s_waitcnt vmcnt(" #n ")" ::: "memory")
#define PG8_WAIT_L(n) asm volatile("s_waitcnt lgkmcnt(" #n ")" ::: "memory")
#define PG8_BAR __builtin_amdgcn_s_barrier()
#define PG8_SCHED __builtin_amdgcn_sched_barrier(0)
    Unit cur, nxt; int ui = 0;
    if (!S.next(0, cur)) return;
    f32x4 acc[2][2][4][2];
#pragma unroll
    for (int a = 0; a < 2; ++a)
#pragma unroll
        for (int b = 0; b < 2; ++b)
#pragma unroll
            for (int m = 0; m < 4; ++m)
#pragma unroll
                for (int n = 0; n < 2; ++n) acc[a][b][m][n] = (f32x4){0.f, 0.f, 0.f, 0.f};
    bf16x8 At[4][2], B0[2][2], B1[2][2];
    const char* cA = (const char*)g.A + (size_t)cur.pm * tstep; const char* cB = (const char*)g.Bt + (size_t)cur.pn * tstep;
    S.a_ready(cur);
    if constexpr (SP2) {
        PG8_STAGE(PG8_SB(0, 0), cB, voffB); PG8_STAGE(PG8_SB(0, 1), cB + hstep, voffB); PG8_STAGE(PG8_SA(0, 0), cA, voffA); PG8_STAGE(PG8_SA(0, 1), cA + hstep, voffA);
        if (wr == 1) PG8_BAR;
        PG8_WAIT_V(2); PG8_BAR;
        PG8_STAGE(PG8_SB(1, 0), cB + kstep, voffB); PG8_STAGE(PG8_SA(1, 0), cA + kstep, voffA); PG8_STAGE(PG8_SB(1, 1), cB + hstep + kstep, voffB);
        PG8_WAIT_V(6); PG8_BAR;
    } else {
        PG8_STAGE(PG8_SB(0, 0), cB, voffB); PG8_STAGE(PG8_SA(0, 0), cA, voffA); PG8_STAGE(PG8_SB(0, 1), cB + hstep, voffB); PG8_STAGE(PG8_SA(0, 1), cA + hstep, voffA);
        if (wr == 1) PG8_BAR;
        PG8_WAIT_V(4); PG8_BAR;
        PG8_STAGE(PG8_SB(1, 0), cB + kstep, voffB); PG8_STAGE(PG8_SA(1, 0), cA + kstep, voffA); PG8_STAGE(PG8_SB(1, 1), cB + hstep + kstep, voffB);
        PG8_WAIT_V(6); PG8_BAR;
    }
    for (;;) {
        const bool has_next = S.next(ui + 1, nxt);
        const char* nA = has_next ? (const char*)g.A + (size_t)nxt.pm * tstep : cA; const char* nB = has_next ? (const char*)g.Bt + (size_t)nxt.pn * tstep : cB;
        for (int t = 0; t < nt; t += 2) {
            const bool last = (t == nt - 2);
            const char* a1 = cA + (size_t)(t + 1) * kstep;
            const char* a2 = last ? nA : cA + (size_t)(t + 2) * kstep; const char* b2 = last ? nB : cB + (size_t)(t + 2) * kstep;
            const char* a3 = a2 + kstep; const char* b3 = b2 + kstep;
            if (last && has_next) S.a_ready(nxt);
            if constexpr (SP2) {
            PG8_LDB(B0, 0, 0); PG8_LDB(B1, 0, 1); PG8_SCHED; PG8_LDA(At, 0, 0); PG8_STAGE(PG8_SA(1, 1), a1 + hstep, voffA);
            PG8_WAIT_V(8); PG8_WAIT_L(0); PG8_BAR; PG8_MMA(0, 0, At, B0); PG8_MMA(0, 1, At, B1); PG8_BAR; PG8_SCHED;
            PG8_LDA(At, 0, 1); PG8_STAGE(PG8_SB(0, 0), b2, voffB); PG8_STAGE(PG8_SB(0, 1), b2 + hstep, voffB); PG8_STAGE(PG8_SA(0, 0), a2, voffA);
            PG8_WAIT_V(8); PG8_WAIT_L(0); PG8_BAR; PG8_MMA(1, 0, At, B0); PG8_MMA(1, 1, At, B1); PG8_BAR; PG8_SCHED;
            PG8_LDB(B0, 1, 0); PG8_LDB(B1, 1, 1); PG8_SCHED; PG8_LDA(At, 1, 0); PG8_STAGE(PG8_SA(0, 1), a2 + hstep, voffA);
            PG8_WAIT_V(8); PG8_WAIT_L(0); PG8_BAR; PG8_MMA(0, 0, At, B0); PG8_MMA(0, 1, At, B1); PG8_BAR; PG8_SCHED;
            PG8_LDA(At, 1, 1); PG8_STAGE(PG8_SB(1, 0), b3, voffB); PG8_STAGE(PG8_SB(1, 1), b3 + hstep, voffB); PG8_STAGE(PG8_SA(1, 0), a3, voffA);
            PG8_WAIT_V(8); PG8_WAIT_L(0); PG8_BAR; PG8_MMA(1, 0, At, B0); PG8_MMA(1, 1, At, B1); PG8_BAR; PG8_SCHED;
            } else {
            PG8_LDB(B0, 0, 0); PG8_SCHED; PG8_LDA(At, 0, 0); PG8_STAGE(PG8_SA(1, 1), a1 + hstep, voffA);
            PG8_WAIT_L(8); PG8_BAR; PG8_WAIT_L(0); PG8_MMA(0, 0, At, B0); PG8_BAR; PG8_SCHED;
            PG8_LDB(B1, 0, 1); PG8_STAGE(PG8_SB(0, 0), b2, voffB);
            PG8_BAR; PG8_WAIT_L(0); PG8_MMA(0, 1, At, B1); PG8_BAR;
            PG8_LDA(At, 0, 1); PG8_STAGE(PG8_SA(0, 0), a2, voffA);
            PG8_BAR; PG8_WAIT_L(0); PG8_MMA(1, 0, At, B0); PG8_BAR; PG8_SCHED;
            PG8_STAGE(PG8_SB(0, 1), b2 + hstep, voffB);
            PG8_WAIT_V(6); PG8_BAR; PG8_MMA(1, 1, At, B1); PG8_BAR;
            PG8_LDB(B0, 1, 0); PG8_SCHED; PG8_LDA(At, 1, 0); PG8_STAGE(PG8_SA(0, 1), a2 + hstep, voffA);
            PG8_WAIT_L(8); PG8_BAR; PG8_WAIT_L(0); PG8_MMA(0, 0, At, B0); PG8_BAR; PG8_SCHED;
            PG8_LDB(B1, 1, 1); PG8_STAGE(PG8_SB(1, 0), b3, voffB);
            PG8_BAR; PG8_WAIT_L(0); PG8_MMA(0, 1, At, B1); PG8_BAR;
            PG8_LDA(At, 1, 1); PG8_STAGE(PG8_SA(1, 0), a3, voffA);
            PG8_BAR; PG8_WAIT_L(0); PG8_MMA(1, 0, At, B0); PG8_BAR; PG8_SCHED;
            PG8_STAGE(PG8_SB(1, 1), b3 + hstep, voffB);
            PG8_WAIT_V(6); PG8_BAR; PG8_MMA(1, 1, At, B1); PG8_BAR;
            }
        }
        if constexpr (ALIGN_EPI) { if (wr == 0) PG8_BAR; }
        if constexpr (!Epi::AFTER_DRAIN) { E(acc, cur, wr, wc, fr, fq); S.done(cur); }
        if (!has_next) break;
#pragma unroll
        for (int a = 0; a < 2; ++a)
#pragma unroll
            for (int b = 0; b < 2; ++b)
#pragma unroll
                for (int m = 0; m < 4; ++m)
#pragma unroll
                    for (int n = 0; n < 2; ++n) acc[a][b][m][n] = (f32x4){0.f, 0.f, 0.f, 0.f};
        cur = nxt; cA = nA; cB = nB; ++ui;
        if constexpr (ALIGN_EPI) { if (wr == 1) PG8_BAR; }
    }
    PG8_WAIT_V(0);
    if constexpr (!ALIGN_EPI) { if (wr == 0) PG8_BAR; }
    PG8_BAR;
    if constexpr (Epi::AFTER_DRAIN) { E.fused(acc, cur, wr, wc, fr, fq, lds, wid, lane); S.done(cur); }
#undef PG8_SA
#undef PG8_SB
#undef PG8_STAGE
#undef PG8_LDA
#undef PG8_LDB
#undef PG8_MMA
#undef PG8_WAIT_V
#undef PG8_WAIT_L
#undef PG8_BAR
#undef PG8_SCHED
}
}
#define GAS __attribute__((address_space(1)))
#define LAS __attribute__((address_space(3)))
typedef short bf16x8 __attribute__((ext_vector_type(8)));
typedef GAS unsigned gu32;
typedef GAS unsigned long long gu64;
#define RLX_AGENT __ATOMIC_RELAXED, __HIP_MEMORY_SCOPE_AGENT
#define LDS_WAIT() asm volatile("s_waitcnt lgkmcnt(0)" ::: "memory")
#define VM_WAIT() asm volatile("s_waitcnt vmcnt(0)" ::: "memory")
__device__ __forceinline__ unsigned long long rt() { return __builtin_amdgcn_s_memrealtime(); }

#define XB_TMO      128
#define XB_XCNT(j)  (256  + 64 * (j))
#define XB_XSUB(j)  (1280 + 64 * (j))
#define XB_XGEN(j)  (2304 + 64 * (j))
#define XB_TOP      3328
#define XB_TOPGEN   3392
#define XCD_BAR_WORDS 3456
#define XB_SPIN_CAP (1u << 18)

__device__ __forceinline__ unsigned xb_ld(unsigned* p)              { return __hip_atomic_load(p, __ATOMIC_RELAXED, __HIP_MEMORY_SCOPE_AGENT); }
__device__ __forceinline__ unsigned xb_add(unsigned* p, unsigned v) { return __hip_atomic_fetch_add(p, v, __ATOMIC_RELAXED, __HIP_MEMORY_SCOPE_AGENT); }
__device__ __forceinline__ unsigned xb_xcc_id() { return (unsigned)__builtin_amdgcn_s_getreg((3 << 11) | 20) & 0xFu; }
#define XB_SPIN(cond, bar) do { unsigned _sp = 0; while (cond) { __builtin_amdgcn_s_sleep(1); \
    if ((++_sp & 255u) == 0u) { if (xb_ld(&(bar)[XB_TMO])) break; if (_sp > XB_SPIN_CAP) { atomicAdd(&(bar)[XB_TMO], 1u); break; } } } } while (0)

struct XcdBarrier {
    unsigned* bar; unsigned x;
    volatile LAS unsigned* st;
};

__device__ __forceinline__ XcdBarrier xcd_barrier_post(unsigned* bar, volatile LAS unsigned* st) {
    XcdBarrier b; b.bar = bar; b.x = xb_xcc_id(); b.st = st;
    if (threadIdx.x == 0) (void)xb_add(&bar[XB_XCNT(b.x)], 1u);
    return b;
}
__device__ __forceinline__ void xcd_barrier_complete(unsigned* bar, unsigned x, unsigned& nloc, unsigned& nx) {
    const unsigned G = gridDim.x * gridDim.y * gridDim.z;
    unsigned sum, cnt, mine, sp = 0u;
    for (;;) {
        sum = 0u; cnt = 0u; mine = 0u;
#pragma unroll
        for (unsigned j = 0; j < 16; ++j) { const unsigned c = xb_ld(&bar[XB_XCNT(j)]); sum += c; cnt += (c > 0u) ? 1u : 0u; mine = (j == x) ? c : mine; }
        if (sum == G) break;
        __builtin_amdgcn_s_sleep(1);
        if ((++sp & 255u) == 0u) { if (xb_ld(&bar[XB_TMO])) break; if (sp > XB_SPIN_CAP) { atomicAdd(&bar[XB_TMO], 1u); break; } }
    }
    nloc = mine > 0u ? mine : 1u; nx = cnt > 0u ? cnt : 1u;
}

__device__ __forceinline__ void xcd_barrier(const XcdBarrier& b) {
    asm volatile("s_waitcnt vmcnt(0)" ::: "memory");
    __syncthreads();
    if (threadIdx.x == 0) {
        unsigned* bar = b.bar;
        __builtin_amdgcn_s_waitcnt(0);
        unsigned nloc = b.st[0], nx = b.st[1];
        if (nloc == 0u) { xcd_barrier_complete(bar, b.x, nloc, nx); b.st[0] = nloc; b.st[1] = nx; }
        const unsigned old = xb_add(&bar[XB_XSUB(b.x)], 1u);
        const unsigned gen = old / nloc;
        if (old + 1u == (gen + 1u) * nloc) {
            __builtin_amdgcn_fence(__ATOMIC_RELEASE, "agent");
            asm volatile("s_waitcnt vmcnt(0)" ::: "memory");
            const unsigned og = xb_add(&bar[XB_TOP], 1u);
            const unsigned tg = og / nx;
            if (og + 1u == (tg + 1u) * nx) xb_add(&bar[XB_TOPGEN], 1u);
            else XB_SPIN(xb_ld(&bar[XB_TOPGEN]) == tg, bar);
            __builtin_amdgcn_fence(__ATOMIC_ACQUIRE, "agent");
            xb_add(&bar[XB_XGEN(b.x)], 1u);
            asm volatile("s_waitcnt vmcnt(0)" ::: "memory");
        } else {
            XB_SPIN(xb_ld(&bar[XB_XGEN(b.x)]) == gen, bar);
            __builtin_amdgcn_fence(__ATOMIC_ACQUIRE, "agent");
            asm volatile("s_waitcnt vmcnt(0)" ::: "memory");
        }
    }
    __syncthreads();
}
namespace att {
typedef short s16x8 __attribute__((ext_vector_type(8)));
typedef short s16x4 __attribute__((ext_vector_type(4)));
constexpr int PITCH = 144;
constexpr int KOFF = 0, VOFF = 256 * PITCH;
typedef float f32x2_t __attribute__((ext_vector_type(2))); typedef __bf16 bf16x2_t __attribute__((ext_vector_type(2)));
__device__ __forceinline__ unsigned cvtpk(float lo, float hi) { f32x2_t v = {lo, hi}; bf16x2_t b = __builtin_convertvector(v, bf16x2_t); return __builtin_bit_cast(unsigned, b); }

struct QState { s16x8 q0, q1; f32x4 o[4]; float m, l; };

__device__ __forceinline__ void tile(QState& S, const s16x8 k0, const s16x8 k1, const s16x4 (&vf)[4], int base, int dq, unsigned limB, unsigned limC) {
    f32x4 s = {0.f, 0.f, 0.f, 0.f};
    s = __builtin_amdgcn_mfma_f32_16x16x32_bf16(k0, S.q0, s, 0, 0, 0);
    s = __builtin_amdgcn_mfma_f32_16x16x32_bf16(k1, S.q1, s, 0, 0, 0);
    float wf[4], sm[4];
#pragma unroll
    for (int j = 0; j < 4; ++j) { const unsigned ud = (unsigned)(base + dq - 16 * j); const int w = (ud < 129u ? 1 : 0) + (ud < limB ? 1 : 0) + (ud < limC ? 1 : 0);
        wf[j] = (float)w; sm[j] = w ? s[j] : -1.0e30f; }
    float tm = fmaxf(fmaxf(sm[0], sm[1]), fmaxf(sm[2], sm[3]));
    tm = fmaxf(tm, __shfl_xor(tm, 16)); tm = fmaxf(tm, __shfl_xor(tm, 32));
    const float mn = fmaxf(S.m, tm), al = __builtin_amdgcn_exp2f(S.m - mn); S.m = mn;
    float p[4], ps = 0.f;
#pragma unroll
    for (int j = 0; j < 4; ++j) { p[j] = wf[j] * __builtin_amdgcn_exp2f(sm[j] - mn); ps += p[j]; }
    S.l = S.l * al + ps;
    typedef unsigned u32x2 __attribute__((ext_vector_type(2)));
    u32x2 pw; pw.x = cvtpk(p[0], p[1]); pw.y = cvtpk(p[2], p[3]);
    const s16x4 pb = __builtin_bit_cast(s16x4, pw);
#pragma unroll
    for (int dt = 0; dt < 4; ++dt) { S.o[dt] = S.o[dt] * al; S.o[dt] = __builtin_amdgcn_mfma_f32_16x16x16bf16_1k(vf[dt], pb, S.o[dt], 0, 0, 0); }
}

__device__ __forceinline__ void phase(LAS unsigned char* lds, const bf16* Q, const bf16* Kb, const bf16* Vb, bf16* ATT, int vcu, int G) {
    int tid_ = threadIdx.x; asm volatile("" : "+v"(tid_));
    const int tid = tid_, lane = tid & 63, wave = __builtin_amdgcn_readfirstlane(tid >> 6), g = lane >> 4, i16 = lane & 15;
    const int klane = i16 * PITCH + 16 * g, vlane = (4 * g + (i16 >> 2)) * PITCH + 8 * (i16 & 3), dq = 16 * (i16 - 4 * g);
    for (int un = vcu; un < BATCH * NH * (SEQ / 256); un += G) {
        const int bh = un & 15, qblk = un >> 4, b = bh >> 3, h = bh & 7, t0 = qblk * 256;
        const bf16* Kg = Kb + (size_t)b * SEQ * 512 + h * 64; const bf16* Vg = Vb + (size_t)b * SEQ * 512 + h * 64;
        QState SA, SB; const int rA = 2 * wave, rB = 2 * wave + 1;
        { const bf16* qa = Q + ((size_t)b * SEQ + t0 + rA + 16 * i16) * 512 + h * 64 + 8 * g; SA.q0 = *(const s16x8*)qa; SA.q1 = *(const s16x8*)(qa + 32);
          const bf16* qb = qa + 512; SB.q0 = *(const s16x8*)qb; SB.q1 = *(const s16x8*)(qb + 32); }
#pragma unroll
        for (int dt = 0; dt < 4; ++dt) { SA.o[dt] = (f32x4){0.f, 0.f, 0.f, 0.f}; SB.o[dt] = (f32x4){0.f, 0.f, 0.f, 0.f}; }
        SA.m = -1.0e30f; SB.m = -1.0e30f; SA.l = 0.f; SB.l = 0.f;
        const int jc0 = qblk >= 8 ? 0 : 8 - qblk;
        v4u st[8];
#define ATT_LOAD(jc) do { const int c0_ = t0 - 2048 + 256 * (jc); _Pragma("unroll") for (int i_ = 0; i_ < 4; ++i_) { const int p_ = tid + 512 * i_; const size_t go_ = (size_t)(c0_ + (p_ >> 3)) * 512 + 8 * (p_ & 7); \
            st[i_] = *(const v4u*)(Kg + go_); st[4 + i_] = *(const v4u*)(Vg + go_); } } while (0)
#define ATT_STORE() do { _Pragma("unroll") for (int i_ = 0; i_ < 4; ++i_) { const int p_ = tid + 512 * i_, pos_ = p_ >> 3; const int off_ = ((pos_ & 15) * 16 + (pos_ >> 4)) * PITCH + 16 * (p_ & 7); \
            *(LAS v4u*)(lds + KOFF + off_) = st[i_]; *(LAS v4u*)(lds + VOFF + off_) = st[4 + i_]; } } while (0)
        ATT_LOAD(jc0); ATT_STORE();
        __syncthreads();
        for (int jc = jc0; jc <= 8; ++jc) {
            if (jc < 8) ATT_LOAD(jc + 1);
            const int D0 = 256 * (8 - jc);
            for (int rho = 0; rho < 16; ++rho) {
                const bool nA = (jc >= 7) || (rho == rA) || (jc == 6 && ((rA - rho) & 3) == 0);
                const bool nB = (jc >= 7) || (rho == rB) || (jc == 6 && ((rB - rho) & 3) == 0);
                if (!(nA || nB)) continue;
                const LAS unsigned char* kp = lds + KOFF + rho * (16 * PITCH) + klane; const LAS unsigned char* vp = lds + VOFF + rho * (16 * PITCH) + vlane;
                const s16x8 k0 = *(const LAS s16x8*)kp, k1 = *(const LAS s16x8*)(kp + 64);
                s16x4 vf[4];
#pragma unroll
                for (int dt = 0; dt < 4; ++dt) vf[dt] = __builtin_amdgcn_ds_read_tr16_b64_v4i16((LAS s16x4*)(vp + 32 * dt));
                if (nA) tile(SA, k0, k1, vf, D0 + rA - rho, dq, ((rA - rho) & 3) == 0 ? 513u : 0u, rho == rA ? 2049u : 0u);
                if (nB) tile(SB, k0, k1, vf, D0 + rB - rho, dq, ((rB - rho) & 3) == 0 ? 513u : 0u, rho == rB ? 2049u : 0u);
            }
            __syncthreads();
            if (jc < 8) { ATT_STORE(); }
            __syncthreads();
        }
#undef ATT_LOAD
#undef ATT_STORE
        typedef unsigned u32x2 __attribute__((ext_vector_type(2)));
        { float l = SA.l; l += __shfl_xor(l, 16); l += __shfl_xor(l, 32); const float inv = 1.f / l; bf16* op = ATT + ((size_t)b * SEQ + t0 + rA + 16 * i16) * 512 + h * 64 + 4 * g;
#pragma unroll
          for (int dt = 0; dt < 4; ++dt) { u32x2 w; w.x = cvtpk(SA.o[dt][0] * inv, SA.o[dt][1] * inv); w.y = cvtpk(SA.o[dt][2] * inv, SA.o[dt][3] * inv); *(u32x2*)(op + 16 * dt) = w; } }
        { float l = SB.l; l += __shfl_xor(l, 16); l += __shfl_xor(l, 32); const float inv = 1.f / l; bf16* op = ATT + ((size_t)b * SEQ + t0 + rB + 16 * i16) * 512 + h * 64 + 4 * g;
#pragma unroll
          for (int dt = 0; dt < 4; ++dt) { u32x2 w; w.x = cvtpk(SB.o[dt][0] * inv, SB.o[dt][1] * inv); w.y = cvtpk(SB.o[dt][2] * inv, SB.o[dt][3] * inv); *(u32x2*)(op + 16 * dt) = w; } }
    }
}
}
namespace peer {
typedef __bf16 bf2 __attribute__((ext_vector_type(2)));
__device__ __forceinline__ float dot2(unsigned a, unsigned b, float acc) { return __builtin_amdgcn_fdot2_f32_bf16(__builtin_bit_cast(bf2, a), __builtin_bit_cast(bf2, b), acc, false); }
__device__ __forceinline__ float dot8(const v4u a, const v4u b, float acc) {
    const unsigned a0 = a.x, a1 = a.y, a2 = a.z, a3 = a.w, b0 = b.x, b1 = b.y, b2 = b.z, b3 = b.w;
    acc = dot2(a0, b0, acc); acc = dot2(a1, b1, acc); acc = dot2(a2, b2, acc); acc = dot2(a3, b3, acc);
    return acc;
}
__device__ __forceinline__ int next_bit(unsigned long long& lo, unsigned long long& hi) {
    if (lo) { const int k = __builtin_ctzll(lo); lo &= lo - 1; return k; }
    const int k = __builtin_ctzll(hi); hi &= hi - 1; return 64 + k;
}
__device__ __forceinline__ void phase_u(const bf16* XN, const bf16* U, const int* EID, float* GATE, int bx, int G) {
    int tid_ = threadIdx.x; asm volatile("" : "+v"(tid_));
    const int tid = tid_, lane = tid & 63, wave = __builtin_amdgcn_readfirstlane(tid >> 6);
    const int xslot = bx & 7, member = bx >> 3, nmem = (G - xslot + 7) >> 3;
    for (int sp = 0; sp < 2; ++sp) {
        const int slice = xslot + 8 * sp;
        for (int t = member * 8 + wave; t < NTOK; t += nmem * 8) {
            const int e0 = EID[(size_t)t * HK + lane], e1 = EID[(size_t)t * HK + 64 + lane];
            const bool in0 = (e0 >> 10) == slice, in1 = (e1 >> 10) == slice;
            unsigned long long m0 = __ballot(in0), m1 = __ballot(in1);
            if ((m0 | m1) == 0ull) continue;
            const v4u xa = ((const v4u*)(XN + (size_t)t * DM))[lane], xb = ((const v4u*)(XN + (size_t)t * DM))[64 + lane];
            float h0 = 0.f, h1 = 0.f;
            while (m0 | m1) {
                int k[4], e[4];
                k[0] = next_bit(m0, m1);
#pragma unroll
                for (int j = 1; j < 4; ++j) k[j] = (m0 | m1) ? next_bit(m0, m1) : -1;
#pragma unroll
                for (int j = 0; j < 4; ++j) { const int kk = k[j] < 0 ? k[0] : k[j]; e[j] = kk < 64 ? __builtin_amdgcn_readlane(e0, kk) : __builtin_amdgcn_readlane(e1, kk - 64); }
                v4u ua[4], ub[4];
#pragma unroll
                for (int j = 0; j < 4; ++j) { const v4u* row = (const v4u*)(U + (size_t)e[j] * DM); ua[j] = row[lane]; ub[j] = row[64 + lane]; }
#pragma unroll
                for (int j = 0; j < 4; ++j) { float d = dot8(xa, ua[j], 0.f); d = dot8(xb, ub[j], d); d = wave_sum(d);
                    if (k[j] >= 0) { if (k[j] < 64) { if (lane == k[j]) h0 = d; } else { if (lane == k[j] - 64) h1 = d; } } }
            }
            if (in0) GATE[(size_t)t * HK + lane] = gelu_erf(h0) * GATE[(size_t)t * HK + lane];
            if (in1) GATE[(size_t)t * HK + 64 + lane] = gelu_erf(h1) * GATE[(size_t)t * HK + 64 + lane];
        }
    }
}
__device__ __forceinline__ void phase_v(const bf16* V, const int* EID, const float* ACT, float* H, int bx, int G) {
    int tid_ = threadIdx.x; asm volatile("" : "+v"(tid_));
    const int tid = tid_, lane = tid & 63, wave = __builtin_amdgcn_readfirstlane(tid >> 6), g8 = lane >> 3, c8 = lane & 7;
    const int xslot = bx & 7, member = bx >> 3, nmem = (G - xslot + 7) >> 3;
    for (int sp = 0; sp < 2; ++sp) {
        const int slice = xslot + 8 * sp; const bf16* Vs = V + slice * 64 + c8 * 8;
        for (int t = member * 8 + wave; t < NTOK; t += nmem * 8) {
            const int e0 = EID[(size_t)t * HK + lane], e1 = EID[(size_t)t * HK + 64 + lane];
            const float a0 = ACT[(size_t)t * HK + lane], a1 = ACT[(size_t)t * HK + 64 + lane];
            v4u r[16]; float av[16];
#pragma unroll
            for (int i = 0; i < 16; ++i) { const int src = ((8 * i) & 63) + g8; const int e = __shfl(i < 8 ? e0 : e1, src); av[i] = __shfl(i < 8 ? a0 : a1, src);
                r[i] = *(const v4u*)(Vs + (size_t)e * DM); }
            float acc[8];
#pragma unroll
            for (int q = 0; q < 8; ++q) acc[q] = 0.f;
#pragma unroll
            for (int i = 0; i < 16; ++i) { const float a = av[i];
                acc[0] += a * bflo(r[i].x); acc[1] += a * bfhi(r[i].x); acc[2] += a * bflo(r[i].y); acc[3] += a * bfhi(r[i].y);
                acc[4] += a * bflo(r[i].z); acc[5] += a * bfhi(r[i].z); acc[6] += a * bflo(r[i].w); acc[7] += a * bfhi(r[i].w); }
#pragma unroll
            for (int q = 0; q < 8; ++q) { float v = acc[q]; v += __shfl_xor(v, 8); v += __shfl_xor(v, 16); v += __shfl_xor(v, 32); acc[q] = v; }
            if (g8 == 0) { float* hp = H + (size_t)t * DM + slice * 64 + c8 * 8; f32x4 v0 = *(f32x4*)hp, v1 = *(f32x4*)(hp + 4);
                v0.x += acc[0]; v0.y += acc[1]; v0.z += acc[2]; v0.w += acc[3]; v1.x += acc[4]; v1.y += acc[5]; v1.z += acc[6]; v1.w += acc[7];
                *(f32x4*)hp = v0; *(f32x4*)(hp + 4) = v1; }
        }
    }
}

__device__ __forceinline__ void naive_u_token(int tok, int lane, const bf16* XN, const bf16* U, const int* EID, float* GATE) {
    const v4u xa = ((const v4u*)(XN + (size_t)tok * DM))[lane], xb = ((const v4u*)(XN + (size_t)tok * DM))[64 + lane];
    for (int k = 0; k < HK; ++k) { const int e = EID[(size_t)tok * HK + k]; const v4u* row = (const v4u*)(U + (size_t)e * DM);
        float d = dot8(xa, row[lane], 0.f); d = dot8(xb, row[64 + lane], d); d = wave_sum(d);
        if (lane == 0) GATE[(size_t)tok * HK + k] = gelu_erf(d) * GATE[(size_t)tok * HK + k]; }
}
__device__ __forceinline__ void naive_v_token(int tok, int lane, const bf16* V, const int* EID, const float* ACT, float* H) {
    float y[16];
#pragma unroll
    for (int i = 0; i < 16; ++i) y[i] = 0.f;
    for (int k = 0; k < HK; ++k) { const int e = EID[(size_t)tok * HK + k]; const float act = ACT[(size_t)tok * HK + k];
        const v4u c = ((const v4u*)(V + (size_t)e * 1024))[lane * 2], dd = ((const v4u*)(V + (size_t)e * 1024))[lane * 2 + 1];
        y[0] += act * bflo(c.x); y[1] += act * bfhi(c.x); y[2] += act * bflo(c.y); y[3] += act * bfhi(c.y); y[4] += act * bflo(c.z); y[5] += act * bfhi(c.z); y[6] += act * bflo(c.w); y[7] += act * bfhi(c.w);
        y[8] += act * bflo(dd.x); y[9] += act * bfhi(dd.x); y[10] += act * bflo(dd.y); y[11] += act * bfhi(dd.y); y[12] += act * bflo(dd.z); y[13] += act * bfhi(dd.z); y[14] += act * bflo(dd.w); y[15] += act * bfhi(dd.w); }
    float* hr = H + (size_t)tok * 1024 + lane * 16;
#pragma unroll
    for (int i = 0; i < 4; ++i) { f32x4 v = ((f32x4*)hr)[i]; v.x += y[4 * i]; v.y += y[4 * i + 1]; v.z += y[4 * i + 2]; v.w += y[4 * i + 3]; ((f32x4*)hr)[i] = v; }
}
}
namespace peer2 {
typedef __bf16 bf2 __attribute__((ext_vector_type(2)));
__device__ __forceinline__ float dot2(unsigned a, unsigned b, float acc) { return __builtin_amdgcn_fdot2_f32_bf16(__builtin_bit_cast(bf2, a), __builtin_bit_cast(bf2, b), acc, false); }
__device__ __forceinline__ float dot8(const v4u a, const v4u b) {
    const unsigned a0 = a.x, a1 = a.y, a2 = a.z, a3 = a.w, b0 = b.x, b1 = b.y, b2 = b.z, b3 = b.w;
    float acc = dot2(a0, b0, 0.f); acc = dot2(a1, b1, acc); acc = dot2(a2, b2, acc); acc = dot2(a3, b3, acc); return acc;
}
template <int S> __device__ __forceinline__ float rs8(const float (&v)[8], int lane) {
    const bool b2 = lane & (4 * S), b1 = lane & (2 * S), b0 = lane & S;
    float w[4];
#pragma unroll
    for (int j = 0; j < 4; ++j) { const float keep = b2 ? v[j + 4] : v[j], send = b2 ? v[j] : v[j + 4]; w[j] = keep + __shfl_xor(send, 4 * S); }
    float u[2];
#pragma unroll
    for (int j = 0; j < 2; ++j) { const float keep = b1 ? w[j + 2] : w[j], send = b1 ? w[j] : w[j + 2]; u[j] = keep + __shfl_xor(send, 2 * S); }
    const float keep = b0 ? u[1] : u[0], send = b0 ? u[0] : u[1];
    return keep + __shfl_xor(send, S);
}
struct Rows { v4u r[16]; };
__device__ __forceinline__ void load_rows(Rows& R, const unsigned char* tab, const unsigned (&off)[16], int colbyte) {
#pragma unroll
    for (int it = 0; it < 16; ++it) R.r[it] = *(const v4u*)(tab + (size_t)off[it] + colbyte);
}
__device__ __forceinline__ void read16(unsigned (&o)[16], const LAS unsigned* p) {
#pragma unroll
    for (int q = 0; q < 4; ++q) { const v4u t = ((const LAS v4u*)p)[q]; o[4 * q] = t.x; o[4 * q + 1] = t.y; o[4 * q + 2] = t.z; o[4 * q + 3] = t.w; }
}
__device__ __forceinline__ void phase(LAS unsigned char* lds, const bf16* XN, const bf16* U, const bf16* V, const int* EID, const float* GATE, float* H, int gw, int NGW) {
    int tid_ = threadIdx.x; asm volatile("" : "+v"(tid_));
    const int tid = tid_, lane = tid & 63, wave = __builtin_amdgcn_readfirstlane(tid >> 6), g8 = lane >> 3, c8 = lane & 7;
    LAS unsigned* idt = (LAS unsigned*)(lds + wave * 8192);
    LAS float* actt = (LAS float*)(lds + wave * 8192 + 4096);
    const unsigned char* Ub = (const unsigned char*)U; const unsigned char* Vb = (const unsigned char*)V;
    for (int grp = gw; grp < NTOK / 8; grp += NGW) {
        const int t0 = grp * 8;
#pragma unroll
        for (int i = 0; i < 8; ++i) { const int ea = EID[(size_t)(t0 + i) * HK + lane], eb = EID[(size_t)(t0 + i) * HK + 64 + lane];
            idt[i * 128 + (lane & 7) * 16 + (lane >> 3)] = (unsigned)ea << 11; idt[i * 128 + (lane & 7) * 16 + 8 + (lane >> 3)] = (unsigned)eb << 11;
            actt[i * 128 + lane] = 0.f; actt[i * 128 + 64 + lane] = 0.f; }
        asm volatile("s_waitcnt lgkmcnt(0)" ::: "memory");
        v4u ra[16], rb[16];
#define PU_LOAD(R, X, n_) do { const int i_ = (n_) & 7, s_ = (n_) >> 3; const unsigned cb_ = 128 * s_ + 16 * c8; \
            _Pragma("unroll") for (int q = 0; q < 4; ++q) { const v4u o_ = ((const LAS v4u*)(idt + i_ * 128 + g8 * 16))[q]; \
                R[4 * q] = *(const v4u*)(Ub + (size_t)(unsigned)(o_.x + cb_)); R[4 * q + 1] = *(const v4u*)(Ub + (size_t)(unsigned)(o_.y + cb_)); R[4 * q + 2] = *(const v4u*)(Ub + (size_t)(unsigned)(o_.z + cb_)); R[4 * q + 3] = *(const v4u*)(Ub + (size_t)(unsigned)(o_.w + cb_)); } \
            X = *(const v4u*)(XN + (size_t)(t0 + i_) * DM + 64 * s_ + 8 * c8); } while (0)
#define PU_COMP(R, X, n_) do { const int i_ = (n_) & 7; float dA[8], dB[8]; \
            _Pragma("unroll") for (int it = 0; it < 8; ++it) { dA[it] = dot8(X, R[it]); dB[it] = dot8(X, R[8 + it]); } \
            const float sa_ = rs8<1>(dA, lane), sb_ = rs8<1>(dB, lane); LAS float* hp_ = actt + i_ * 128 + g8 * 16 + c8; hp_[0] += sa_; hp_[8] += sb_; } while (0)
        { v4u xa, xb;
          PU_LOAD(ra, xa, 0);
          for (int n = 0; n < 128; n += 2) {
              PU_LOAD(rb, xb, n + 1); asm volatile("" ::: "memory");
              PU_COMP(ra, xa, n); asm volatile("" ::: "memory");
              if (n + 2 < 128) PU_LOAD(ra, xa, n + 2);
              asm volatile("" ::: "memory");
              PU_COMP(rb, xb, n + 1); asm volatile("" ::: "memory");
          } }
#undef PU_LOAD
#undef PU_COMP
        asm volatile("s_waitcnt lgkmcnt(0)" ::: "memory");
#pragma unroll
        for (int i = 0; i < 8; ++i) { const float ga = GATE[(size_t)(t0 + i) * HK + 8 * c8 + g8], gb = GATE[(size_t)(t0 + i) * HK + 64 + 8 * c8 + g8];
            LAS float* hp = actt + i * 128 + g8 * 16 + c8; hp[0] = gelu_erf(hp[0]) * ga; hp[8] = gelu_erf(hp[8]) * gb; }
        asm volatile("s_waitcnt lgkmcnt(0)" ::: "memory");
#define PV_LOAD(R, HV, n_) do { const int i_ = (n_) & 7, s_ = (n_) >> 3; const unsigned cb_ = 128 * s_ + 16 * c8; \
            _Pragma("unroll") for (int q = 0; q < 4; ++q) { const v4u o_ = ((const LAS v4u*)(idt + i_ * 128 + g8 * 16))[q]; \
                R[4 * q] = *(const v4u*)(Vb + (size_t)(unsigned)(o_.x + cb_)); R[4 * q + 1] = *(const v4u*)(Vb + (size_t)(unsigned)(o_.y + cb_)); R[4 * q + 2] = *(const v4u*)(Vb + (size_t)(unsigned)(o_.z + cb_)); R[4 * q + 3] = *(const v4u*)(Vb + (size_t)(unsigned)(o_.w + cb_)); } \
            HV = H[(size_t)(t0 + i_) * DM + 64 * s_ + 8 * c8 + g8]; } while (0)
#define PV_FMA(a_, r_) do { acc[0] += a_ * bflo(r_.x); acc[1] += a_ * bfhi(r_.x); acc[2] += a_ * bflo(r_.y); acc[3] += a_ * bfhi(r_.y); \
                acc[4] += a_ * bflo(r_.z); acc[5] += a_ * bfhi(r_.z); acc[6] += a_ * bflo(r_.w); acc[7] += a_ * bfhi(r_.w); } while (0)
#define PV_COMP(R, HV, n_) do { const int i_ = (n_) & 7, s_ = (n_) >> 3; float acc[8]; \
            _Pragma("unroll") for (int q = 0; q < 8; ++q) acc[q] = 0.f; \
            _Pragma("unroll") for (int q = 0; q < 4; ++q) { const f32x4 a4_ = ((const LAS f32x4*)(actt + i_ * 128 + g8 * 16))[q]; \
                { const float a_ = a4_.x; const v4u r_ = R[4 * q]; PV_FMA(a_, r_); } { const float a_ = a4_.y; const v4u r_ = R[4 * q + 1]; PV_FMA(a_, r_); } \
                { const float a_ = a4_.z; const v4u r_ = R[4 * q + 2]; PV_FMA(a_, r_); } { const float a_ = a4_.w; const v4u r_ = R[4 * q + 3]; PV_FMA(a_, r_); } } \
            H[(size_t)(t0 + i_) * DM + 64 * s_ + 8 * c8 + g8] = HV + rs8<8>(acc, lane); } while (0)
        { float ha, hb;
          PV_LOAD(ra, ha, 0);
          for (int n = 0; n < 128; n += 2) {
              PV_LOAD(rb, hb, n + 1); asm volatile("" ::: "memory");
              PV_COMP(ra, ha, n); asm volatile("" ::: "memory");
              if (n + 2 < 128) PV_LOAD(ra, ha, n + 2);
              asm volatile("" ::: "memory");
              PV_COMP(rb, hb, n + 1); asm volatile("" ::: "memory");
          } }
#undef PV_LOAD
#undef PV_COMP
#undef PV_FMA
    }
}
}
namespace tk {
constexpr int TPITCH = 144;
__device__ __forceinline__ unsigned bkey(unsigned b) { return (b & 0x8000u) ? (~b & 0xffffu) : (b | 0x8000u); }
__device__ __forceinline__ float bkey2f(unsigned k) { const unsigned b = (k & 0x8000u) ? (k & 0x7fffu) : (~k & 0xffffu); return __uint_as_float(b << 16); }
__device__ __forceinline__ void ins8(unsigned (&L)[16], const v4u w, int c0) {
    const unsigned x0 = w.x, x1 = w.y, x2 = w.z, x3 = w.w;
    ins16(L, (bkey(x0 & 0xffffu) << 16) | (unsigned)(127 - c0));     ins16(L, (bkey(x0 >> 16) << 16) | (unsigned)(126 - c0));
    ins16(L, (bkey(x1 & 0xffffu) << 16) | (unsigned)(125 - c0));     ins16(L, (bkey(x1 >> 16) << 16) | (unsigned)(124 - c0));
    ins16(L, (bkey(x2 & 0xffffu) << 16) | (unsigned)(123 - c0));     ins16(L, (bkey(x2 >> 16) << 16) | (unsigned)(122 - c0));
    ins16(L, (bkey(x3 & 0xffffu) << 16) | (unsigned)(121 - c0));     ins16(L, (bkey(x3 >> 16) << 16) | (unsigned)(120 - c0));
}
__device__ __forceinline__ void phase(LAS unsigned char* lds, const bf16* SC, int* EID, float* GATE, int vcu, int G) {
    int tid_ = threadIdx.x; asm volatile("" : "+v"(tid_));
    const int tid = tid_;
    for (int batch = vcu; batch < NTOK * PH / 512; batch += G) {
        const bf16* src = SC + (size_t)batch * 512 * 256;
        v4u st[8];
#define TK_LOAD(ch) do { _Pragma("unroll") for (int i_ = 0; i_ < 8; ++i_) { const int p_ = tid + 512 * i_; st[i_] = *(const v4u*)(src + (size_t)(p_ >> 3) * 256 + (ch) * 64 + 8 * (p_ & 7)); } } while (0)
#define TK_STORE() do { _Pragma("unroll") for (int i_ = 0; i_ < 8; ++i_) { const int p_ = tid + 512 * i_; *(LAS v4u*)(lds + (p_ >> 3) * TPITCH + 16 * (p_ & 7)) = st[i_]; } } while (0)
        unsigned La[16], Lb[16];
#pragma unroll
        for (int q = 0; q < 16; ++q) { La[q] = 0u; Lb[q] = 0u; }
        TK_LOAD(0); TK_STORE(); __syncthreads();
#pragma unroll
        for (int ch = 0; ch < 4; ++ch) {
            if (ch < 3) TK_LOAD(ch + 1);
            const LAS v4u* row = (const LAS v4u*)(lds + tid * TPITCH);
#pragma unroll
            for (int pc = 0; pc < 8; ++pc) { const v4u w = row[pc]; if (ch < 2) ins8(La, w, ch * 64 + pc * 8); else ins8(Lb, w, (ch - 2) * 64 + pc * 8); }
            __syncthreads();
            if (ch < 3) { TK_STORE(); }
            __syncthreads();
        }
#undef TK_LOAD
#undef TK_STORE
#pragma unroll
        for (int q = 0; q < 16; ++q) { La[q] = (f2key(bkey2f(La[q] >> 16)) & ~127u) | (La[q] & 127u); Lb[q] = (f2key(bkey2f(Lb[q] >> 16)) & ~127u) | (Lb[q] & 127u); }
        int e[16]; float g[16]; topk_combine(La, Lb, e, g);
        const size_t o = ((size_t)batch * 512 + tid) * 16;
#pragma unroll
        for (int r = 0; r < 4; ++r) { *(int4*)(EID + o + 4 * r) = make_int4(e[4 * r], e[4 * r + 1], e[4 * r + 2], e[4 * r + 3]); *(f32x4*)(GATE + o + 4 * r) = (f32x4){g[4 * r], g[4 * r + 1], g[4 * r + 2], g[4 * r + 3]}; }
    }
}
__device__ __forceinline__ void fold_phase(LAS unsigned char* lds, const float* wq, const float* keys, bf16* WQK, int vcu, int G) {
    int tid_ = threadIdx.x; asm volatile("" : "+v"(tid_));
    const int tid = tid_, dl = tid & 63, kg = __builtin_amdgcn_readfirstlane(tid >> 6);
    LAS float* ks = (LAS float*)lds;
    LAS float* wsm = (LAS float*)(lds + 128 * 132 * 4);
    for (int it = vcu; it < 16 * 16; it += G) {
        const int hp = it >> 4, d0 = (it & 15) * 64, p = hp & 1;
        for (int i = tid; i < 128 * 32; i += 512) { const int r = i >> 5, c4 = i & 31; *(LAS f32x4*)(ks + r * 132 + 4 * c4) = *(const f32x4*)(keys + ((size_t)p * 128 + r) * 128 + 4 * c4); }
        for (int i = tid; i < 64 * 32; i += 512) { const int r = i >> 5, c4 = i & 31; *(LAS f32x4*)(wsm + r * 132 + 4 * c4) = *(const f32x4*)(wq + (size_t)(d0 + r) * 2048 + hp * 128 + 4 * c4); }
        __syncthreads();
        float acc[16];
#pragma unroll
        for (int j = 0; j < 16; ++j) acc[j] = 0.f;
        for (int c = 0; c < 128; c += 4) { const f32x4 w = *(const LAS f32x4*)(wsm + dl * 132 + c);
#pragma unroll
            for (int j = 0; j < 16; ++j) { const f32x4 kv = *(const LAS f32x4*)(ks + (kg * 16 + j) * 132 + c); acc[j] += w.x * kv.x + w.y * kv.y + w.z * kv.z + w.w * kv.w; } }
#pragma unroll
        for (int j = 0; j < 16; ++j) WQK[(size_t)(hp * 128 + kg * 16 + j) * 1024 + d0 + dl] = (bf16)f2bf(acc[j]);
        __syncthreads();
    }
}
}
#ifndef PH_MASK
#define PH_MASK 0xFFFu
#endif
#ifndef REP_MASK
#define REP_MASK 0u
#endif
#ifndef REP_N
#define REP_N 1
#endif
constexpr int NWAVES = 8;
constexpr int RING_OFF = 0, RING_BYTES = 131072;
constexpr int LDSCTL_OFF = RING_BYTES, MISC_OFF = LDSCTL_OFF + 320;
constexpr int LDS_BYTES = 147456;
constexpr int CW_BAR = 4096;

struct Params {
    const float *x, *p; const int* pos; const float *norm_mix, *w_in, *conv_w, *conv_b, *ln_g, *ln_b, *g_att, *g_conv, *w_out, *norm_ffn, *wq, *keys, *eu, *ev, *norm_ple, *wg, *wp, *fin;
    float* out; unsigned char* ws; float freq[8];
};

__device__ __forceinline__ void transpose_item(const float* W, int K, int NW, bf16* WT, int n_dst0, int n_src0, int k0, LAS float* scr, int lane) {
#pragma unroll 8
    for (int i = 0; i < 32; ++i) { const int kk = 2 * i + (lane >> 5); scr[kk * 33 + (lane & 31)] = W[(size_t)(k0 + kk) * NW + n_src0 + (lane & 31)]; }
    LDS_WAIT(); asm volatile("" ::: "memory");
    const int c = lane & 7;
#pragma unroll
    for (int j = 0; j < 4; ++j) { const int n = (lane >> 3) + 8 * j; const LAS float* s = scr + (8 * c) * 33 + n;
        v4u o; o.x = pk2(s[0 * 33], s[1 * 33]); o.y = pk2(s[2 * 33], s[3 * 33]); o.z = pk2(s[4 * 33], s[5 * 33]); o.w = pk2(s[6 * 33], s[7 * 33]);
        *(v4u*)(WT + (size_t)(n_dst0 + n) * K + k0 + 8 * c) = o; }
    LDS_WAIT(); asm volatile("" ::: "memory");
}

__global__ void __launch_bounds__(NWAVES * 64, 2) mega(Params a) {
    extern __shared__ __attribute__((aligned(16))) unsigned char lds_raw[];
    LAS unsigned char* lds = (LAS unsigned char*)lds_raw;
    volatile LAS unsigned* MISC = (volatile LAS unsigned*)(lds + MISC_OFF);
    const int wave = __builtin_amdgcn_readfirstlane((int)threadIdx.x >> 6);
#define LANE_ ((int)(threadIdx.x & 63u))
    const int G = gridDim.x, bx = blockIdx.x, vcu = (G % 8 == 0) ? (bx % 8) * (G / 8) + bx / 8 : bx;
    const int gw = vcu * NWAVES + wave, NGW = G * NWAVES, NGT = G * NWAVES * 64;
#define GT_ (vcu * (NWAVES * 64) + (int)threadIdx.x)
    unsigned* ctl = (unsigned*)(a.ws + WS_CTL);
#define H ((float*)a.out)
#define cs ((float*)(a.ws + WS_ROPE))
#define sn ((float*)(a.ws + WS_ROPE) + NTOK * 8)
#define WIN ((bf16*)(a.ws + WS_WIN))
#define WOUT ((bf16*)(a.ws + WS_WOUT))
#define WQK ((bf16*)(a.ws + WS_WQK))
#define WG ((bf16*)(a.ws + WS_WG))
#define WP ((bf16*)(a.ws + WS_WP))
#define U ((bf16*)(a.ws + WS_U))
#define V ((bf16*)(a.ws + WS_V))
#define XN ((bf16*)(a.ws + WS_XN))
#define Q ((bf16*)(a.ws + WS_Q))
#define Kb ((bf16*)(a.ws + WS_K))
#define Vb ((bf16*)(a.ws + WS_VV))
#define GLU ((bf16*)(a.ws + WS_GLU))
#define SC ((bf16*)(a.ws + WS_SC))
#define ATT ((bf16*)(a.ws + WS_ATT))
#define Y ((bf16*)(a.ws + WS_Y))
#define EID ((int*)(a.ws + WS_EID))
#define GATE ((float*)(a.ws + WS_GATE))
#define PP ((bf16*)(a.ws + WS_PP))

    for (int u = threadIdx.x; u < (LDS_BYTES - LDSCTL_OFF) / 4; u += NWAVES * 64) ((LAS unsigned*)(lds + LDSCTL_OFF))[u] = 0u;
    __syncthreads();
    XcdBarrier bar = xcd_barrier_post(ctl + CW_BAR, MISC + 8);

    for (int rep_ = 0; rep_ < (((REP_MASK >> 0) & 1u) ? 1 + REP_N : 1); ++rep_) { if (rep_) xcd_barrier(bar);
    if (PH_MASK & (1u << 0)) {
    {
        LAS float* scr = (LAS float*)(lds + RING_OFF + wave * 16384);
        constexpr int I_IN = (DM / 64) * (DIN / 32), I_SQ = (DM / 64) * (DM / 32), I_WP = (PLE / 64) * (DM / 32);
        for (int it = gw; it < I_IN + 2 * I_SQ + I_WP; it += NGW) {
            int r = it;
            if (r < I_IN) { const int nb = r % (DIN / 32), kb = r / (DIN / 32); transpose_item(a.w_in, DM, DIN, WIN, 32 * nb, nv::win_srccol(32 * nb), 64 * kb, scr, LANE_); continue; } r -= I_IN;
            if (r < I_SQ) { const int nb = r % (DM / 32), kb = r / (DM / 32); transpose_item(a.w_out, DM, DM, WOUT, 32 * nb, 32 * nb, 64 * kb, scr, LANE_); continue; } r -= I_SQ;
            if (r < I_SQ) { const int nb = r % (DM / 32), kb = r / (DM / 32); transpose_item(a.wg, DM, DM, WG, 32 * nb, 32 * nb, 64 * kb, scr, LANE_); continue; } r -= I_SQ;
            { const int nb = r % (DM / 32), kb = r / (DM / 32); transpose_item(a.wp, PLE, DM, WP, 32 * nb, 32 * nb, 64 * kb, scr, LANE_); }
        }
        __syncthreads();
        tk::fold_phase(lds, a.wq, a.keys, WQK, vcu, G);
        for (size_t i = GT_; i < (size_t)NEXP * DM / 8; i += NGT) { const f32x4 u0 = ((const f32x4*)a.eu)[2 * i], u1 = ((const f32x4*)a.eu)[2 * i + 1], v0 = ((const f32x4*)a.ev)[2 * i], v1 = ((const f32x4*)a.ev)[2 * i + 1];
            v4u o; o.x = pk2(u0.x, u0.y); o.y = pk2(u0.z, u0.w); o.z = pk2(u1.x, u1.y); o.w = pk2(u1.z, u1.w); ((v4u*)U)[i] = o;
            o.x = pk2(v0.x, v0.y); o.y = pk2(v0.z, v0.w); o.z = pk2(v1.x, v1.y); o.w = pk2(v1.z, v1.w); ((v4u*)V)[i] = o; }
        for (size_t i = GT_; i < (size_t)NTOK * PLE / 8; i += NGT) { const f32x4 u0 = ((const f32x4*)a.p)[2 * i], u1 = ((const f32x4*)a.p)[2 * i + 1];
            v4u o; o.x = pk2(u0.x, u0.y); o.y = pk2(u0.z, u0.w); o.z = pk2(u1.x, u1.y); o.w = pk2(u1.z, u1.w); ((v4u*)PP)[i] = o; }
        for (int i = GT_; i < NTOK * 8; i += NGT) { const float ang = (float)a.pos[i >> 3] * a.freq[i & 7]; cs[i] = cosf(ang); sn[i] = sinf(ang); }
        for (int r = gw; r < NTOK; r += NGW) nv::rms_row<false>(r, LANE_, a.x, a.norm_mix, XN);
    }
    } }
    xcd_barrier(bar);
    for (int rep_ = 0; rep_ < (((REP_MASK >> 1) & 1u) ? 1 + REP_N : 1); ++rep_) { if (rep_) xcd_barrier(bar);
    if (PH_MASK & (1u << 1)) {
    { pg8::Gemm g{XN, WIN, NTOK, DIN, DM}; pg8::StaticOrder S; S.init(NTOK, DIN, G, bx); pg8::EpiInProj E{Q, cs, sn};
      pg8::gemm_phase<pg8::EpiInProj, pg8::StaticOrder, true, true>(lds + RING_OFF, g, S, E); }
    } }
    xcd_barrier(bar);
    for (int rep_ = 0; rep_ < (((REP_MASK >> 2) & 1u) ? 1 + REP_N : 1); ++rep_) { if (rep_) xcd_barrier(bar);
    if (PH_MASK & (1u << 2)) {
    att::phase(lds, Q, Kb, Vb, ATT, vcu, G);
    } }
    xcd_barrier(bar);
    for (int rep_ = 0; rep_ < (((REP_MASK >> 3) & 1u) ? 1 + REP_N : 1); ++rep_) { if (rep_) xcd_barrier(bar);
    if (PH_MASK & (1u << 3)) {
    for (int t = gw; t < NTOK; t += NGW) nv::mix_token(t, LANE_, GLU, ATT, a.conv_w, a.conv_b, a.ln_g, a.ln_b, a.g_att, a.g_conv, Y);
    } }
    xcd_barrier(bar);
    for (int rep_ = 0; rep_ < (((REP_MASK >> 4) & 1u) ? 1 + REP_N : 1); ++rep_) { if (rep_) xcd_barrier(bar);
    if (PH_MASK & (1u << 4)) {
    { pg8::Gemm g{Y, WOUT, NTOK, DM, DM}; pg8::StaticOrder S; S.init(NTOK, DM, G, bx); pg8::EpiResid E{a.x, H};
      pg8::gemm_phase<pg8::EpiResid, pg8::StaticOrder, false, true>(lds + RING_OFF, g, S, E); }
    } }
    xcd_barrier(bar);
    for (int rep_ = 0; rep_ < (((REP_MASK >> 5) & 1u) ? 1 + REP_N : 1); ++rep_) { if (rep_) xcd_barrier(bar);
    if (PH_MASK & (1u << 5)) {
    for (int r = gw; r < NTOK; r += NGW) nv::rms_row<false>(r, LANE_, H, a.norm_ffn, XN);
    } }
    xcd_barrier(bar);
    for (int rep_ = 0; rep_ < (((REP_MASK >> 6) & 1u) ? 1 + REP_N : 1); ++rep_) { if (rep_) xcd_barrier(bar);
    if (PH_MASK & (1u << 6)) {
    { pg8::Gemm g{XN, WQK, NTOK, 2048, DM}; pg8::StaticOrder S; S.init(NTOK, 2048, G, bx); pg8::EpiBf16<0> E{SC, 2048, nullptr, 0, 0, 1.f};
      pg8::gemm_phase<pg8::EpiBf16<0>, pg8::StaticOrder, true, true>(lds + RING_OFF, g, S, E); }
    } }
    xcd_barrier(bar);
    for (int rep_ = 0; rep_ < (((REP_MASK >> 7) & 1u) ? 1 + REP_N : 1); ++rep_) { if (rep_) xcd_barrier(bar);
    if (PH_MASK & (1u << 7)) {
    tk::phase(lds, SC, EID, GATE, vcu, G);
    } }
    xcd_barrier(bar);
    for (int rep_ = 0; rep_ < (((REP_MASK >> 8) & 1u) ? 1 + REP_N : 1); ++rep_) { if (rep_) xcd_barrier(bar);
    if (PH_MASK & (1u << 8)) {
    peer2::phase(lds, XN, U, V, EID, GATE, H, gw, NGW);
    } }
    xcd_barrier(bar);
    for (int rep_ = 0; rep_ < (((REP_MASK >> 9) & 1u) ? 1 + REP_N : 1); ++rep_) { if (rep_) xcd_barrier(bar);
    if (PH_MASK & (1u << 9)) {
    for (int r = gw; r < NTOK; r += NGW) nv::rms_row<false>(r, LANE_, H, a.norm_ple, XN);
    } }
    xcd_barrier(bar);
    for (int rep_ = 0; rep_ < (((REP_MASK >> 10) & 1u) ? 1 + REP_N : 1); ++rep_) { if (rep_) xcd_barrier(bar);
    if (PH_MASK & (1u << 10)) {
    { int kple = PLE; asm volatile("" : "+s"(kple));
      pg8::Gemm g{PP, WP, NTOK, DM, kple}; pg8::StaticOrder S; S.init(NTOK, DM, G, bx); pg8::EpiBf16<0> E{Y, DM, nullptr, 0, 0, 1.f};
      pg8::gemm_phase<pg8::EpiBf16<0>, pg8::StaticOrder, false, true>(lds + RING_OFF, g, S, E); }
    VM_WAIT(); __syncthreads();
    { pg8::Gemm g{XN, WG, NTOK, DM, DM}; pg8::StaticOrder S; S.init(NTOK, DM, G, bx); pg8::EpiPle E{H, Y};
      pg8::gemm_phase<pg8::EpiPle, pg8::StaticOrder, false, true>(lds + RING_OFF, g, S, E); }
    } }
    xcd_barrier(bar);
    for (int rep_ = 0; rep_ < (((REP_MASK >> 11) & 1u) ? 1 + REP_N : 1); ++rep_) { if (rep_) xcd_barrier(bar);
    if (PH_MASK & (1u << 11)) {
    for (int r = gw; r < NTOK; r += NGW) nv::rms_row<true>(r, LANE_, H, a.fin, H);
    } }
#undef H
#undef cs
#undef sn
#undef WIN
#undef WOUT
#undef WQK
#undef WG
#undef WP
#undef U
#undef V
#undef XN
#undef Q
#undef Kb
#undef Vb
#undef GLU
#undef SC
#undef ATT
#undef Y
#undef EID
#undef GATE
#undef PP
#undef LANE_
#undef GT_
}

extern "C" void kernel_launch(void* const* d_in, const int* in_sizes, int n_in, void* d_out, int out_size, void* d_ws, size_t ws_size, hipStream_t stream) {
    static int grid = 0;
    if (grid == 0) {
        if (n_in != 21 || out_size != NTOK * DM || ws_size < WS_END) { fprintf(stderr, "kernel_launch: unexpected shapes n_in %d out %d ws %zu\n", n_in, out_size, ws_size); grid = -1; return; }
        int dev = 0, cus = 0, per_cu = 0;
        if (hipGetDevice(&dev) != hipSuccess || hipDeviceGetAttribute(&cus, hipDeviceAttributeMultiprocessorCount, dev) != hipSuccess) { grid = -1; return; }
        if (hipFuncSetAttribute((const void*)mega, hipFuncAttributeMaxDynamicSharedMemorySize, LDS_BYTES) != hipSuccess) { fprintf(stderr, "kernel_launch: hipFuncSetAttribute failed\n"); grid = -1; return; }
        if (hipOccupancyMaxActiveBlocksPerMultiprocessor(&per_cu, (const void*)mega, NWAVES * 64, LDS_BYTES) != hipSuccess || per_cu < 1) { fprintf(stderr, "kernel_launch: occupancy query says %d\n", per_cu); }
        (void)hipGetLastError();
        grid = cus;
    }
    if (grid < 0) return;
    (void)hipMemsetAsync((char*)d_ws + WS_CTL, 0, 1 * MiB, stream);
    Params a{};
    a.x = (const float*)d_in[0]; a.p = (const float*)d_in[1]; a.pos = (const int*)d_in[2]; a.norm_mix = (const float*)d_in[3]; a.w_in = (const float*)d_in[4]; a.conv_w = (const float*)d_in[5];
    a.conv_b = (const float*)d_in[6]; a.ln_g = (const float*)d_in[7]; a.ln_b = (const float*)d_in[8]; a.g_att = (const float*)d_in[9]; a.g_conv = (const float*)d_in[10]; a.w_out = (const float*)d_in[11];
    a.norm_ffn = (const float*)d_in[12]; a.wq = (const float*)d_in[13]; a.keys = (const float*)d_in[14]; a.eu = (const float*)d_in[15]; a.ev = (const float*)d_in[16]; a.norm_ple = (const float*)d_in[17];
    a.wg = (const float*)d_in[18]; a.wp = (const float*)d_in[19]; a.fin = (const float*)d_in[20]; a.out = (float*)d_out; a.ws = (unsigned char*)d_ws;
    for (int i = 0; i < 8; ++i) a.freq[i] = (float)pow(500000.0, -(double)i / 8.0);
    hipLaunchKernelGGL(mega, dim3(grid), dim3(NWAVES * 64), LDS_BYTES, stream, a);
}
```

```cpp
#include <hip/hip_runtime.h>
#include <cstdio>
#include <cstdint>
#include <cmath>

constexpr int BATCH = 2, SEQ = 8192, DM = 1024, NTOK = BATCH * SEQ;
constexpr int PLE = 256, HD = 64, NH = 8, DATT = 512, DCONV = 512, DIN = 2560, CW = 31;
constexpr int NKEYS = 128, NEXP = 16384, PH = 8, TOPK = 16, HK = PH * TOPK;
constexpr float EPS = 1e-6f;
constexpr float QSCALE = 0.125f * 1.4426950408889634f;

typedef unsigned short bf16;
typedef unsigned v4u __attribute__((ext_vector_type(4)));
typedef unsigned v2u __attribute__((ext_vector_type(2)));
typedef float f32x4 __attribute__((ext_vector_type(4)));

constexpr size_t MiB = 1u << 20;
constexpr size_t WS_CTL = 0;
constexpr size_t WS_ROPE = 1 * MiB;
constexpr size_t WS_WIN = 2 * MiB;
constexpr size_t WS_WOUT = 7 * MiB;
constexpr size_t WS_WQK = 9 * MiB;
constexpr size_t WS_WG = 13 * MiB;
constexpr size_t WS_WP = 15 * MiB;
constexpr size_t WS_U = 16 * MiB;
constexpr size_t WS_V = 48 * MiB;
constexpr size_t WS_XN = 80 * MiB;
constexpr size_t WS_Q = 112 * MiB, WS_K = 128 * MiB, WS_VV = 144 * MiB, WS_GLU = 160 * MiB;
constexpr size_t WS_SC = 112 * MiB;
constexpr size_t WS_ATT = 176 * MiB;
constexpr size_t WS_Y = 192 * MiB;
constexpr size_t WS_EID = 224 * MiB;
constexpr size_t WS_GATE = 232 * MiB;
constexpr size_t WS_PP = 240 * MiB;
constexpr size_t WS_MISC = 248 * MiB;
constexpr size_t WS_END = 256 * MiB;

__device__ __forceinline__ unsigned f2bf(float f) { unsigned u = __float_as_uint(f); return (u + 0x7fffu + ((u >> 16) & 1u)) >> 16; }
__device__ __forceinline__ float bf2f(unsigned h) { return __uint_as_float(h << 16); }
__device__ __forceinline__ unsigned pk2(float lo, float hi) { return f2bf(lo) | (f2bf(hi) << 16); }
__device__ __forceinline__ float bflo(unsigned w) { return __uint_as_float(w << 16); }
__device__ __forceinline__ float bfhi(unsigned w) { return __uint_as_float(w & 0xffff0000u); }
__device__ __forceinline__ float wave_sum(float v) {
#pragma unroll
    for (int o = 1; o < 64; o <<= 1) v += __shfl_xor(v, o);
    return v;
}
__device__ __forceinline__ float sigmoidf_(float x) { return 1.f / (1.f + __expf(-x)); }
__device__ __forceinline__ float gelu_erf(float x) { return 0.5f * x * (1.f + erff(x * 0.70710678118654752f)); }

__device__ __forceinline__ unsigned f2key(float f) { unsigned u = __float_as_uint(f); return (u & 0x80000000u) ? ~u : (u | 0x80000000u); }
__device__ __forceinline__ float key2f(unsigned k) { unsigned u = (k & 0x80000000u) ? (k & 0x7fffffffu) : ~k; return __uint_as_float(u); }
__device__ __forceinline__ void ins16(unsigned (&L)[16], unsigned x) {
#pragma unroll
    for (int i = 0; i < 16; ++i) { const unsigned h = L[i] > x ? L[i] : x; x = L[i] > x ? x : L[i]; L[i] = h; }
}
#define INS16(L, xx) ins16(L, (xx))
__device__ __forceinline__ int sel16(const int (&a)[16], int i) {
    int v0 = a[0], v1 = a[1], v2 = a[2], v3 = a[3], v4 = a[4], v5 = a[5], v6 = a[6], v7 = a[7], v8 = a[8], v9 = a[9], v10 = a[10], v11 = a[11], v12 = a[12], v13 = a[13], v14 = a[14], v15 = a[15];
    asm volatile("" : "+v"(v0), "+v"(v1), "+v"(v2), "+v"(v3), "+v"(v4), "+v"(v5), "+v"(v6), "+v"(v7));
    asm volatile("" : "+v"(v8), "+v"(v9), "+v"(v10), "+v"(v11), "+v"(v12), "+v"(v13), "+v"(v14), "+v"(v15));
    const bool b0 = i & 1, b1 = i & 2, b2 = i & 4, b3 = i & 8;
    const int t0 = b0 ? v1 : v0, t1 = b0 ? v3 : v2, t2 = b0 ? v5 : v4, t3 = b0 ? v7 : v6, t4 = b0 ? v9 : v8, t5 = b0 ? v11 : v10, t6 = b0 ? v13 : v12, t7 = b0 ? v15 : v14;
    const int s0 = b1 ? t1 : t0, s1 = b1 ? t3 : t2, s2 = b1 ? t5 : t4, s3 = b1 ? t7 : t6;
    const int r0 = b2 ? s1 : s0, r1 = b2 ? s3 : s2;
    return b3 ? r1 : r0;
}
__device__ __forceinline__ void topk_combine(const unsigned (&La)[16], const unsigned (&Lb)[16], int* eid_out, float* gate_out) {
    float a[16], b[16]; int ia[16], ib[16];
#pragma unroll
    for (int i = 0; i < 16; ++i) { a[i] = key2f(La[i] & ~127u); ia[i] = 127 - (int)(La[i] & 127u); b[i] = key2f(Lb[i] & ~127u); ib[i] = 127 - (int)(Lb[i] & 127u);
        asm volatile("" : "+v"(ia[i]), "+v"(ib[i])); }
    unsigned Lc[16];
#pragma unroll
    for (int i = 0; i < 16; ++i) Lc[i] = 0u;
#define TK_CAND(i, j) do { const float s_ = a[i] + b[j]; const unsigned k_ = (f2key(s_) & ~255u) | (unsigned)(255 - ((i) * 16 + (j))); INS16(Lc, k_); } while (0)
    TK_CAND(0, 0); TK_CAND(0, 1); TK_CAND(0, 2); TK_CAND(0, 3); TK_CAND(0, 4); TK_CAND(0, 5); TK_CAND(0, 6); TK_CAND(0, 7);
    TK_CAND(0, 8); TK_CAND(0, 9); TK_CAND(0, 10); TK_CAND(0, 11); TK_CAND(0, 12); TK_CAND(0, 13); TK_CAND(0, 14); TK_CAND(0, 15);
    TK_CAND(1, 0); TK_CAND(1, 1); TK_CAND(1, 2); TK_CAND(1, 3); TK_CAND(1, 4); TK_CAND(1, 5); TK_CAND(1, 6); TK_CAND(1, 7);
    TK_CAND(2, 0); TK_CAND(2, 1); TK_CAND(2, 2); TK_CAND(2, 3); TK_CAND(2, 4);
    TK_CAND(3, 0); TK_CAND(3, 1); TK_CAND(3, 2); TK_CAND(3, 3);
    TK_CAND(4, 0); TK_CAND(4, 1); TK_CAND(4, 2);
    TK_CAND(5, 0); TK_CAND(5, 1); TK_CAND(6, 0); TK_CAND(6, 1); TK_CAND(7, 0); TK_CAND(7, 1);
    TK_CAND(8, 0); TK_CAND(9, 0); TK_CAND(10, 0); TK_CAND(11, 0); TK_CAND(12, 0); TK_CAND(13, 0); TK_CAND(14, 0); TK_CAND(15, 0);
#undef TK_CAND
    float sv[16]; float m = -3.0e38f;
#pragma unroll
    for (int r = 0; r < 16; ++r) { sv[r] = key2f(Lc[r] & ~255u); m = fmaxf(m, sv[r]); }
    float sum = 0.f;
#pragma unroll
    for (int r = 0; r < 16; ++r) { sv[r] = __expf(sv[r] - m); sum += sv[r]; }
    const float inv = 1.f / sum;
#pragma unroll
    for (int r = 0; r < 16; ++r) { const int c = 255 - (int)(Lc[r] & 255u); const int i1 = sel16(ia, c >> 4), i2 = sel16(ib, c & 15);
        eid_out[r] = i1 * NKEYS + i2; gate_out[r] = sv[r] * inv; }
}
namespace nv {
__device__ __forceinline__ int win_srccol(int n) { if (n < 1536) return n; const int j = n - 1536, u = j >> 8, r = j & 255; return r < 128 ? 1536 + 128 * u + r : 2048 + 128 * u + (r - 128); }
__global__ void transpose_w(const float* W, int K, int NW, int N, bf16* WT, int mode) {
    const size_t i = (size_t)blockIdx.x * blockDim.x + threadIdx.x; if (i >= (size_t)N * K) return;
    const int n = (int)(i / K), k = (int)(i % K); const int c = mode == 1 ? win_srccol(n) : n;
    WT[i] = (bf16)f2bf(W[(size_t)k * NW + c]);
}
__global__ void fold_wq(const float* wq, const float* keys, bf16* WQK) {
    const size_t i = (size_t)blockIdx.x * blockDim.x + threadIdx.x; if (i >= (size_t)2048 * 1024) return;
    const int n = (int)(i / 1024), d = (int)(i % 1024); const int hp = n >> 7, kk = n & 127, p = hp & 1;
    const float* w = wq + (size_t)d * 2048 + hp * 128; const float* kr = keys + ((size_t)p * 128 + kk) * 128; float s = 0.f;
    for (int c = 0; c < 128; ++c) s += w[c] * kr[c];
    WQK[i] = (bf16)f2bf(s);
}
__global__ void cvt_bf16(const float* src, bf16* dst, size_t n) { const size_t i = (size_t)blockIdx.x * blockDim.x + threadIdx.x; if (i < n) dst[i] = (bf16)f2bf(src[i]); }
struct Freq { float f[8]; };
__global__ void rope_table(const int* pos, float* cs, float* sn, Freq fr) {
    const int i = blockIdx.x * blockDim.x + threadIdx.x; if (i >= NTOK * 8) return;
    const float ang = (float)pos[i >> 3] * fr.f[i & 7]; cs[i] = cosf(ang); sn[i] = sinf(ang);
}
template <bool OUTF32> __device__ __forceinline__ void rms_row(int row, int lane, const float* in, const float* g, void* out) {
    const f32x4* xr = (const f32x4*)(in + (size_t)row * DM) + lane; f32x4 v[4]; float s = 0.f;
#pragma unroll
    for (int j = 0; j < 4; ++j) { v[j] = xr[64 * j]; s += v[j].x * v[j].x + v[j].y * v[j].y + v[j].z * v[j].z + v[j].w * v[j].w; }
    const float r = rsqrtf(wave_sum(s) * (1.f / DM) + EPS);
#pragma unroll
    for (int j = 0; j < 4; ++j) { const f32x4 gg = ((const f32x4*)g)[lane + 64 * j]; const f32x4 o = v[j] * r * gg;
        if (OUTF32) ((f32x4*)((float*)out + (size_t)row * DM))[lane + 64 * j] = o;
        else { v2u w; w.x = pk2(o.x, o.y); w.y = pk2(o.z, o.w); ((v2u*)((bf16*)out + (size_t)row * DM))[lane + 64 * j] = w; } }
}
template <bool OUTF32> __global__ void rms_rows(const float* in, const float* g, void* out) {
    const int row = blockIdx.x * 4 + (threadIdx.x >> 6); if (row >= NTOK) return; rms_row<OUTF32>(row, threadIdx.x & 63, in, g, out);
}
struct GP { const bf16* A; const bf16* Bt; const float* cs; const float* sn; bf16 *Q, *Kb, *Vb, *GLU; const float* x; float* H; bf16* O; const bf16* PPO; int M, N, K, pad; };
__device__ __forceinline__ void dot4(const bf16* A, const bf16* Bt, int K, int m0, int n, float (&acc)[4]) {
    const v4u* b = (const v4u*)(Bt + (size_t)n * K);
#pragma unroll
    for (int r = 0; r < 4; ++r) acc[r] = 0.f;
    for (int kc = 0; kc < K / 8; ++kc) { const v4u bw = b[kc];
#pragma unroll
        for (int r = 0; r < 4; ++r) { const v4u aw = ((const v4u*)(A + (size_t)(m0 + r) * K))[kc];
            acc[r] += bflo(aw.x) * bflo(bw.x) + bfhi(aw.x) * bfhi(bw.x) + bflo(aw.y) * bflo(bw.y) + bfhi(aw.y) * bfhi(bw.y) + bflo(aw.z) * bflo(bw.z) + bfhi(aw.z) * bfhi(bw.z) + bflo(aw.w) * bflo(bw.w) + bfhi(aw.w) * bfhi(bw.w); } }
}
template <int EPI> __global__ void gemm(GP p) {
    const int n = blockIdx.x * 256 + threadIdx.x, m0 = blockIdx.y * 4; if (n >= p.N) return;
    float acc[4];
    if (EPI == 1) {
        if (n < 1024) {
            dot4(p.A, p.Bt, p.K, m0, n, acc); const int hc = n & 63;
            if (hc < 16) { float pa[4]; dot4(p.A, p.Bt, p.K, m0, n ^ 8, pa);
#pragma unroll
                for (int r = 0; r < 4; ++r) { const float c = p.cs[(size_t)(m0 + r) * 8 + (hc & 7)], s = p.sn[(size_t)(m0 + r) * 8 + (hc & 7)];
                    acc[r] = (hc & 8) ? acc[r] * c + pa[r] * s : acc[r] * c - pa[r] * s; } }
#pragma unroll
            for (int r = 0; r < 4; ++r) { if (n < 512) p.Q[(size_t)(m0 + r) * 512 + n] = (bf16)f2bf(acc[r] * QSCALE); else p.Kb[(size_t)(m0 + r) * 512 + n - 512] = (bf16)f2bf(acc[r]); }
        } else if (n < 1536) { dot4(p.A, p.Bt, p.K, m0, n, acc);
#pragma unroll
            for (int r = 0; r < 4; ++r) p.Vb[(size_t)(m0 + r) * 512 + n - 1024] = (bf16)f2bf(acc[r]);
        } else { const int j = n - 1536, u = j >> 8, rr = j & 255; if (rr >= 128) return; float g[4]; dot4(p.A, p.Bt, p.K, m0, n, acc); dot4(p.A, p.Bt, p.K, m0, n + 128, g);
#pragma unroll
            for (int r = 0; r < 4; ++r) p.GLU[(size_t)(m0 + r) * 512 + 128 * u + rr] = (bf16)f2bf(acc[r] * sigmoidf_(g[r])); }
    } else {
        dot4(p.A, p.Bt, p.K, m0, n, acc);
#pragma unroll
        for (int r = 0; r < 4; ++r) { const size_t o = (size_t)(m0 + r) * p.N + n;
            if (EPI == 2) p.H[o] = p.x[o] + acc[r];
            if (EPI == 3) p.O[o] = (bf16)f2bf(acc[r]);
            if (EPI == 4) p.H[o] = p.H[o] + sigmoidf_(acc[r]) * bf2f(p.PPO[o]); }
    }
}
__device__ __forceinline__ void attn_item(int gw, int lane, const bf16* Q, const bf16* Kb, const bf16* Vb, bf16* ATT) {
    const int tok = gw >> 3, h = gw & 7, b = tok / SEQ, s = tok % SEQ;
    const float q = bf2f(Q[(size_t)tok * 512 + h * 64 + lane]);
    float o[3], lse[3]; const int dil[3] = {1, 4, 16};
#pragma unroll
    for (int p = 0; p < 3; ++p) { float m = -3.0e38f, l = 0.f, acc = 0.f;
        for (int j = 0; j <= 128; ++j) { const int tk = s - j * dil[p]; if (tk < 0) break; const size_t kr = ((size_t)b * SEQ + tk) * 512 + h * 64 + lane;
            const float sc = wave_sum(q * bf2f(Kb[kr])); const float mn = fmaxf(m, sc), al = exp2f(m - mn), pe = exp2f(sc - mn);
            l = l * al + pe; acc = acc * al + pe * bf2f(Vb[kr]); m = mn; }
        o[p] = acc / l; lse[p] = m + log2f(l); }
    const float M = fmaxf(lse[0], fmaxf(lse[1], lse[2])); const float w0 = exp2f(lse[0] - M), w1 = exp2f(lse[1] - M), w2 = exp2f(lse[2] - M);
    ATT[(size_t)tok * 512 + h * 64 + lane] = (bf16)f2bf((w0 * o[0] + w1 * o[1] + w2 * o[2]) / (w0 + w1 + w2));
}
__global__ void attn(const bf16* Q, const bf16* Kb, const bf16* Vb, bf16* ATT) {
    const int gw = blockIdx.x * 4 + (threadIdx.x >> 6); if (gw >= NTOK * NH) return; attn_item(gw, threadIdx.x & 63, Q, Kb, Vb, ATT);
}
__device__ __forceinline__ void mix_token(int tok, int lane, const bf16* GLU, const bf16* ATT, const float* cw, const float* cb, const float* lg, const float* lb, const float* ga, const float* gc, bf16* Y) {
    const int s = tok % SEQ, c0 = lane * 8; float acc[8];
    { const f32x4 b0 = *(const f32x4*)(cb + c0), b1 = *(const f32x4*)(cb + c0 + 4); acc[0] = b0.x; acc[1] = b0.y; acc[2] = b0.z; acc[3] = b0.w; acc[4] = b1.x; acc[5] = b1.y; acc[6] = b1.z; acc[7] = b1.w; }
    for (int j = 0; j < CW; ++j) { const int ts = s - (CW - 1) + j; if (ts < 0) continue;
        const v4u g = *(const v4u*)(GLU + (size_t)(tok - (CW - 1) + j) * 512 + c0); const f32x4 w0 = *(const f32x4*)(cw + j * 512 + c0), w1 = *(const f32x4*)(cw + j * 512 + c0 + 4);
        acc[0] += w0.x * bflo(g.x); acc[1] += w0.y * bfhi(g.x); acc[2] += w0.z * bflo(g.y); acc[3] += w0.w * bfhi(g.y); acc[4] += w1.x * bflo(g.z); acc[5] += w1.y * bfhi(g.z); acc[6] += w1.z * bflo(g.w); acc[7] += w1.w * bfhi(g.w); }
    float sm = 0.f;
#pragma unroll
    for (int i = 0; i < 8; ++i) sm += acc[i];
    const float mean = wave_sum(sm) * (1.f / 512.f); float sq = 0.f;
#pragma unroll
    for (int i = 0; i < 8; ++i) { acc[i] -= mean; sq += acc[i] * acc[i]; }
    const float rstd = rsqrtf(wave_sum(sq) * (1.f / 512.f) + EPS); float ss = 0.f;
#pragma unroll
    for (int i = 0; i < 8; ++i) { const float y = acc[i] * rstd * lg[c0 + i] + lb[c0 + i]; acc[i] = y * sigmoidf_(y); ss += acc[i] * acc[i]; }
    const float rc = rsqrtf(wave_sum(ss) * (1.f / 512.f) + EPS);
    v4u o; o.x = pk2(acc[0] * rc * gc[c0 + 0], acc[1] * rc * gc[c0 + 1]); o.y = pk2(acc[2] * rc * gc[c0 + 2], acc[3] * rc * gc[c0 + 3]); o.z = pk2(acc[4] * rc * gc[c0 + 4], acc[5] * rc * gc[c0 + 5]); o.w = pk2(acc[6] * rc * gc[c0 + 6], acc[7] * rc * gc[c0 + 7]);
    *(v4u*)(Y + (size_t)tok * 1024 + 512 + c0) = o;
    const v4u a = *(const v4u*)(ATT + (size_t)tok * 512 + c0); float av[8] = {bflo(a.x), bfhi(a.x), bflo(a.y), bfhi(a.y), bflo(a.z), bfhi(a.z), bflo(a.w), bfhi(a.w)}; float sa = 0.f;
#pragma unroll
    for (int i = 0; i < 8; ++i) sa += av[i] * av[i];
    const float ra = rsqrtf(wave_sum(sa) * (1.f / 512.f) + EPS);
    v4u oa; oa.x = pk2(av[0] * ra * ga[c0 + 0], av[1] * ra * ga[c0 + 1]); oa.y = pk2(av[2] * ra * ga[c0 + 2], av[3] * ra * ga[c0 + 3]); oa.z = pk2(av[4] * ra * ga[c0 + 4], av[5] * ra * ga[c0 + 5]); oa.w = pk2(av[6] * ra * ga[c0 + 6], av[7] * ra * ga[c0 + 7]);
    *(v4u*)(Y + (size_t)tok * 1024 + c0) = oa;
}
__global__ void mix_norm(const bf16* GLU, const bf16* ATT, const float* cw, const float* cb, const float* lg, const float* lb, const float* ga, const float* gc, bf16* Y) {
    const int tok = blockIdx.x * 4 + (threadIdx.x >> 6); if (tok >= NTOK) return; mix_token(tok, threadIdx.x & 63, GLU, ATT, cw, cb, lg, lb, ga, gc, Y);
}
__device__ __forceinline__ void topk_item(int i, const bf16* SC, int* EID, float* GATE) {
    const bf16* row = SC + (size_t)i * 256; unsigned La[16], Lb[16];
#pragma unroll
    for (int q = 0; q < 16; ++q) { La[q] = 0u; Lb[q] = 0u; }
    for (int c = 0; c < 128; ++c) { const unsigned k = (f2key(bf2f(row[c])) & ~127u) | (unsigned)(127 - c); INS16(La, k); }
    for (int c = 0; c < 128; ++c) { const unsigned k = (f2key(bf2f(row[128 + c])) & ~127u) | (unsigned)(127 - c); INS16(Lb, k); }
    int e[16]; float g[16]; topk_combine(La, Lb, e, g);
#pragma unroll
    for (int r = 0; r < 16; ++r) { EID[(size_t)i * 16 + r] = e[r]; GATE[(size_t)i * 16 + r] = g[r]; }
}
__global__ void topk(const bf16* SC, int* EID, float* GATE) {
    const int i = blockIdx.x * blockDim.x + threadIdx.x; if (i >= NTOK * PH) return; topk_item(i, SC, EID, GATE);
}
__device__ __forceinline__ void peer_token(int tok, int lane, const bf16* XN, const bf16* U, const bf16* V, const int* EID, const float* GATE, float* H) {
    float x[16], y[16];
    { const v4u a = ((const v4u*)(XN + (size_t)tok * 1024))[lane * 2], b = ((const v4u*)(XN + (size_t)tok * 1024))[lane * 2 + 1];
      x[0] = bflo(a.x); x[1] = bfhi(a.x); x[2] = bflo(a.y); x[3] = bfhi(a.y); x[4] = bflo(a.z); x[5] = bfhi(a.z); x[6] = bflo(a.w); x[7] = bfhi(a.w);
      x[8] = bflo(b.x); x[9] = bfhi(b.x); x[10] = bflo(b.y); x[11] = bfhi(b.y); x[12] = bflo(b.z); x[13] = bfhi(b.z); x[14] = bflo(b.w); x[15] = bfhi(b.w); }
#pragma unroll
    for (int i = 0; i < 16; ++i) y[i] = 0.f;
    for (int k = 0; k < HK; ++k) { const int e = EID[(size_t)tok * HK + k]; const float g = GATE[(size_t)tok * HK + k];
        const v4u a = ((const v4u*)(U + (size_t)e * 1024))[lane * 2], b = ((const v4u*)(U + (size_t)e * 1024))[lane * 2 + 1];
        float d = x[0] * bflo(a.x) + x[1] * bfhi(a.x) + x[2] * bflo(a.y) + x[3] * bfhi(a.y) + x[4] * bflo(a.z) + x[5] * bfhi(a.z) + x[6] * bflo(a.w) + x[7] * bfhi(a.w)
                + x[8] * bflo(b.x) + x[9] * bfhi(b.x) + x[10] * bflo(b.y) + x[11] * bfhi(b.y) + x[12] * bflo(b.z) + x[13] * bfhi(b.z) + x[14] * bflo(b.w) + x[15] * bfhi(b.w);
        d = wave_sum(d); const float act = gelu_erf(d) * g;
        const v4u c = ((const v4u*)(V + (size_t)e * 1024))[lane * 2], dd = ((const v4u*)(V + (size_t)e * 1024))[lane * 2 + 1];
        y[0] += act * bflo(c.x); y[1] += act * bfhi(c.x); y[2] += act * bflo(c.y); y[3] += act * bfhi(c.y); y[4] += act * bflo(c.z); y[5] += act * bfhi(c.z); y[6] += act * bflo(c.w); y[7] += act * bfhi(c.w);
        y[8] += act * bflo(dd.x); y[9] += act * bfhi(dd.x); y[10] += act * bflo(dd.y); y[11] += act * bfhi(dd.y); y[12] += act * bflo(dd.z); y[13] += act * bfhi(dd.z); y[14] += act * bflo(dd.w); y[15] += act * bfhi(dd.w); }
    float* hr = H + (size_t)tok * 1024 + lane * 16;
#pragma unroll
    for (int i = 0; i < 4; ++i) { f32x4 v = ((f32x4*)hr)[i]; v.x += y[4 * i]; v.y += y[4 * i + 1]; v.z += y[4 * i + 2]; v.w += y[4 * i + 3]; ((f32x4*)hr)[i] = v; }
}
__global__ void peer(const bf16* XN, const bf16* U, const bf16* V, const int* EID, const float* GATE, float* H) {
    const int tok = blockIdx.x * 4 + (threadIdx.x >> 6); if (tok >= NTOK) return; peer_token(tok, threadIdx.x & 63, XN, U, V, EID, GATE, H);
}
}
namespace pg8 {
#define PG8_LAS __attribute__((address_space(3)))
typedef unsigned short bf16_t;
typedef short bf16x8 __attribute__((ext_vector_type(8)));
typedef float f32x4 __attribute__((ext_vector_type(4)));
typedef unsigned u32x4 __attribute__((ext_vector_type(4)));
constexpr int BM = 256, BK = 64, HALF = 128, HTB = HALF * BK * 2  , STAGE_BYTES = 8 * HTB, NXCD = 8, WGM = 8;

__host__ __device__ __forceinline__ int lds_byte(int r, int c) { const int st = (r >> 4) * 2 + (c >> 5), rr = r & 15, cc = c & 31, ob = rr * 64 + cc * 2; return st * 1024 + (ob ^ (((ob >> 9) & 1) << 5)); }
__host__ __device__ __forceinline__ void stage_rc(int b, int& R, int& C) { const int st = b / 1024, sb = b % 1024, swz = sb ^ (((sb >> 9) & 1) << 5); R = (st >> 1) * 16 + swz / 64; C = (st & 1) * 32 + (swz % 64) / 2; }
__host__ __device__ __forceinline__ int perm32(int rho) { const int n = rho >> 4, i = rho & 15; return 8 * (i >> 2) + 4 * n + (i & 3); }

struct Unit { int pm, pn; };
struct Gemm { const bf16_t* A; const bf16_t* Bt; int M, N, K; };

struct StaticOrder {
    int nM, nN, nwg, G, c;
    __host__ __device__ void init(int M, int N, int G_, int c_) { nM = M / BM; nN = N / BM; nwg = nM * nN; G = G_; c = c_; }
    __host__ __device__ bool next(int i, Unit& u) const {
        const long L = (long)i * G + c; if (L >= nwg) return false;
        int wgid = (int)L; { const int q = nwg / NXCD, r = nwg % NXCD, xcd = wgid % NXCD, off = wgid / NXCD; wgid = (xcd < r ? xcd * (q + 1) : r * (q + 1) + (xcd - r) * q) + off; }
        const int nig = WGM * nN, gid = wgid / nig, fm = gid * WGM, gsz = (nM - fm) < WGM ? (nM - fm) : WGM;
        u.pm = fm + ((wgid % nig) % gsz); u.pn = (wgid % nig) / gsz; return true;
    }
    __device__ __forceinline__ void a_ready(const Unit&) const {}
    __device__ __forceinline__ void done(const Unit&) const {}
};

__device__ __forceinline__ unsigned cvt_pk_bf16(float lo, float hi) { unsigned r; asm volatile("v_cvt_pk_bf16_f32 %0, %1, %2" : "=v"(r) : "v"(lo), "v"(hi)); return r; }
typedef float f32x2 __attribute__((ext_vector_type(2)));
__device__ __forceinline__ f32x2 gelu_pk(f32x2 v) {
    const f32x2 av = __builtin_elementwise_abs(v), d = av * 0.2316418882f + 1.0f;
    f32x2 t; t.x = __builtin_amdgcn_rcpf(d.x); t.y = __builtin_amdgcn_rcpf(d.y);
    f32x2 q = t * 0.5307027145f + (-0.7265760135f); q = q * t + 0.7107068705f; q = q * t + (-0.142248368f); q = q * t + 0.127414796f; q = q * t;
    const f32x2 s = (v * v) * (-0.72134752044f);
    f32x2 e; e.x = __builtin_amdgcn_exp2f(s.x); e.y = __builtin_amdgcn_exp2f(s.y);
    const f32x2 m = v * (q * e), r = v - m;
    f32x2 o; o.x = v.x < 0.f ? m.x : r.x; o.y = v.y < 0.f ? m.y : r.y; return o;
}

template <int ACT  > struct EpiBf16 {
    static constexpr bool PERM = true, AFTER_DRAIN = false; static_assert(ACT == 0 || ACT == 1, "EpiBf16: ACT is 0 (none) or 1 (gelu_pk)");
    bf16_t* O; int ldc; const float* bias; int split_cols; size_t split_stride; float scale0;
    __device__ __forceinline__ void operator()(const f32x4 (&acc)[2][2][4][2], const Unit& u, int wr, int wc, int fr, int fq) const {
        const int row0 = u.pm * BM + wr * 64 + fr; int colt = u.pn * BM; bf16_t* base = O;
        float sc = 1.f; if (split_cols) { const int t = colt / split_cols; base += (size_t)t * split_stride; colt -= t * split_cols; if (t == 0) sc = scale0; }
        const int col0 = colt + wc * 32 + 8 * fq, bcol0 = u.pn * BM + wc * 32 + 8 * fq;
        f32x4 bv[2][2];
#pragma unroll
        for (int bj = 0; bj < 2; ++bj)
#pragma unroll
            for (int n = 0; n < 2; ++n) bv[bj][n] = bias ? *(const f32x4*)(bias + bcol0 + bj * HALF + 4 * n) : (f32x4){0.f, 0.f, 0.f, 0.f};
#pragma unroll
        for (int ai = 0; ai < 2; ++ai)
#pragma unroll
            for (int m = 0; m < 4; ++m) { bf16_t* rowp = base + (size_t)(row0 + ai * HALF + m * 16) * ldc + col0;
#pragma unroll
                for (int bj = 0; bj < 2; ++bj) { f32x4 v0 = acc[ai][bj][m][0] + bv[bj][0], v1 = acc[ai][bj][m][1] + bv[bj][1];
                    if (ACT == 1) { f32x2 a = gelu_pk((f32x2){v0[0], v0[1]}), b = gelu_pk((f32x2){v0[2], v0[3]}), c = gelu_pk((f32x2){v1[0], v1[1]}), d = gelu_pk((f32x2){v1[2], v1[3]});
                        v0 = (f32x4){a.x, a.y, b.x, b.y}; v1 = (f32x4){c.x, c.y, d.x, d.y}; }
                    v0 = v0 * sc; v1 = v1 * sc; u32x4 w; w.x = cvt_pk_bf16(v0[0], v0[1]); w.y = cvt_pk_bf16(v0[2], v0[3]); w.z = cvt_pk_bf16(v1[0], v1[1]); w.w = cvt_pk_bf16(v1[2], v1[3]);
                    *(u32x4*)(rowp + bj * HALF) = w; } }
    }
};
struct EpiInProj {
    static constexpr bool PERM = true, AFTER_DRAIN = false;
    bf16_t* QKVG; const float* cs; const float* sn;
    __device__ __forceinline__ void operator()(const f32x4 (&acc)[2][2][4][2], const Unit& u, int wr, int wc, int fr, int fq) const {
        const int row0 = u.pm * BM + wr * 64 + fr;
        if (u.pn < 6) {
            bf16_t* dst = QKVG + (size_t)(u.pn >> 1) * ((size_t)16384 * 512);
            const int col0 = (u.pn & 1) * 256 + wc * 32 + 8 * fq;
            const bool rope_wave = (u.pn < 4) && ((wc & 1) == 0);
            const float sc = u.pn < 2 ? 0.125f * 1.4426950408889634f : 1.f;
#pragma unroll
            for (int ai = 0; ai < 2; ++ai)
#pragma unroll
                for (int m = 0; m < 4; ++m) { const int row = row0 + ai * HALF + m * 16;
                    f32x4 c0 = {1.f, 1.f, 1.f, 1.f}, c1 = c0, s0 = {0.f, 0.f, 0.f, 0.f}, s1 = s0;
                    if (rope_wave) { c0 = *(const f32x4*)(cs + (size_t)row * 8); c1 = *(const f32x4*)(cs + (size_t)row * 8 + 4); s0 = *(const f32x4*)(sn + (size_t)row * 8); s1 = *(const f32x4*)(sn + (size_t)row * 8 + 4); }
#pragma unroll
                    for (int bj = 0; bj < 2; ++bj) { f32x4 v0 = acc[ai][bj][m][0], v1 = acc[ai][bj][m][1];
                        if (rope_wave) { f32x4 p0, p1;
                            p0.x = __shfl_xor(v0.x, 16); p0.y = __shfl_xor(v0.y, 16); p0.z = __shfl_xor(v0.z, 16); p0.w = __shfl_xor(v0.w, 16);
                            p1.x = __shfl_xor(v1.x, 16); p1.y = __shfl_xor(v1.y, 16); p1.z = __shfl_xor(v1.z, 16); p1.w = __shfl_xor(v1.w, 16);
                            if (fq == 0) { v0 = v0 * c0 - p0 * s0; v1 = v1 * c1 - p1 * s1; }
                            else if (fq == 1) { v0 = v0 * c0 + p0 * s0; v1 = v1 * c1 + p1 * s1; } }
                        v0 = v0 * sc; v1 = v1 * sc; u32x4 w; w.x = cvt_pk_bf16(v0[0], v0[1]); w.y = cvt_pk_bf16(v0[2], v0[3]); w.z = cvt_pk_bf16(v1[0], v1[1]); w.w = cvt_pk_bf16(v1[2], v1[3]);
                        *(u32x4*)(dst + (size_t)row * 512 + col0 + bj * HALF) = w; } }
        } else {
            const int ch0 = (u.pn - 6) * 128 + wc * 32 + 8 * fq;
#pragma unroll
            for (int ai = 0; ai < 2; ++ai)
#pragma unroll
                for (int m = 0; m < 4; ++m) { const int row = row0 + ai * HALF + m * 16;
                    const f32x4 a0 = acc[ai][0][m][0], g0 = acc[ai][1][m][0], a1 = acc[ai][0][m][1], g1 = acc[ai][1][m][1];
#define GLU1(av, gv) ((av) * __builtin_amdgcn_rcpf(1.f + __expf(-(gv))))
                    u32x4 w; w.x = cvt_pk_bf16(GLU1(a0.x, g0.x), GLU1(a0.y, g0.y)); w.y = cvt_pk_bf16(GLU1(a0.z, g0.z), GLU1(a0.w, g0.w)); w.z = cvt_pk_bf16(GLU1(a1.x, g1.x), GLU1(a1.y, g1.y)); w.w = cvt_pk_bf16(GLU1(a1.z, g1.z), GLU1(a1.w, g1.w));
#undef GLU1
                    *(u32x4*)(QKVG + (size_t)3 * 16384 * 512 + (size_t)row * 512 + ch0) = w; }
        }
    }
};
struct EpiResid {
    static constexpr bool PERM = false, AFTER_DRAIN = false;
    const float* base; float* H;
    __device__ __forceinline__ void operator()(const f32x4 (&acc)[2][2][4][2], const Unit& u, int wr, int wc, int fr, int fq) const {
        const int row0 = u.pm * BM + wr * 64 + fr, col0 = u.pn * BM + wc * 32 + 4 * fq;
#pragma unroll
        for (int ai = 0; ai < 2; ++ai)
#pragma unroll
            for (int m = 0; m < 4; ++m) { const size_t ro = (size_t)(row0 + ai * HALF + m * 16) * 1024 + col0;
#pragma unroll
                for (int bj = 0; bj < 2; ++bj)
#pragma unroll
                    for (int n = 0; n < 2; ++n) { const size_t o = ro + bj * HALF + n * 16; *(f32x4*)(H + o) = *(const f32x4*)(base + o) + acc[ai][bj][m][n]; }
                if (m & 1) asm volatile("" ::: "memory"); }
    }
};
struct EpiPle {
    static constexpr bool PERM = false, AFTER_DRAIN = false;
    float* H; const bf16_t* PPO;
    __device__ __forceinline__ void operator()(const f32x4 (&acc)[2][2][4][2], const Unit& u, int wr, int wc, int fr, int fq) const {
        typedef unsigned u32x2 __attribute__((ext_vector_type(2)));
        const int row0 = u.pm * BM + wr * 64 + fr, col0 = u.pn * BM + wc * 32 + 4 * fq;
#pragma unroll
        for (int ai = 0; ai < 2; ++ai)
#pragma unroll
            for (int m = 0; m < 4; ++m) { const size_t ro = (size_t)(row0 + ai * HALF + m * 16) * 1024 + col0;
#pragma unroll
                for (int bj = 0; bj < 2; ++bj)
#pragma unroll
                    for (int n = 0; n < 2; ++n) { const size_t o = ro + bj * HALF + n * 16; const u32x2 pw = *(const u32x2*)(PPO + o); const f32x4 a = acc[ai][bj][m][n]; f32x4 h = *(const f32x4*)(H + o);
                        h[0] += __builtin_amdgcn_rcpf(1.f + __expf(-a[0])) * __uint_as_float(pw.x << 16); h[1] += __builtin_amdgcn_rcpf(1.f + __expf(-a[1])) * __uint_as_float(pw.x & 0xffff0000u);
                        h[2] += __builtin_amdgcn_rcpf(1.f + __expf(-a[2])) * __uint_as_float(pw.y << 16); h[3] += __builtin_amdgcn_rcpf(1.f + __expf(-a[3])) * __uint_as_float(pw.y & 0xffff0000u);
                        *(f32x4*)(H + o) = h; }
                if (m & 1) asm volatile("" ::: "memory"); }
    }
};
template <class Epi, class Sched, bool ALIGN_EPI = false, bool SP2 = false>
__device__ __forceinline__ void gemm_phase(PG8_LAS unsigned char* lds, const Gemm g, const Sched& S, const Epi& E) {
    int tid_ = threadIdx.x; asm volatile("" : "+v"(tid_));
    const int tid = tid_, wid = __builtin_amdgcn_readfirstlane(tid >> 6), lane = tid & 63, wr = wid >> 2, wc = wid & 3, fr = lane & 15, fq = lane >> 4;
    const int K = g.K, nt = K / BK;
    unsigned voffA[2], voffB[2];
#pragma unroll
    for (int i = 0; i < 2; ++i) { int R, C; stage_rc(tid * 16 + i * 8192, R, C); const int Rb = Epi::PERM ? ((R & ~31) + perm32(R & 31)) : R;
        voffA[i] = (unsigned)(R * K + C) * 2u; voffB[i] = (unsigned)(Rb * K + C) * 2u; }
    const size_t kstep = (size_t)(BK * 2);
    const size_t hstep = (size_t)HALF * K * 2;
    const size_t tstep = 2 * hstep;
    const unsigned ldsw = (unsigned)wid * 1024u;
    const int aoff = lds_byte(wr * 64 + fr, fq * 8), boff = lds_byte(wc * 32 + fr, fq * 8);
#define PG8_SA(b, h) (((b) * 2 + (h)) * HTB)
#define PG8_SB(b, h) ((4 + (b) * 2 + (h)) * HTB)
#define PG8_STAGE(bufoff, gbase, voff) do { _Pragma("unroll") for (int _i = 0; _i < 2; ++_i) \
        __builtin_amdgcn_global_load_lds((const unsigned*)((const char*)(gbase) + (voff)[_i]), (PG8_LAS unsigned*)(lds + (bufoff) + ldsw + _i * 8192), 16, 0, 0); } while (0)
#define PG8_LDA(dst, b, h) do { _Pragma("unroll") for (int m = 0; m < 4; ++m) _Pragma("unroll") for (int k = 0; k < 2; ++k) dst[m][k] = *(const PG8_LAS bf16x8*)(lds + PG8_SA(b, h) + aoff + m * 2048 + k * 1024); } while (0)
#define PG8_LDB(dst, b, h) do { _Pragma("unroll") for (int n = 0; n < 2; ++n) _Pragma("unroll") for (int k = 0; k < 2; ++k) dst[n][k] = *(const PG8_LAS bf16x8*)(lds + PG8_SB(b, h) + boff + n * 2048 + k * 1024); } while (0)
#define PG8_MMA(ai, bj, At, Bt) do { __builtin_amdgcn_s_setprio(1); _Pragma("unroll") for (int m = 0; m < 4; ++m) _Pragma("unroll") for (int n = 0; n < 2; ++n) _Pragma("unroll") for (int k = 0; k < 2; ++k) \
        acc[ai][bj][m][n] = __builtin_amdgcn_mfma_f32_16x16x32_bf16(Bt[n][k], At[m][k], acc[ai][bj][m][n], 0, 0, 0); __builtin_amdgcn_s_setprio(0); } while (0)
#define PG8_WAIT_V(n) asm volatile("s_waitcnt vmcnt(" #n ")" ::: "memory")
#define PG8_WAIT_L(n) asm volatile("s_waitcnt lgkmcnt(" #n ")" ::: "memory")
#define PG8_BAR __builtin_amdgcn_s_barrier()
#define PG8_SCHED __builtin_amdgcn_sched_barrier(0)
    Unit cur, nxt; int ui = 0;
    if (!S.next(0, cur)) return;
    f32x4 acc[2][2][4][2];
#pragma unroll
    for (int a = 0; a < 2; ++a)
#pragma unroll
        for (int b = 0; b < 2; ++b)
#pragma unroll
            for (int m = 0; m < 4; ++m)
#pragma unroll
                for (int n = 0; n < 2; ++n) acc[a][b][m][n] = (f32x4){0.f, 0.f, 0.f, 0.f};
    bf16x8 At[4][2], B0[2][2], B1[2][2];
    const char* cA = (const char*)g.A + (size_t)cur.pm * tstep; const char* cB = (const char*)g.Bt + (size_t)cur.pn * tstep;
    S.a_ready(cur);
    if constexpr (SP2) {
        PG8_STAGE(PG8_SB(0, 0), cB, voffB); PG8_STAGE(PG8_SB(0, 1), cB + hstep, voffB); PG8_STAGE(PG8_SA(0, 0), cA, voffA); PG8_STAGE(PG8_SA(0, 1), cA + hstep, voffA);
        if (wr == 1) PG8_BAR;
        PG8_WAIT_V(2); PG8_BAR;
        PG8_STAGE(PG8_SB(1, 0), cB + kstep, voffB); PG8_STAGE(PG8_SA(1, 0), cA + kstep, voffA); PG8_STAGE(PG8_SB(1, 1), cB + hstep + kstep, voffB);
        PG8_WAIT_V(6); PG8_BAR;
    } else {
        PG8_STAGE(PG8_SB(0, 0), cB, voffB); PG8_STAGE(PG8_SA(0, 0), cA, voffA); PG8_STAGE(PG8_SB(0, 1), cB + hstep, voffB); PG8_STAGE(PG8_SA(0, 1), cA + hstep, voffA);
        if (wr == 1) PG8_BAR;
        PG8_WAIT_V(4); PG8_BAR;
        PG8_STAGE(PG8_SB(1, 0), cB + kstep, voffB); PG8_STAGE(PG8_SA(1, 0), cA + kstep, voffA); PG8_STAGE(PG8_SB(1, 1), cB + hstep + kstep, voffB);
        PG8_WAIT_V(6); PG8_BAR;
    }
    for (;;) {
        const bool has_next = S.next(ui + 1, nxt);
        const char* nA = has_next ? (const char*)g.A + (size_t)nxt.pm * tstep : cA; const char* nB = has_next ? (const char*)g.Bt + (size_t)nxt.pn * tstep : cB;
        for (int t = 0; t < nt; t += 2) {
            const bool last = (t == nt - 2);
            const char* a1 = cA + (size_t)(t + 1) * kstep;
            const char* a2 = last ? nA : cA + (size_t)(t + 2) * kstep; const char* b2 = last ? nB : cB + (size_t)(t + 2) * kstep;
            const char* a3 = a2 + kstep; const char* b3 = b2 + kstep;
            if (last && has_next) S.a_ready(nxt);
            if constexpr (SP2) {
            PG8_LDB(B0, 0, 0); PG8_LDB(B1, 0, 1); PG8_SCHED; PG8_LDA(At, 0, 0); PG8_STAGE(PG8_SA(1, 1), a1 + hstep, voffA);
            PG8_WAIT_V(8); PG8_WAIT_L(0); PG8_BAR; PG8_MMA(0, 0, At, B0); PG8_MMA(0, 1, At, B1); PG8_BAR; PG8_SCHED;
            PG8_LDA(At, 0, 1); PG8_STAGE(PG8_SB(0, 0), b2, voffB); PG8_STAGE(PG8_SB(0, 1), b2 + hstep, voffB); PG8_STAGE(PG8_SA(0, 0), a2, voffA);
            PG8_WAIT_V(8); PG8_WAIT_L(0); PG8_BAR; PG8_MMA(1, 0, At, B0); PG8_MMA(1, 1, At, B1); PG8_BAR; PG8_SCHED;
            PG8_LDB(B0, 1, 0); PG8_LDB(B1, 1, 1); PG8_SCHED; PG8_LDA(At, 1, 0); PG8_STAGE(PG8_SA(0, 1), a2 + hstep, voffA);
            PG8_WAIT_V(8); PG8_WAIT_L(0); PG8_BAR; PG8_MMA(0, 0, At, B0); PG8_MMA(0, 1, At, B1); PG8_BAR; PG8_SCHED;
            PG8_LDA(At, 1, 1); PG8_STAGE(PG8_SB(1, 0), b3, voffB); PG8_STAGE(PG8_SB(1, 1), b3 + hstep, voffB); PG8_STAGE(PG8_SA(1, 0), a3, voffA);
            PG8_WAIT_V(8); PG8_WAIT_L(0); PG8_BAR; PG8_MMA(1, 0, At, B0); PG8_MMA(1, 1, At, B1); PG8_BAR; PG8_SCHED;
            } else {
            PG8_LDB(B0, 0, 0); PG8_SCHED; PG8_LDA(At, 0, 0); PG8_STAGE(PG8_SA(1, 1), a1 + hstep, voffA);
            PG8_WAIT_L(8); PG8_BAR; PG8_WAIT_L(0); PG8_MMA(0, 0, At, B0); PG8_BAR; PG8_SCHED;
            PG8_LDB(B1, 0, 1); PG8_STAGE(PG8_SB(0, 0), b2, voffB);
            PG8_BAR; PG8_WAIT_L(0); PG8_MMA(0, 1, At, B1); PG8_BAR;
            PG8_LDA(At, 0, 1); PG8_STAGE(PG8_SA(0, 0), a2, voffA);
            PG8_BAR; PG8_WAIT_L(0); PG8_MMA(1, 0, At, B0); PG8_BAR; PG8_SCHED;
            PG8_STAGE(PG8_SB(0, 1), b2 + hstep, voffB);
            PG8_WAIT_V(6); PG8_BAR; PG8_MMA(1, 1, At, B1); PG8_BAR;
            PG8_LDB(B0, 1, 0); PG8_SCHED; PG8_LDA(At, 1, 0); PG8_STAGE(PG8_SA(0, 1), a2 + hstep, voffA);
            PG8_WAIT_L(8); PG8_BAR; PG8_WAIT_L(0); PG8_MMA(0, 0, At, B0); PG8_BAR; PG8_SCHED;
            PG8_LDB(B1, 1, 1); PG8_STAGE(PG8_SB(1, 0), b3, voffB);
            PG8_BAR; PG8_WAIT_L(0); PG8_MMA(0, 1, At, B1); PG8_BAR;
            PG8_LDA(At, 1, 1); PG8_STAGE(PG8_SA(1, 0), a3, voffA);
            PG8_BAR; PG8_WAIT_L(0); PG8_MMA(1, 0, At, B0); PG8_BAR; PG8_SCHED;
            PG8_STAGE(PG8_SB(1, 1), b3 + hstep, voffB);
            PG8_WAIT_V(6); PG8_BAR; PG8_MMA(1, 1, At, B1); PG8_BAR;
            }
        }
        if constexpr (ALIGN_EPI) { if (wr == 0) PG8_BAR; }
        if constexpr (!Epi::AFTER_DRAIN) { E(acc, cur, wr, wc, fr, fq); S.done(cur); }
        if (!has_next) break;
#pragma unroll
        for (int a = 0; a < 2; ++a)
#pragma unroll
            for (int b = 0; b < 2; ++b)
#pragma unroll
                for (int m = 0; m < 4; ++m)
#pragma unroll
                    for (int n = 0; n < 2; ++n) acc[a][b][m][n] = (f32x4){0.f, 0.f, 0.f, 0.f};
        cur = nxt; cA = nA; cB = nB; ++ui;
        if constexpr (ALIGN_EPI) { if (wr == 1) PG8_BAR; }
    }
    PG8_WAIT_V(0);
    if constexpr (!ALIGN_EPI) { if (wr == 0) PG8_BAR; }
    PG8_BAR;
    if constexpr (Epi::AFTER_DRAIN) { E.fused(acc, cur, wr, wc, fr, fq, lds, wid, lane); S.done(cur); }
#undef PG8_SA
#undef PG8_SB
#undef PG8_STAGE
#undef PG8_LDA
#undef PG8_LDB
#undef PG8_MMA
#undef PG8_WAIT_V
#undef PG8_WAIT_L
#undef PG8_BAR
#undef PG8_SCHED
}
}
#define GAS __attribute__((address_space(1)))
#define LAS __attribute__((address_space(3)))
typedef short bf16x8 __attribute__((ext_vector_type(8)));
typedef GAS unsigned gu32;
typedef GAS unsigned long long gu64;
#define RLX_AGENT __ATOMIC_RELAXED, __HIP_MEMORY_SCOPE_AGENT
#define LDS_WAIT() asm volatile("s_waitcnt lgkmcnt(0)" ::: "memory")
#define VM_WAIT() asm volatile("s_waitcnt vmcnt(0)" ::: "memory")
__device__ __forceinline__ unsigned long long rt() { return __builtin_amdgcn_s_memrealtime(); }

#define XB_TMO      128
#define XB_XCNT(j)  (256  + 64 * (j))
#define XB_XSUB(j)  (1280 + 64 * (j))
#define XB_XGEN(j)  (2304 + 64 * (j))
#define XB_TOP      3328
#define XB_TOPGEN   3392
#define XCD_BAR_WORDS 3456
#define XB_SPIN_CAP (1u << 18)

__device__ __forceinline__ unsigned xb_ld(unsigned* p)              { return __hip_atomic_load(p, __ATOMIC_RELAXED, __HIP_MEMORY_SCOPE_AGENT); }
__device__ __forceinline__ unsigned xb_add(unsigned* p, unsigned v) { return __hip_atomic_fetch_add(p, v, __ATOMIC_RELAXED, __HIP_MEMORY_SCOPE_AGENT); }
__device__ __forceinline__ unsigned xb_xcc_id() { return (unsigned)__builtin_amdgcn_s_getreg((3 << 11) | 20) & 0xFu; }
#define XB_SPIN(cond, bar) do { unsigned _sp = 0; while (cond) { __builtin_amdgcn_s_sleep(1); \
    if ((++_sp & 255u) == 0u) { if (xb_ld(&(bar)[XB_TMO])) break; if (_sp > XB_SPIN_CAP) { atomicAdd(&(bar)[XB_TMO], 1u); break; } } } } while (0)

struct XcdBarrier {
    unsigned* bar; unsigned x;
    volatile LAS unsigned* st;
};

__device__ __forceinline__ XcdBarrier xcd_barrier_post(unsigned* bar, volatile LAS unsigned* st) {
    XcdBarrier b; b.bar = bar; b.x = xb_xcc_id(); b.st = st;
    if (threadIdx.x == 0) (void)xb_add(&bar[XB_XCNT(b.x)], 1u);
    return b;
}
__device__ __forceinline__ void xcd_barrier_complete(unsigned* bar, unsigned x, unsigned& nloc, unsigned& nx) {
    const unsigned G = gridDim.x * gridDim.y * gridDim.z;
    unsigned sum, cnt, mine, sp = 0u;
    for (;;) {
        sum = 0u; cnt = 0u; mine = 0u;
#pragma unroll
        for (unsigned j = 0; j < 16; ++j) { const unsigned c = xb_ld(&bar[XB_XCNT(j)]); sum += c; cnt += (c > 0u) ? 1u : 0u; mine = (j == x) ? c : mine; }
        if (sum == G) break;
        __builtin_amdgcn_s_sleep(1);
        if ((++sp & 255u) == 0u) { if (xb_ld(&bar[XB_TMO])) break; if (sp > XB_SPIN_CAP) { atomicAdd(&bar[XB_TMO], 1u); break; } }
    }
    nloc = mine > 0u ? mine : 1u; nx = cnt > 0u ? cnt : 1u;
}

__device__ __forceinline__ void xcd_barrier(const XcdBarrier& b) {
    asm volatile("s_waitcnt vmcnt(0)" ::: "memory");
    __syncthreads();
    if (threadIdx.x == 0) {
        unsigned* bar = b.bar;
        __builtin_amdgcn_s_waitcnt(0);
        unsigned nloc = b.st[0], nx = b.st[1];
        if (nloc == 0u) { xcd_barrier_complete(bar, b.x, nloc, nx); b.st[0] = nloc; b.st[1] = nx; }
        const unsigned old = xb_add(&bar[XB_XSUB(b.x)], 1u);
        const unsigned gen = old / nloc;
        if (old + 1u == (gen + 1u) * nloc) {
            __builtin_amdgcn_fence(__ATOMIC_RELEASE, "agent");
            asm volatile("s_waitcnt vmcnt(0)" ::: "memory");
            const unsigned og = xb_add(&bar[XB_TOP], 1u);
            const unsigned tg = og / nx;
            if (og + 1u == (tg + 1u) * nx) xb_add(&bar[XB_TOPGEN], 1u);
            else XB_SPIN(xb_ld(&bar[XB_TOPGEN]) == tg, bar);
            __builtin_amdgcn_fence(__ATOMIC_ACQUIRE, "agent");
            xb_add(&bar[XB_XGEN(b.x)], 1u);
            asm volatile("s_waitcnt vmcnt(0)" ::: "memory");
        } else {
            XB_SPIN(xb_ld(&bar[XB_XGEN(b.x)]) == gen, bar);
            __builtin_amdgcn_fence(__ATOMIC_ACQUIRE, "agent");
            asm volatile("s_waitcnt vmcnt(0)" ::: "memory");
        }
    }
    __syncthreads();
}
namespace att {
typedef short s16x8 __attribute__((ext_vector_type(8)));
typedef short s16x4 __attribute__((ext_vector_type(4)));
constexpr int PITCH = 144;
constexpr int KOFF = 0, VOFF = 256 * PITCH;
typedef float f32x2_t __attribute__((ext_vector_type(2))); typedef __bf16 bf16x2_t __attribute__((ext_vector_type(2)));
__device__ __forceinline__ unsigned cvtpk(float lo, float hi) { f32x2_t v = {lo, hi}; bf16x2_t b = __builtin_convertvector(v, bf16x2_t); return __builtin_bit_cast(unsigned, b); }

struct QState { s16x8 q0, q1; f32x4 o[4]; float m, l; };

__device__ __forceinline__ void tile(QState& S, const s16x8 k0, const s16x8 k1, const s16x4 (&vf)[4], int base, int dq, unsigned limB, unsigned limC) {
    f32x4 s = {0.f, 0.f, 0.f, 0.f};
    s = __builtin_amdgcn_mfma_f32_16x16x32_bf16(k0, S.q0, s, 0, 0, 0);
    s = __builtin_amdgcn_mfma_f32_16x16x32_bf16(k1, S.q1, s, 0, 0, 0);
    float wf[4], sm[4];
#pragma unroll
    for (int j = 0; j < 4; ++j) { const unsigned ud = (unsigned)(base + dq - 16 * j); const int w = (ud < 129u ? 1 : 0) + (ud < limB ? 1 : 0) + (ud < limC ? 1 : 0);
        wf[j] = (float)w; sm[j] = w ? s[j] : -1.0e30f; }
    float tm = fmaxf(fmaxf(sm[0], sm[1]), fmaxf(sm[2], sm[3]));
    tm = fmaxf(tm, __shfl_xor(tm, 16)); tm = fmaxf(tm, __shfl_xor(tm, 32));
    const float mn = fmaxf(S.m, tm), al = __builtin_amdgcn_exp2f(S.m - mn); S.m = mn;
    float p[4], ps = 0.f;
#pragma unroll
    for (int j = 0; j < 4; ++j) { p[j] = wf[j] * __builtin_amdgcn_exp2f(sm[j] - mn); ps += p[j]; }
    S.l = S.l * al + ps;
    typedef unsigned u32x2 __attribute__((ext_vector_type(2)));
    u32x2 pw; pw.x = cvtpk(p[0], p[1]); pw.y = cvtpk(p[2], p[3]);
    const s16x4 pb = __builtin_bit_cast(s16x4, pw);
#pragma unroll
    for (int dt = 0; dt < 4; ++dt) { S.o[dt] = S.o[dt] * al; S.o[dt] = __builtin_amdgcn_mfma_f32_16x16x16bf16_1k(vf[dt], pb, S.o[dt], 0, 0, 0); }
}

__device__ __forceinline__ void phase(LAS unsigned char* lds, const bf16* Q, const bf16* Kb, const bf16* Vb, bf16* ATT, int vcu, int G) {
    int tid_ = threadIdx.x; asm volatile("" : "+v"(tid_));
    const int tid = tid_, lane = tid & 63, wave = __builtin_amdgcn_readfirstlane(tid >> 6), g = lane >> 4, i16 = lane & 15;
    const int klane = i16 * PITCH + 16 * g, vlane = (4 * g + (i16 >> 2)) * PITCH + 8 * (i16 & 3), dq = 16 * (i16 - 4 * g);
    for (int un = vcu; un < BATCH * NH * (SEQ / 256); un += G) {
        const int bh = un & 15, qblk = un >> 4, b = bh >> 3, h = bh & 7, t0 = qblk * 256;
        const bf16* Kg = Kb + (size_t)b * SEQ * 512 + h * 64; const bf16* Vg = Vb + (size_t)b * SEQ * 512 + h * 64;
        QState SA, SB; const int rA = 2 * wave, rB = 2 * wave + 1;
        { const bf16* qa = Q + ((size_t)b * SEQ + t0 + rA + 16 * i16) * 512 + h * 64 + 8 * g; SA.q0 = *(const s16x8*)qa; SA.q1 = *(const s16x8*)(qa + 32);
          const bf16* qb = qa + 512; SB.q0 = *(const s16x8*)qb; SB.q1 = *(const s16x8*)(qb + 32); }
#pragma unroll
        for (int dt = 0; dt < 4; ++dt) { SA.o[dt] = (f32x4){0.f, 0.f, 0.f, 0.f}; SB.o[dt] = (f32x4){0.f, 0.f, 0.f, 0.f}; }
        SA.m = -1.0e30f; SB.m = -1.0e30f; SA.l = 0.f; SB.l = 0.f;
        const int jc0 = qblk >= 8 ? 0 : 8 - qblk;
        v4u st[8];
#define ATT_LOAD(jc) do { const int c0_ = t0 - 2048 + 256 * (jc); _Pragma("unroll") for (int i_ = 0; i_ < 4; ++i_) { const int p_ = tid + 512 * i_; const size_t go_ = (size_t)(c0_ + (p_ >> 3)) * 512 + 8 * (p_ & 7); \
            st[i_] = *(const v4u*)(Kg + go_); st[4 + i_] = *(const v4u*)(Vg + go_); } } while (0)
#define ATT_STORE() do { _Pragma("unroll") for (int i_ = 0; i_ < 4; ++i_) { const int p_ = tid + 512 * i_, pos_ = p_ >> 3; const int off_ = ((pos_ & 15) * 16 + (pos_ >> 4)) * PITCH + 16 * (p_ & 7); \
            *(LAS v4u*)(lds + KOFF + off_) = st[i_]; *(LAS v4u*)(lds + VOFF + off_) = st[4 + i_]; } } while (0)
        ATT_LOAD(jc0); ATT_STORE();
        __syncthreads();
        for (int jc = jc0; jc <= 8; ++jc) {
            if (jc < 8) ATT_LOAD(jc + 1);
            const int D0 = 256 * (8 - jc);
            for (int rho = 0; rho < 16; ++rho) {
                const bool nA = (jc >= 7) || (rho == rA) || (jc == 6 && ((rA - rho) & 3) == 0);
                const bool nB = (jc >= 7) || (rho == rB) || (jc == 6 && ((rB - rho) & 3) == 0);
                if (!(nA || nB)) continue;
                const LAS unsigned char* kp = lds + KOFF + rho * (16 * PITCH) + klane; const LAS unsigned char* vp = lds + VOFF + rho * (16 * PITCH) + vlane;
                const s16x8 k0 = *(const LAS s16x8*)kp, k1 = *(const LAS s16x8*)(kp + 64);
                s16x4 vf[4];
#pragma unroll
                for (int dt = 0; dt < 4; ++dt) vf[dt] = __builtin_amdgcn_ds_read_tr16_b64_v4i16((LAS s16x4*)(vp + 32 * dt));
                if (nA) tile(SA, k0, k1, vf, D0 + rA - rho, dq, ((rA - rho) & 3) == 0 ? 513u : 0u, rho == rA ? 2049u : 0u);
                if (nB) tile(SB, k0, k1, vf, D0 + rB - rho, dq, ((rB - rho) & 3) == 0 ? 513u : 0u, rho == rB ? 2049u : 0u);
            }
            __syncthreads();
            if (jc < 8) { ATT_STORE(); }
            __syncthreads();
        }
#undef ATT_LOAD
#undef ATT_STORE
        typedef unsigned u32x2 __attribute__((ext_vector_type(2)));
        { float l = SA.l; l += __shfl_xor(l, 16); l += __shfl_xor(l, 32); const float inv = 1.f / l; bf16* op = ATT + ((size_t)b * SEQ + t0 + rA + 16 * i16) * 512 + h * 64 + 4 * g;
#pragma unroll
          for (int dt = 0; dt < 4; ++dt) { u32x2 w; w.x = cvtpk(SA.o[dt][0] * inv, SA.o[dt][1] * inv); w.y = cvtpk(SA.o[dt][2] * inv, SA.o[dt][3] * inv); *(u32x2*)(op + 16 * dt) = w; } }
        { float l = SB.l; l += __shfl_xor(l, 16); l += __shfl_xor(l, 32); const float inv = 1.f / l; bf16* op = ATT + ((size_t)b * SEQ + t0 + rB + 16 * i16) * 512 + h * 64 + 4 * g;
#pragma unroll
          for (int dt = 0; dt < 4; ++dt) { u32x2 w; w.x = cvtpk(SB.o[dt][0] * inv, SB.o[dt][1] * inv); w.y = cvtpk(SB.o[dt][2] * inv, SB.o[dt][3] * inv); *(u32x2*)(op + 16 * dt) = w; } }
    }
}
}
namespace peer {
typedef __bf16 bf2 __attribute__((ext_vector_type(2)));
__device__ __forceinline__ float dot2(unsigned a, unsigned b, float acc) { return __builtin_amdgcn_fdot2_f32_bf16(__builtin_bit_cast(bf2, a), __builtin_bit_cast(bf2, b), acc, false); }
__device__ __forceinline__ float dot8(const v4u a, const v4u b, float acc) {
    const unsigned a0 = a.x, a1 = a.y, a2 = a.z, a3 = a.w, b0 = b.x, b1 = b.y, b2 = b.z, b3 = b.w;
    acc = dot2(a0, b0, acc); acc = dot2(a1, b1, acc); acc = dot2(a2, b2, acc); acc = dot2(a3, b3, acc);
    return acc;
}
__device__ __forceinline__ int next_bit(unsigned long long& lo, unsigned long long& hi) {
    if (lo) { const int k = __builtin_ctzll(lo); lo &= lo - 1; return k; }
    const int k = __builtin_ctzll(hi); hi &= hi - 1; return 64 + k;
}
__device__ __forceinline__ void phase_u(const bf16* XN, const bf16* U, const int* EID, float* GATE, int bx, int G) {
    int tid_ = threadIdx.x; asm volatile("" : "+v"(tid_));
    const int tid = tid_, lane = tid & 63, wave = __builtin_amdgcn_readfirstlane(tid >> 6);
    const int xslot = bx & 7, member = bx >> 3, nmem = (G - xslot + 7) >> 3;
    for (int sp = 0; sp < 2; ++sp) {
        const int slice = xslot + 8 * sp;
        for (int t = member * 8 + wave; t < NTOK; t += nmem * 8) {
            const int e0 = EID[(size_t)t * HK + lane], e1 = EID[(size_t)t * HK + 64 + lane];
            const bool in0 = (e0 >> 10) == slice, in1 = (e1 >> 10) == slice;
            unsigned long long m0 = __ballot(in0), m1 = __ballot(in1);
            if ((m0 | m1) == 0ull) continue;
            const v4u xa = ((const v4u*)(XN + (size_t)t * DM))[lane], xb = ((const v4u*)(XN + (size_t)t * DM))[64 + lane];
            float h0 = 0.f, h1 = 0.f;
            while (m0 | m1) {
                int k[4], e[4];
                k[0] = next_bit(m0, m1);
#pragma unroll
                for (int j = 1; j < 4; ++j) k[j] = (m0 | m1) ? next_bit(m0, m1) : -1;
#pragma unroll
                for (int j = 0; j < 4; ++j) { const int kk = k[j] < 0 ? k[0] : k[j]; e[j] = kk < 64 ? __builtin_amdgcn_readlane(e0, kk) : __builtin_amdgcn_readlane(e1, kk - 64); }
                v4u ua[4], ub[4];
#pragma unroll
                for (int j = 0; j < 4; ++j) { const v4u* row = (const v4u*)(U + (size_t)e[j] * DM); ua[j] = row[lane]; ub[j] = row[64 + lane]; }
#pragma unroll
                for (int j = 0; j < 4; ++j) { float d = dot8(xa, ua[j], 0.f); d = dot8(xb, ub[j], d); d = wave_sum(d);
                    if (k[j] >= 0) { if (k[j] < 64) { if (lane == k[j]) h0 = d; } else { if (lane == k[j] - 64) h1 = d; } } }
            }
            if (in0) GATE[(size_t)t * HK + lane] = gelu_erf(h0) * GATE[(size_t)t * HK + lane];
            if (in1) GATE[(size_t)t * HK + 64 + lane] = gelu_erf(h1) * GATE[(size_t)t * HK + 64 + lane];
        }
    }
}
__device__ __forceinline__ void phase_v(const bf16* V, const int* EID, const float* ACT, float* H, int bx, int G) {
    int tid_ = threadIdx.x; asm volatile("" : "+v"(tid_));
    const int tid = tid_, lane = tid & 63, wave = __builtin_amdgcn_readfirstlane(tid >> 6), g8 = lane >> 3, c8 = lane & 7;
    const int xslot = bx & 7, member = bx >> 3, nmem = (G - xslot + 7) >> 3;
    for (int sp = 0; sp < 2; ++sp) {
        const int slice = xslot + 8 * sp; const bf16* Vs = V + slice * 64 + c8 * 8;
        for (int t = member * 8 + wave; t < NTOK; t += nmem * 8) {
            const int e0 = EID[(size_t)t * HK + lane], e1 = EID[(size_t)t * HK + 64 + lane];
            const float a0 = ACT[(size_t)t * HK + lane], a1 = ACT[(size_t)t * HK + 64 + lane];
            v4u r[16]; float av[16];
#pragma unroll
            for (int i = 0; i < 16; ++i) { const int src = ((8 * i) & 63) + g8; const int e = __shfl(i < 8 ? e0 : e1, src); av[i] = __shfl(i < 8 ? a0 : a1, src);
                r[i] = *(const v4u*)(Vs + (size_t)e * DM); }
            float acc[8];
#pragma unroll
            for (int q = 0; q < 8; ++q) acc[q] = 0.f;
#pragma unroll
            for (int i = 0; i < 16; ++i) { const float a = av[i];
                acc[0] += a * bflo(r[i].x); acc[1] += a * bfhi(r[i].x); acc[2] += a * bflo(r[i].y); acc[3] += a * bfhi(r[i].y);
                acc[4] += a * bflo(r[i].z); acc[5] += a * bfhi(r[i].z); acc[6] += a * bflo(r[i].w); acc[7] += a * bfhi(r[i].w); }
#pragma unroll
            for (int q = 0; q < 8; ++q) { float v = acc[q]; v += __shfl_xor(v, 8); v += __shfl_xor(v, 16); v += __shfl_xor(v, 32); acc[q] = v; }
            if (g8 == 0) { float* hp = H + (size_t)t * DM + slice * 64 + c8 * 8; f32x4 v0 = *(f32x4*)hp, v1 = *(f32x4*)(hp + 4);
                v0.x += acc[0]; v0.y += acc[1]; v0.z += acc[2]; v0.w += acc[3]; v1.x += acc[4]; v1.y += acc[5]; v1.z += acc[6]; v1.w += acc[7];
                *(f32x4*)hp = v0; *(f32x4*)(hp + 4) = v1; }
        }
    }
}

__device__ __forceinline__ void naive_u_token(int tok, int lane, const bf16* XN, const bf16* U, const int* EID, float* GATE) {
    const v4u xa = ((const v4u*)(XN + (size_t)tok * DM))[lane], xb = ((const v4u*)(XN + (size_t)tok * DM))[64 + lane];
    for (int k = 0; k < HK; ++k) { const int e = EID[(size_t)tok * HK + k]; const v4u* row = (const v4u*)(U + (size_t)e * DM);
        float d = dot8(xa, row[lane], 0.f); d = dot8(xb, row[64 + lane], d); d = wave_sum(d);
        if (lane == 0) GATE[(size_t)tok * HK + k] = gelu_erf(d) * GATE[(size_t)tok * HK + k]; }
}
__device__ __forceinline__ void naive_v_token(int tok, int lane, const bf16* V, const int* EID, const float* ACT, float* H) {
    float y[16];
#pragma unroll
    for (int i = 0; i < 16; ++i) y[i] = 0.f;
    for (int k = 0; k < HK; ++k) { const int e = EID[(size_t)tok * HK + k]; const float act = ACT[(size_t)tok * HK + k];
        const v4u c = ((const v4u*)(V + (size_t)e * 1024))[lane * 2], dd = ((const v4u*)(V + (size_t)e * 1024))[lane * 2 + 1];
        y[0] += act * bflo(c.x); y[1] += act * bfhi(c.x); y[2] += act * bflo(c.y); y[3] += act * bfhi(c.y); y[4] += act * bflo(c.z); y[5] += act * bfhi(c.z); y[6] += act * bflo(c.w); y[7] += act * bfhi(c.w);
        y[8] += act * bflo(dd.x); y[9] += act * bfhi(dd.x); y[10] += act * bflo(dd.y); y[11] += act * bfhi(dd.y); y[12] += act * bflo(dd.z); y[13] += act * bfhi(dd.z); y[14] += act * bflo(dd.w); y[15] += act * bfhi(dd.w); }
    float* hr = H + (size_t)tok * 1024 + lane * 16;
#pragma unroll
    for (int i = 0; i < 4; ++i) { f32x4 v = ((f32x4*)hr)[i]; v.x += y[4 * i]; v.y += y[4 * i + 1]; v.z += y[4 * i + 2]; v.w += y[4 * i + 3]; ((f32x4*)hr)[i] = v; }
}
}
namespace peer2 {
typedef __bf16 bf2 __attribute__((ext_vector_type(2)));
__device__ __forceinline__ float dot2(unsigned a, unsigned b, float acc) { return __builtin_amdgcn_fdot2_f32_bf16(__builtin_bit_cast(bf2, a), __builtin_bit_cast(bf2, b), acc, false); }
__device__ __forceinline__ float dot8(const v4u a, const v4u b) {
    const unsigned a0 = a.x, a1 = a.y, a2 = a.z, a3 = a.w, b0 = b.x, b1 = b.y, b2 = b.z, b3 = b.w;
    float acc = dot2(a0, b0, 0.f); acc = dot2(a1, b1, acc); acc = dot2(a2, b2, acc); acc = dot2(a3, b3, acc); return acc;
}
template <int S> __device__ __forceinline__ float rs8(const float (&v)[8], int lane) {
    const bool b2 = lane & (4 * S), b1 = lane & (2 * S), b0 = lane & S;
    float w[4];
#pragma unroll
    for (int j = 0; j < 4; ++j) { const float keep = b2 ? v[j + 4] : v[j], send = b2 ? v[j] : v[j + 4]; w[j] = keep + __shfl_xor(send, 4 * S); }
    float u[2];
#pragma unroll
    for (int j = 0; j < 2; ++j) { const float keep = b1 ? w[j + 2] : w[j], send = b1 ? w[j] : w[j + 2]; u[j] = keep + __shfl_xor(send, 2 * S); }
    const float keep = b0 ? u[1] : u[0], send = b0 ? u[0] : u[1];
    return keep + __shfl_xor(send, S);
}
struct Rows { v4u r[16]; };
__device__ __forceinline__ void load_rows(Rows& R, const unsigned char* tab, const unsigned (&off)[16], int colbyte) {
#pragma unroll
    for (int it = 0; it < 16; ++it) R.r[it] = *(const v4u*)(tab + (size_t)off[it] + colbyte);
}
__device__ __forceinline__ void read16(unsigned (&o)[16], const LAS unsigned* p) {
#pragma unroll
    for (int q = 0; q < 4; ++q) { const v4u t = ((const LAS v4u*)p)[q]; o[4 * q] = t.x; o[4 * q + 1] = t.y; o[4 * q + 2] = t.z; o[4 * q + 3] = t.w; }
}
__device__ __forceinline__ void phase(LAS unsigned char* lds, const bf16* XN, const bf16* U, const bf16* V, const int* EID, const float* GATE, float* H, int gw, int NGW) {
    int tid_ = threadIdx.x; asm volatile("" : "+v"(tid_));
    const int tid = tid_, lane = tid & 63, wave = __builtin_amdgcn_readfirstlane(tid >> 6), g8 = lane >> 3, c8 = lane & 7;
    LAS unsigned* idt = (LAS unsigned*)(lds + wave * 8192);
    LAS float* actt = (LAS float*)(lds + wave * 8192 + 4096);
    const unsigned char* Ub = (const unsigned char*)U; const unsigned char* Vb = (const unsigned char*)V;
    for (int grp = gw; grp < NTOK / 8; grp += NGW) {
        const int t0 = grp * 8;
#pragma unroll
        for (int i = 0; i < 8; ++i) { const int ea = EID[(size_t)(t0 + i) * HK + lane], eb = EID[(size_t)(t0 + i) * HK + 64 + lane];
            idt[i * 128 + (lane & 7) * 16 + (lane >> 3)] = (unsigned)ea << 11; idt[i * 128 + (lane & 7) * 16 + 8 + (lane >> 3)] = (unsigned)eb << 11;
            actt[i * 128 + lane] = 0.f; actt[i * 128 + 64 + lane] = 0.f; }
        asm volatile("s_waitcnt lgkmcnt(0)" ::: "memory");
        v4u ra[16], rb[16];
#define PU_LOAD(R, X, n_) do { const int i_ = (n_) & 7, s_ = (n_) >> 3; const unsigned cb_ = 128 * s_ + 16 * c8; \
            _Pragma("unroll") for (int q = 0; q < 4; ++q) { const v4u o_ = ((const LAS v4u*)(idt + i_ * 128 + g8 * 16))[q]; \
                R[4 * q] = *(const v4u*)(Ub + (size_t)(unsigned)(o_.x + cb_)); R[4 * q + 1] = *(const v4u*)(Ub + (size_t)(unsigned)(o_.y + cb_)); R[4 * q + 2] = *(const v4u*)(Ub + (size_t)(unsigned)(o_.z + cb_)); R[4 * q + 3] = *(const v4u*)(Ub + (size_t)(unsigned)(o_.w + cb_)); asm volatile("" ::: "memory"); } \
            X = *(const v4u*)(XN + (size_t)(t0 + i_) * DM + 64 * s_ + 8 * c8); } while (0)
#define PU_COMP(R, X, n_) do { const int i_ = (n_) & 7; float dA[8], dB[8]; \
            _Pragma("unroll") for (int it = 0; it < 8; ++it) { dA[it] = dot8(X, R[it]); dB[it] = dot8(X, R[8 + it]); } \
            const float sa_ = rs8<1>(dA, lane), sb_ = rs8<1>(dB, lane); LAS float* hp_ = actt + i_ * 128 + g8 * 16 + c8; hp_[0] += sa_; hp_[8] += sb_; } while (0)
        { v4u xa, xb;
          PU_LOAD(ra, xa, 0);
          for (int n = 0; n < 128; n += 2) {
              PU_LOAD(rb, xb, n + 1); asm volatile("" ::: "memory");
              PU_COMP(ra, xa, n); asm volatile("" ::: "memory");
              if (n + 2 < 128) PU_LOAD(ra, xa, n + 2);
              asm volatile("" ::: "memory");
              PU_COMP(rb, xb, n + 1); asm volatile("" ::: "memory");
          } }
#undef PU_LOAD
#undef PU_COMP
        asm volatile("s_waitcnt lgkmcnt(0)" ::: "memory");
#pragma unroll
        for (int i = 0; i < 8; ++i) { const float ga = GATE[(size_t)(t0 + i) * HK + 8 * c8 + g8], gb = GATE[(size_t)(t0 + i) * HK + 64 + 8 * c8 + g8];
            LAS float* hp = actt + i * 128 + g8 * 16 + c8; hp[0] = gelu_erf(hp[0]) * ga; hp[8] = gelu_erf(hp[8]) * gb; }
        asm volatile("s_waitcnt lgkmcnt(0)" ::: "memory");
#define PV_LOAD(R, HV, n_) do { const int i_ = (n_) & 7, s_ = (n_) >> 3; const unsigned cb_ = 128 * s_ + 16 * c8; \
            _Pragma("unroll") for (int q = 0; q < 4; ++q) { const v4u o_ = ((const LAS v4u*)(idt + i_ * 128 + g8 * 16))[q]; \
                R[4 * q] = *(const v4u*)(Vb + (size_t)(unsigned)(o_.x + cb_)); R[4 * q + 1] = *(const v4u*)(Vb + (size_t)(unsigned)(o_.y + cb_)); R[4 * q + 2] = *(const v4u*)(Vb + (size_t)(unsigned)(o_.z + cb_)); R[4 * q + 3] = *(const v4u*)(Vb + (size_t)(unsigned)(o_.w + cb_)); asm volatile("" ::: "memory"); } \
            HV = H[(size_t)(t0 + i_) * DM + 64 * s_ + 8 * c8 + g8]; } while (0)
#define PV_FMA(a_, r_) do { acc[0] += a_ * bflo(r_.x); acc[1] += a_ * bfhi(r_.x); acc[2] += a_ * bflo(r_.y); acc[3] += a_ * bfhi(r_.y); \
                acc[4] += a_ * bflo(r_.z); acc[5] += a_ * bfhi(r_.z); acc[6] += a_ * bflo(r_.w); acc[7] += a_ * bfhi(r_.w); } while (0)
#define PV_COMP(R, HV, n_) do { const int i_ = (n_) & 7, s_ = (n_) >> 3; float acc[8]; \
            _Pragma("unroll") for (int q = 0; q < 8; ++q) acc[q] = 0.f; \
            _Pragma("unroll") for (int q = 0; q < 4; ++q) { const f32x4 a4_ = ((const LAS f32x4*)(actt + i_ * 128 + g8 * 16))[q]; \
                { const float a_ = a4_.x; const v4u r_ = R[4 * q]; PV_FMA(a_, r_); } { const float a_ = a4_.y; const v4u r_ = R[4 * q + 1]; PV_FMA(a_, r_); } \
                { const float a_ = a4_.z; const v4u r_ = R[4 * q + 2]; PV_FMA(a_, r_); } { const float a_ = a4_.w; const v4u r_ = R[4 * q + 3]; PV_FMA(a_, r_); } } \
            H[(size_t)(t0 + i_) * DM + 64 * s_ + 8 * c8 + g8] = HV + rs8<8>(acc, lane); } while (0)
        { float ha, hb;
          PV_LOAD(ra, ha, 0);
          for (int n = 0; n < 128; n += 2) {
              PV_LOAD(rb, hb, n + 1); asm volatile("" ::: "memory");
              PV_COMP(ra, ha, n); asm volatile("" ::: "memory");
              if (n + 2 < 128) PV_LOAD(ra, ha, n + 2);
              asm volatile("" ::: "memory");
              PV_COMP(rb, hb, n + 1); asm volatile("" ::: "memory");
          } }
#undef PV_LOAD
#undef PV_COMP
#undef PV_FMA
    }
}
}
namespace peer3 {
typedef float f32x2 __attribute__((ext_vector_type(2)));
constexpr float USCALE = 256.f, VSCALE = 16.f;
__device__ __forceinline__ float dot16(const float (&x)[16], const v4u r) {
    const unsigned w0 = r.x, w1 = r.y, w2 = r.z, w3 = r.w; float a = 0.f, b = 0.f;
    { const f32x2 l = __builtin_amdgcn_cvt_pk_f32_fp8((int)w0, false), h = __builtin_amdgcn_cvt_pk_f32_fp8((int)w0, true); a += l.x * x[0]; b += l.y * x[1]; a += h.x * x[2]; b += h.y * x[3]; }
    { const f32x2 l = __builtin_amdgcn_cvt_pk_f32_fp8((int)w1, false), h = __builtin_amdgcn_cvt_pk_f32_fp8((int)w1, true); a += l.x * x[4]; b += l.y * x[5]; a += h.x * x[6]; b += h.y * x[7]; }
    { const f32x2 l = __builtin_amdgcn_cvt_pk_f32_fp8((int)w2, false), h = __builtin_amdgcn_cvt_pk_f32_fp8((int)w2, true); a += l.x * x[8]; b += l.y * x[9]; a += h.x * x[10]; b += h.y * x[11]; }
    { const f32x2 l = __builtin_amdgcn_cvt_pk_f32_fp8((int)w3, false), h = __builtin_amdgcn_cvt_pk_f32_fp8((int)w3, true); a += l.x * x[12]; b += l.y * x[13]; a += h.x * x[14]; b += h.y * x[15]; }
    return a + b;
}
__device__ __forceinline__ void fma16(float (&acc)[16], const float a, const v4u r) {
    const unsigned w0 = r.x, w1 = r.y, w2 = r.z, w3 = r.w;
    { const f32x2 l = __builtin_amdgcn_cvt_pk_f32_fp8((int)w0, false), h = __builtin_amdgcn_cvt_pk_f32_fp8((int)w0, true); acc[0] += a * l.x; acc[1] += a * l.y; acc[2] += a * h.x; acc[3] += a * h.y; }
    { const f32x2 l = __builtin_amdgcn_cvt_pk_f32_fp8((int)w1, false), h = __builtin_amdgcn_cvt_pk_f32_fp8((int)w1, true); acc[4] += a * l.x; acc[5] += a * l.y; acc[6] += a * h.x; acc[7] += a * h.y; }
    { const f32x2 l = __builtin_amdgcn_cvt_pk_f32_fp8((int)w2, false), h = __builtin_amdgcn_cvt_pk_f32_fp8((int)w2, true); acc[8] += a * l.x; acc[9] += a * l.y; acc[10] += a * h.x; acc[11] += a * h.y; }
    { const f32x2 l = __builtin_amdgcn_cvt_pk_f32_fp8((int)w3, false), h = __builtin_amdgcn_cvt_pk_f32_fp8((int)w3, true); acc[12] += a * l.x; acc[13] += a * l.y; acc[14] += a * h.x; acc[15] += a * h.y; }
}
template <int S> __device__ __forceinline__ float rs8(const float (&v)[8], int lane) {
    const bool b2 = lane & (4 * S), b1 = lane & (2 * S), b0 = lane & S;
    float w[4];
#pragma unroll
    for (int j = 0; j < 4; ++j) { const float keep = b2 ? v[j + 4] : v[j], send = b2 ? v[j] : v[j + 4]; w[j] = keep + __shfl_xor(send, 4 * S); }
    float u[2];
#pragma unroll
    for (int j = 0; j < 2; ++j) { const float keep = b1 ? w[j + 2] : w[j], send = b1 ? w[j] : w[j + 2]; u[j] = keep + __shfl_xor(send, 2 * S); }
    const float keep = b0 ? u[1] : u[0], send = b0 ? u[0] : u[1];
    return keep + __shfl_xor(send, S);
}
__device__ __forceinline__ void phase(LAS unsigned char* lds, const bf16* XN, const unsigned char* U8, const unsigned char* V8, const int* EID, const float* GATE, float* H, int gw, int NGW) {
    int tid_ = threadIdx.x; asm volatile("" : "+v"(tid_));
    const int tid = tid_, lane = tid & 63, wave = __builtin_amdgcn_readfirstlane(tid >> 6), g8 = lane >> 3, c8 = lane & 7;
    LAS unsigned* idt = (LAS unsigned*)(lds + wave * 8192);
    LAS float* actt = (LAS float*)(lds + wave * 8192 + 4096);
    const unsigned char* Ub = U8; const unsigned char* Vb = V8;
    for (int grp = gw; grp < NTOK / 8; grp += NGW) {
        const int t0 = grp * 8;
#pragma unroll
        for (int i = 0; i < 8; ++i) { const int ea = EID[(size_t)(t0 + i) * HK + lane], eb = EID[(size_t)(t0 + i) * HK + 64 + lane];
            idt[i * 128 + (lane & 7) * 16 + (lane >> 3)] = (unsigned)ea << 10; idt[i * 128 + (lane & 7) * 16 + 8 + (lane >> 3)] = (unsigned)eb << 10;
            actt[i * 128 + lane] = 0.f; actt[i * 128 + 64 + lane] = 0.f; }
        asm volatile("s_waitcnt lgkmcnt(0)" ::: "memory");
        v4u ra[16], rb[16];
#define PU_LOAD(R, X0, X1, n_) do { const int i_ = (n_) & 7, s_ = (n_) >> 3; const unsigned cb_ = 128 * s_ + 16 * c8; \
            _Pragma("unroll") for (int q = 0; q < 4; ++q) { const v4u o_ = ((const LAS v4u*)(idt + i_ * 128 + g8 * 16))[q]; \
                R[4 * q] = *(const v4u*)(Ub + (size_t)(unsigned)(o_.x + cb_)); R[4 * q + 1] = *(const v4u*)(Ub + (size_t)(unsigned)(o_.y + cb_)); R[4 * q + 2] = *(const v4u*)(Ub + (size_t)(unsigned)(o_.z + cb_)); R[4 * q + 3] = *(const v4u*)(Ub + (size_t)(unsigned)(o_.w + cb_)); } \
            const v4u* xp_ = (const v4u*)(XN + (size_t)(t0 + i_) * DM + 128 * s_ + 16 * c8); X0 = xp_[0]; X1 = xp_[1]; } while (0)
#define PU_COMP(R, X0, X1, n_) do { const int i_ = (n_) & 7; float dA[8], dB[8]; \
            const float xf[16] = {bflo(X0.x), bfhi(X0.x), bflo(X0.y), bfhi(X0.y), bflo(X0.z), bfhi(X0.z), bflo(X0.w), bfhi(X0.w), bflo(X1.x), bfhi(X1.x), bflo(X1.y), bfhi(X1.y), bflo(X1.z), bfhi(X1.z), bflo(X1.w), bfhi(X1.w)}; \
            _Pragma("unroll") for (int it = 0; it < 8; ++it) { dA[it] = dot16(xf, R[it]); dB[it] = dot16(xf, R[8 + it]); } \
            const float sa_ = rs8<1>(dA, lane), sb_ = rs8<1>(dB, lane); LAS float* hp_ = actt + i_ * 128 + g8 * 16 + c8; hp_[0] += sa_; hp_[8] += sb_; } while (0)
        { v4u xa0, xa1, xb0, xb1;
          PU_LOAD(ra, xa0, xa1, 0);
          for (int n = 0; n < 64; n += 2) {
              PU_LOAD(rb, xb0, xb1, n + 1); asm volatile("" ::: "memory");
              PU_COMP(ra, xa0, xa1, n); asm volatile("" ::: "memory");
              if (n + 2 < 64) PU_LOAD(ra, xa0, xa1, n + 2);
              asm volatile("" ::: "memory");
              PU_COMP(rb, xb0, xb1, n + 1); asm volatile("" ::: "memory");
          } }
#undef PU_LOAD
#undef PU_COMP
        asm volatile("s_waitcnt lgkmcnt(0)" ::: "memory");
#pragma unroll
        for (int i = 0; i < 8; ++i) { const float ga = GATE[(size_t)(t0 + i) * HK + 8 * c8 + g8], gb = GATE[(size_t)(t0 + i) * HK + 64 + 8 * c8 + g8];
            LAS float* hp = actt + i * 128 + g8 * 16 + c8; hp[0] = gelu_erf(hp[0] * (1.f / USCALE)) * ga * (1.f / VSCALE); hp[8] = gelu_erf(hp[8] * (1.f / USCALE)) * gb * (1.f / VSCALE); }
        asm volatile("s_waitcnt lgkmcnt(0)" ::: "memory");
#define PV_LOAD(R, HV0, HV1, n_) do { const int i_ = (n_) & 7, s_ = (n_) >> 3; const unsigned cb_ = 128 * s_ + 16 * c8; \
            _Pragma("unroll") for (int q = 0; q < 4; ++q) { const v4u o_ = ((const LAS v4u*)(idt + i_ * 128 + g8 * 16))[q]; \
                R[4 * q] = *(const v4u*)(Vb + (size_t)(unsigned)(o_.x + cb_)); R[4 * q + 1] = *(const v4u*)(Vb + (size_t)(unsigned)(o_.y + cb_)); R[4 * q + 2] = *(const v4u*)(Vb + (size_t)(unsigned)(o_.z + cb_)); R[4 * q + 3] = *(const v4u*)(Vb + (size_t)(unsigned)(o_.w + cb_)); } \
            const float* hp_ = H + (size_t)(t0 + i_) * DM + 128 * s_ + 16 * c8 + g8; HV0 = hp_[0]; HV1 = hp_[8]; } while (0)
#define PV_COMP(R, HV0, HV1, n_) do { const int i_ = (n_) & 7, s_ = (n_) >> 3; float acc[16]; \
            _Pragma("unroll") for (int q = 0; q < 16; ++q) acc[q] = 0.f; \
            _Pragma("unroll") for (int q = 0; q < 4; ++q) { const f32x4 a4_ = ((const LAS f32x4*)(actt + i_ * 128 + g8 * 16))[q]; \
                fma16(acc, a4_.x, R[4 * q]); fma16(acc, a4_.y, R[4 * q + 1]); fma16(acc, a4_.z, R[4 * q + 2]); fma16(acc, a4_.w, R[4 * q + 3]); } \
            float lo_[8], hi_[8]; _Pragma("unroll") for (int q = 0; q < 8; ++q) { lo_[q] = acc[q]; hi_[q] = acc[8 + q]; } \
            float* hp_ = H + (size_t)(t0 + i_) * DM + 128 * s_ + 16 * c8 + g8; hp_[0] = HV0 + rs8<8>(lo_, lane); hp_[8] = HV1 + rs8<8>(hi_, lane); } while (0)
        { float ha0, ha1, hb0, hb1;
          PV_LOAD(ra, ha0, ha1, 0);
          for (int n = 0; n < 64; n += 2) {
              PV_LOAD(rb, hb0, hb1, n + 1); asm volatile("" ::: "memory");
              PV_COMP(ra, ha0, ha1, n); asm volatile("" ::: "memory");
              if (n + 2 < 64) PV_LOAD(ra, ha0, ha1, n + 2);
              asm volatile("" ::: "memory");
              PV_COMP(rb, hb0, hb1, n + 1); asm volatile("" ::: "memory");
          } }
#undef PV_LOAD
#undef PV_COMP
    }
}
}
namespace tk {
constexpr int TPITCH = 144;
__device__ __forceinline__ unsigned bkey(unsigned b) { return (b & 0x8000u) ? (~b & 0xffffu) : (b | 0x8000u); }
__device__ __forceinline__ float bkey2f(unsigned k) { const unsigned b = (k & 0x8000u) ? (k & 0x7fffu) : (~k & 0xffffu); return __uint_as_float(b << 16); }
__device__ __forceinline__ void ins8(unsigned (&L)[16], const v4u w, int c0) {
    const unsigned x0 = w.x, x1 = w.y, x2 = w.z, x3 = w.w;
    ins16(L, (bkey(x0 & 0xffffu) << 16) | (unsigned)(127 - c0));     ins16(L, (bkey(x0 >> 16) << 16) | (unsigned)(126 - c0));
    ins16(L, (bkey(x1 & 0xffffu) << 16) | (unsigned)(125 - c0));     ins16(L, (bkey(x1 >> 16) << 16) | (unsigned)(124 - c0));
    ins16(L, (bkey(x2 & 0xffffu) << 16) | (unsigned)(123 - c0));     ins16(L, (bkey(x2 >> 16) << 16) | (unsigned)(122 - c0));
    ins16(L, (bkey(x3 & 0xffffu) << 16) | (unsigned)(121 - c0));     ins16(L, (bkey(x3 >> 16) << 16) | (unsigned)(120 - c0));
}
__device__ __forceinline__ void phase(LAS unsigned char* lds, const bf16* SC, int* EID, float* GATE, int vcu, int G) {
    int tid_ = threadIdx.x; asm volatile("" : "+v"(tid_));
    const int tid = tid_;
    for (int batch = vcu; batch < NTOK * PH / 512; batch += G) {
        const bf16* src = SC + (size_t)batch * 512 * 256;
        v4u st[8];
#define TK_LOAD(ch) do { _Pragma("unroll") for (int i_ = 0; i_ < 8; ++i_) { const int p_ = tid + 512 * i_; st[i_] = *(const v4u*)(src + (size_t)(p_ >> 3) * 256 + (ch) * 64 + 8 * (p_ & 7)); } } while (0)
#define TK_STORE() do { _Pragma("unroll") for (int i_ = 0; i_ < 8; ++i_) { const int p_ = tid + 512 * i_; *(LAS v4u*)(lds + (p_ >> 3) * TPITCH + 16 * (p_ & 7)) = st[i_]; } } while (0)
        unsigned La[16], Lb[16];
#pragma unroll
        for (int q = 0; q < 16; ++q) { La[q] = 0u; Lb[q] = 0u; }
        TK_LOAD(0); TK_STORE(); __syncthreads();
#pragma unroll
        for (int ch = 0; ch < 4; ++ch) {
            if (ch < 3) TK_LOAD(ch + 1);
            const LAS v4u* row = (const LAS v4u*)(lds + tid * TPITCH);
#pragma unroll
            for (int pc = 0; pc < 8; ++pc) { const v4u w = row[pc]; if (ch < 2) ins8(La, w, ch * 64 + pc * 8); else ins8(Lb, w, (ch - 2) * 64 + pc * 8); }
            __syncthreads();
            if (ch < 3) { TK_STORE(); }
            __syncthreads();
        }
#undef TK_LOAD
#undef TK_STORE
#pragma unroll
        for (int q = 0; q < 16; ++q) { La[q] = (f2key(bkey2f(La[q] >> 16)) & ~127u) | (La[q] & 127u); Lb[q] = (f2key(bkey2f(Lb[q] >> 16)) & ~127u) | (Lb[q] & 127u); }
        int e[16]; float g[16]; topk_combine(La, Lb, e, g);
        const size_t o = ((size_t)batch * 512 + tid) * 16;
#pragma unroll
        for (int r = 0; r < 4; ++r) { *(int4*)(EID + o + 4 * r) = make_int4(e[4 * r], e[4 * r + 1], e[4 * r + 2], e[4 * r + 3]); *(f32x4*)(GATE + o + 4 * r) = (f32x4){g[4 * r], g[4 * r + 1], g[4 * r + 2], g[4 * r + 3]}; }
    }
}
__device__ __forceinline__ void fold_phase(LAS unsigned char* lds, const float* wq, const float* keys, bf16* WQK, int vcu, int G) {
    int tid_ = threadIdx.x; asm volatile("" : "+v"(tid_));
    const int tid = tid_, dl = tid & 63, kg = __builtin_amdgcn_readfirstlane(tid >> 6);
    LAS float* ks = (LAS float*)lds;
    LAS float* wsm = (LAS float*)(lds + 128 * 132 * 4);
    for (int it = vcu; it < 16 * 16; it += G) {
        const int hp = it >> 4, d0 = (it & 15) * 64, p = hp & 1;
        for (int i = tid; i < 128 * 32; i += 512) { const int r = i >> 5, c4 = i & 31; *(LAS f32x4*)(ks + r * 132 + 4 * c4) = *(const f32x4*)(keys + ((size_t)p * 128 + r) * 128 + 4 * c4); }
        for (int i = tid; i < 64 * 32; i += 512) { const int r = i >> 5, c4 = i & 31; *(LAS f32x4*)(wsm + r * 132 + 4 * c4) = *(const f32x4*)(wq + (size_t)(d0 + r) * 2048 + hp * 128 + 4 * c4); }
        __syncthreads();
        float acc[16];
#pragma unroll
        for (int j = 0; j < 16; ++j) acc[j] = 0.f;
        for (int c = 0; c < 128; c += 4) { const f32x4 w = *(const LAS f32x4*)(wsm + dl * 132 + c);
#pragma unroll
            for (int j = 0; j < 16; ++j) { const f32x4 kv = *(const LAS f32x4*)(ks + (kg * 16 + j) * 132 + c); acc[j] += w.x * kv.x + w.y * kv.y + w.z * kv.z + w.w * kv.w; } }
#pragma unroll
        for (int j = 0; j < 16; ++j) WQK[(size_t)(hp * 128 + kg * 16 + j) * 1024 + d0 + dl] = (bf16)f2bf(acc[j]);
        __syncthreads();
    }
}
}
namespace mix {
__device__ __forceinline__ void phase(LAS unsigned char* lds, const bf16* GLU, const bf16* ATT, const float* cw, const float* cb, const float* lg, const float* lb, const float* ga, const float* gc, bf16* Y, int gw, int NGW) {
    int tid_ = threadIdx.x; asm volatile("" : "+v"(tid_));
    const int tid = tid_, lane = tid & 63, c0 = lane * 8;
    LAS float* wl = (LAS float*)lds;
    for (int i = tid; i < CW * 512 / 4; i += 512) ((LAS f32x4*)wl)[i] = ((const f32x4*)cw)[i];
    __syncthreads();
    const f32x4 b0 = *(const f32x4*)(cb + c0), b1 = *(const f32x4*)(cb + c0 + 4);
    for (int item = gw; item < NTOK / 8; item += NGW) {
        const int t0 = item * 8, s0 = t0 % SEQ;
        float acc[8][8];
#pragma unroll
        for (int o = 0; o < 8; ++o) { acc[o][0] = b0.x; acc[o][1] = b0.y; acc[o][2] = b0.z; acc[o][3] = b0.w; acc[o][4] = b1.x; acc[o][5] = b1.y; acc[o][6] = b1.z; acc[o][7] = b1.w; }
        v4u gcur[8], gnxt[8];
#define MIX_LOAD(B, rb) do { _Pragma("unroll") for (int rr = 0; rr < 8; ++rr) { const int r_ = (rb) + rr; B[rr] = (v4u){0u, 0u, 0u, 0u}; \
            if (r_ < CW + 7 && s0 - (CW - 1) + r_ >= 0) B[rr] = *(const v4u*)(GLU + (size_t)(t0 - (CW - 1) + r_) * 512 + c0); } } while (0)
        MIX_LOAD(gcur, 0);
        for (int rb = 0; rb < 40; rb += 8) {
            if (rb + 8 < 40) MIX_LOAD(gnxt, rb + 8);
#pragma unroll
            for (int rr = 0; rr < 8; ++rr) { const v4u g = gcur[rr]; const int r = rb + rr;
                const float x0 = bflo(g.x), x1 = bfhi(g.x), x2 = bflo(g.y), x3 = bfhi(g.y), x4 = bflo(g.z), x5 = bfhi(g.z), x6 = bflo(g.w), x7 = bfhi(g.w);
#pragma unroll
                for (int o = 0; o < 8; ++o) { const int j = r - o; if (j < 0 || j >= CW) continue;
                    const f32x4 w0 = *(const LAS f32x4*)(wl + j * 512 + c0), w1 = *(const LAS f32x4*)(wl + j * 512 + c0 + 4);
                    acc[o][0] += w0.x * x0; acc[o][1] += w0.y * x1; acc[o][2] += w0.z * x2; acc[o][3] += w0.w * x3; acc[o][4] += w1.x * x4; acc[o][5] += w1.y * x5; acc[o][6] += w1.z * x6; acc[o][7] += w1.w * x7; }
                asm volatile("" ::: "memory");
            }
#pragma unroll
            for (int rr = 0; rr < 8; ++rr) gcur[rr] = gnxt[rr];
        }
#undef MIX_LOAD
        const f32x4 lg0 = *(const f32x4*)(lg + c0), lg1 = *(const f32x4*)(lg + c0 + 4), lb0 = *(const f32x4*)(lb + c0), lb1 = *(const f32x4*)(lb + c0 + 4);
        const f32x4 gc0 = *(const f32x4*)(gc + c0), gc1 = *(const f32x4*)(gc + c0 + 4), ga0 = *(const f32x4*)(ga + c0), ga1 = *(const f32x4*)(ga + c0 + 4);
        const float lgv[8] = {lg0.x, lg0.y, lg0.z, lg0.w, lg1.x, lg1.y, lg1.z, lg1.w}, lbv[8] = {lb0.x, lb0.y, lb0.z, lb0.w, lb1.x, lb1.y, lb1.z, lb1.w};
        const float gcv[8] = {gc0.x, gc0.y, gc0.z, gc0.w, gc1.x, gc1.y, gc1.z, gc1.w}, gav[8] = {ga0.x, ga0.y, ga0.z, ga0.w, ga1.x, ga1.y, ga1.z, ga1.w};
#pragma unroll
        for (int o = 0; o < 8; ++o) {
            const int tok = t0 + o; float sm = 0.f;
#pragma unroll
            for (int i = 0; i < 8; ++i) sm += acc[o][i];
            const float mean = wave_sum(sm) * (1.f / 512.f); float sq = 0.f;
#pragma unroll
            for (int i = 0; i < 8; ++i) { acc[o][i] -= mean; sq += acc[o][i] * acc[o][i]; }
            const float rstd = rsqrtf(wave_sum(sq) * (1.f / 512.f) + EPS); float ss = 0.f;
#pragma unroll
            for (int i = 0; i < 8; ++i) { const float y = acc[o][i] * rstd * lgv[i] + lbv[i]; acc[o][i] = y * sigmoidf_(y); ss += acc[o][i] * acc[o][i]; }
            const float rc = rsqrtf(wave_sum(ss) * (1.f / 512.f) + EPS);
            v4u ov; ov.x = pk2(acc[o][0] * rc * gcv[0], acc[o][1] * rc * gcv[1]); ov.y = pk2(acc[o][2] * rc * gcv[2], acc[o][3] * rc * gcv[3]); ov.z = pk2(acc[o][4] * rc * gcv[4], acc[o][5] * rc * gcv[5]); ov.w = pk2(acc[o][6] * rc * gcv[6], acc[o][7] * rc * gcv[7]);
            *(v4u*)(Y + (size_t)tok * 1024 + 512 + c0) = ov;
            const v4u a = *(const v4u*)(ATT + (size_t)tok * 512 + c0); const float av[8] = {bflo(a.x), bfhi(a.x), bflo(a.y), bfhi(a.y), bflo(a.z), bfhi(a.z), bflo(a.w), bfhi(a.w)}; float sa = 0.f;
#pragma unroll
            for (int i = 0; i < 8; ++i) sa += av[i] * av[i];
            const float ra = rsqrtf(wave_sum(sa) * (1.f / 512.f) + EPS);
            v4u oa; oa.x = pk2(av[0] * ra * gav[0], av[1] * ra * gav[1]); oa.y = pk2(av[2] * ra * gav[2], av[3] * ra * gav[3]); oa.z = pk2(av[4] * ra * gav[4], av[5] * ra * gav[5]); oa.w = pk2(av[6] * ra * gav[6], av[7] * ra * gav[7]);
            *(v4u*)(Y + (size_t)tok * 1024 + c0) = oa;
        }
    }
    __syncthreads();
}
}
#ifndef PH_MASK
#define PH_MASK 0xFFFu
#endif
#ifndef REP_MASK
#define REP_MASK 0u
#endif
#ifndef REP_N
#define REP_N 1
#endif
constexpr int NWAVES = 8;
constexpr int RING_OFF = 0, RING_BYTES = 131072;
constexpr int LDSCTL_OFF = RING_BYTES, MISC_OFF = LDSCTL_OFF + 320;
constexpr int LDS_BYTES = 147456;
constexpr int CW_BAR = 4096;

struct Params {
    const float *x, *p; const int* pos; const float *norm_mix, *w_in, *conv_w, *conv_b, *ln_g, *ln_b, *g_att, *g_conv, *w_out, *norm_ffn, *wq, *keys, *eu, *ev, *norm_ple, *wg, *wp, *fin;
    float* out; unsigned char* ws; float freq[8];
};

__device__ __forceinline__ void transpose_item(const float* W, int K, int NW, bf16* WT, int n_dst0, int n_src0, int k0, LAS float* scr, int lane) {
#pragma unroll 8
    for (int i = 0; i < 32; ++i) { const int kk = 2 * i + (lane >> 5); scr[kk * 33 + (lane & 31)] = W[(size_t)(k0 + kk) * NW + n_src0 + (lane & 31)]; }
    LDS_WAIT(); asm volatile("" ::: "memory");
    const int c = lane & 7;
#pragma unroll
    for (int j = 0; j < 4; ++j) { const int n = (lane >> 3) + 8 * j; const LAS float* s = scr + (8 * c) * 33 + n;
        v4u o; o.x = pk2(s[0 * 33], s[1 * 33]); o.y = pk2(s[2 * 33], s[3 * 33]); o.z = pk2(s[4 * 33], s[5 * 33]); o.w = pk2(s[6 * 33], s[7 * 33]);
        *(v4u*)(WT + (size_t)(n_dst0 + n) * K + k0 + 8 * c) = o; }
    LDS_WAIT(); asm volatile("" ::: "memory");
}

__global__ void __launch_bounds__(NWAVES * 64, 2) mega(Params a) {
    extern __shared__ __attribute__((aligned(16))) unsigned char lds_raw[];
    LAS unsigned char* lds = (LAS unsigned char*)lds_raw;
    volatile LAS unsigned* MISC = (volatile LAS unsigned*)(lds + MISC_OFF);
    const int wave = __builtin_amdgcn_readfirstlane((int)threadIdx.x >> 6);
#define LANE_ ((int)(threadIdx.x & 63u))
    const int G = gridDim.x, bx = blockIdx.x, vcu = (G % 8 == 0) ? (bx % 8) * (G / 8) + bx / 8 : bx;
    const int gw = vcu * NWAVES + wave, NGW = G * NWAVES, NGT = G * NWAVES * 64;
#define GT_ (vcu * (NWAVES * 64) + (int)threadIdx.x)
    unsigned* ctl = (unsigned*)(a.ws + WS_CTL);
#define H ((float*)a.out)
#define cs ((float*)(a.ws + WS_ROPE))
#define sn ((float*)(a.ws + WS_ROPE) + NTOK * 8)
#define WIN ((bf16*)(a.ws + WS_WIN))
#define WOUT ((bf16*)(a.ws + WS_WOUT))
#define WQK ((bf16*)(a.ws + WS_WQK))
#define WG ((bf16*)(a.ws + WS_WG))
#define WP ((bf16*)(a.ws + WS_WP))
#define U ((bf16*)(a.ws + WS_U))
#define U8 ((unsigned char*)(a.ws + WS_U))
#define V8 ((unsigned char*)(a.ws + WS_U + 16 * MiB))
#define V ((bf16*)(a.ws + WS_V))
#define XN ((bf16*)(a.ws + WS_XN))
#define Q ((bf16*)(a.ws + WS_Q))
#define Kb ((bf16*)(a.ws + WS_K))
#define Vb ((bf16*)(a.ws + WS_VV))
#define GLU ((bf16*)(a.ws + WS_GLU))
#define SC ((bf16*)(a.ws + WS_SC))
#define ATT ((bf16*)(a.ws + WS_ATT))
#define Y ((bf16*)(a.ws + WS_Y))
#define EID ((int*)(a.ws + WS_EID))
#define GATE ((float*)(a.ws + WS_GATE))
#define PP ((bf16*)(a.ws + WS_PP))

    for (int u = threadIdx.x; u < (LDS_BYTES - LDSCTL_OFF) / 4; u += NWAVES * 64) ((LAS unsigned*)(lds + LDSCTL_OFF))[u] = 0u;
    __syncthreads();
    XcdBarrier bar = xcd_barrier_post(ctl + CW_BAR, MISC + 8);

    for (int rep_ = 0; rep_ < (((REP_MASK >> 0) & 1u) ? 1 + REP_N : 1); ++rep_) { if (rep_) xcd_barrier(bar);
    if (PH_MASK & (1u << 0)) {
    {
        LAS float* scr = (LAS float*)(lds + RING_OFF + wave * 16384);
        constexpr int I_IN = (DM / 64) * (DIN / 32), I_SQ = (DM / 64) * (DM / 32), I_WP = (PLE / 64) * (DM / 32);
        for (int it = gw; it < I_IN + 2 * I_SQ + I_WP; it += NGW) {
            int r = it;
            if (r < I_IN) { const int nb = r % (DIN / 32), kb = r / (DIN / 32); transpose_item(a.w_in, DM, DIN, WIN, 32 * nb, nv::win_srccol(32 * nb), 64 * kb, scr, LANE_); continue; } r -= I_IN;
            if (r < I_SQ) { const int nb = r % (DM / 32), kb = r / (DM / 32); transpose_item(a.w_out, DM, DM, WOUT, 32 * nb, 32 * nb, 64 * kb, scr, LANE_); continue; } r -= I_SQ;
            if (r < I_SQ) { const int nb = r % (DM / 32), kb = r / (DM / 32); transpose_item(a.wg, DM, DM, WG, 32 * nb, 32 * nb, 64 * kb, scr, LANE_); continue; } r -= I_SQ;
            { const int nb = r % (DM / 32), kb = r / (DM / 32); transpose_item(a.wp, PLE, DM, WP, 32 * nb, 32 * nb, 64 * kb, scr, LANE_); }
        }
        __syncthreads();
        tk::fold_phase(lds, a.wq, a.keys, WQK, vcu, G);
#ifndef PEER_FP8
#define PEER_FP8 1
#endif
#if PEER_FP8
#define F8C(x_, s_) fminf(fmaxf((x_) * (s_), -448.f), 448.f)
#define F8PK(v0_, s_) ({ int p_ = __builtin_amdgcn_cvt_pk_fp8_f32(F8C(v0_.x, s_), F8C(v0_.y, s_), 0, false); p_ = __builtin_amdgcn_cvt_pk_fp8_f32(F8C(v0_.z, s_), F8C(v0_.w, s_), p_, true); (unsigned)p_; })
        for (size_t i = GT_; i < (size_t)NEXP * DM / 16; i += NGT) {
            { const f32x4 q0 = ((const f32x4*)a.eu)[4 * i], q1 = ((const f32x4*)a.eu)[4 * i + 1], q2 = ((const f32x4*)a.eu)[4 * i + 2], q3 = ((const f32x4*)a.eu)[4 * i + 3];
              v4u o; o.x = F8PK(q0, peer3::USCALE); o.y = F8PK(q1, peer3::USCALE); o.z = F8PK(q2, peer3::USCALE); o.w = F8PK(q3, peer3::USCALE); ((v4u*)U8)[i] = o; }
            { const f32x4 q0 = ((const f32x4*)a.ev)[4 * i], q1 = ((const f32x4*)a.ev)[4 * i + 1], q2 = ((const f32x4*)a.ev)[4 * i + 2], q3 = ((const f32x4*)a.ev)[4 * i + 3];
              v4u o; o.x = F8PK(q0, peer3::VSCALE); o.y = F8PK(q1, peer3::VSCALE); o.z = F8PK(q2, peer3::VSCALE); o.w = F8PK(q3, peer3::VSCALE); ((v4u*)V8)[i] = o; } }
#undef F8C
#undef F8PK
#else
        for (size_t i = GT_; i < (size_t)NEXP * DM / 8; i += NGT) { const f32x4 u0 = ((const f32x4*)a.eu)[2 * i], u1 = ((const f32x4*)a.eu)[2 * i + 1], v0 = ((const f32x4*)a.ev)[2 * i], v1 = ((const f32x4*)a.ev)[2 * i + 1];
            v4u o; o.x = pk2(u0.x, u0.y); o.y = pk2(u0.z, u0.w); o.z = pk2(u1.x, u1.y); o.w = pk2(u1.z, u1.w); ((v4u*)U)[i] = o;
            o.x = pk2(v0.x, v0.y); o.y = pk2(v0.z, v0.w); o.z = pk2(v1.x, v1.y); o.w = pk2(v1.z, v1.w); ((v4u*)V)[i] = o; }
#endif
        for (size_t i = GT_; i < (size_t)NTOK * PLE / 8; i += NGT) { const f32x4 u0 = ((const f32x4*)a.p)[2 * i], u1 = ((const f32x4*)a.p)[2 * i + 1];
            v4u o; o.x = pk2(u0.x, u0.y); o.y = pk2(u0.z, u0.w); o.z = pk2(u1.x, u1.y); o.w = pk2(u1.z, u1.w); ((v4u*)PP)[i] = o; }
        for (int i = GT_; i < NTOK * 8; i += NGT) { const float ang = (float)a.pos[i >> 3] * a.freq[i & 7]; cs[i] = cosf(ang); sn[i] = sinf(ang); }
        for (int r = gw; r < NTOK; r += NGW) nv::rms_row<false>(r, LANE_, a.x, a.norm_mix, XN);
    }
    } }
    xcd_barrier(bar);
    for (int rep_ = 0; rep_ < (((REP_MASK >> 1) & 1u) ? 1 + REP_N : 1); ++rep_) { if (rep_) xcd_barrier(bar);
    if (PH_MASK & (1u << 1)) {
    { pg8::Gemm g{XN, WIN, NTOK, DIN, DM}; pg8::StaticOrder S; S.init(NTOK, DIN, G, bx); pg8::EpiInProj E{Q, cs, sn};
      pg8::gemm_phase<pg8::EpiInProj, pg8::StaticOrder, true, true>(lds + RING_OFF, g, S, E); }
    } }
    xcd_barrier(bar);
    for (int rep_ = 0; rep_ < (((REP_MASK >> 2) & 1u) ? 1 + REP_N : 1); ++rep_) { if (rep_) xcd_barrier(bar);
    if (PH_MASK & (1u << 2)) {
    att::phase(lds, Q, Kb, Vb, ATT, vcu, G);
    } }
    xcd_barrier(bar);
    for (int rep_ = 0; rep_ < (((REP_MASK >> 3) & 1u) ? 1 + REP_N : 1); ++rep_) { if (rep_) xcd_barrier(bar);
    if (PH_MASK & (1u << 3)) {
    mix::phase(lds, GLU, ATT, a.conv_w, a.conv_b, a.ln_g, a.ln_b, a.g_att, a.g_conv, Y, gw, NGW);
    } }
    xcd_barrier(bar);
    for (int rep_ = 0; rep_ < (((REP_MASK >> 4) & 1u) ? 1 + REP_N : 1); ++rep_) { if (rep_) xcd_barrier(bar);
    if (PH_MASK & (1u << 4)) {
    { pg8::Gemm g{Y, WOUT, NTOK, DM, DM}; pg8::StaticOrder S; S.init(NTOK, DM, G, bx); pg8::EpiResid E{a.x, H};
      pg8::gemm_phase<pg8::EpiResid, pg8::StaticOrder, false, true>(lds + RING_OFF, g, S, E); }
    } }
    xcd_barrier(bar);
    for (int rep_ = 0; rep_ < (((REP_MASK >> 5) & 1u) ? 1 + REP_N : 1); ++rep_) { if (rep_) xcd_barrier(bar);
    if (PH_MASK & (1u << 5)) {
    for (int r = gw; r < NTOK; r += NGW) nv::rms_row<false>(r, LANE_, H, a.norm_ffn, XN);
    } }
    xcd_barrier(bar);
    for (int rep_ = 0; rep_ < (((REP_MASK >> 6) & 1u) ? 1 + REP_N : 1); ++rep_) { if (rep_) xcd_barrier(bar);
    if (PH_MASK & (1u << 6)) {
    { pg8::Gemm g{XN, WQK, NTOK, 2048, DM}; pg8::StaticOrder S; S.init(NTOK, 2048, G, bx); pg8::EpiBf16<0> E{SC, 2048, nullptr, 0, 0, 1.f};
      pg8::gemm_phase<pg8::EpiBf16<0>, pg8::StaticOrder, true, true>(lds + RING_OFF, g, S, E); }
    } }
    xcd_barrier(bar);
    for (int rep_ = 0; rep_ < (((REP_MASK >> 7) & 1u) ? 1 + REP_N : 1); ++rep_) { if (rep_) xcd_barrier(bar);
    if (PH_MASK & (1u << 7)) {
    tk::phase(lds, SC, EID, GATE, vcu, G);
    } }
    xcd_barrier(bar);
    for (int rep_ = 0; rep_ < (((REP_MASK >> 8) & 1u) ? 1 + REP_N : 1); ++rep_) { if (rep_) xcd_barrier(bar);
    if (PH_MASK & (1u << 8)) {
#if PEER_FP8
    peer3::phase(lds, XN, U8, V8, EID, GATE, H, gw, NGW);
#else
    peer2::phase(lds, XN, U, V, EID, GATE, H, gw, NGW);
#endif
    } }
    xcd_barrier(bar);
    for (int rep_ = 0; rep_ < (((REP_MASK >> 9) & 1u) ? 1 + REP_N : 1); ++rep_) { if (rep_) xcd_barrier(bar);
    if (PH_MASK & (1u << 9)) {
    for (int r = gw; r < NTOK; r += NGW) nv::rms_row<false>(r, LANE_, H, a.norm_ple, XN);
    } }
    xcd_barrier(bar);
    for (int rep_ = 0; rep_ < (((REP_MASK >> 10) & 1u) ? 1 + REP_N : 1); ++rep_) { if (rep_) xcd_barrier(bar);
    if (PH_MASK & (1u << 10)) {
    { int kple = PLE; asm volatile("" : "+s"(kple));
      pg8::Gemm g{PP, WP, NTOK, DM, kple}; pg8::StaticOrder S; S.init(NTOK, DM, G, bx); pg8::EpiBf16<0> E{Y, DM, nullptr, 0, 0, 1.f};
      pg8::gemm_phase<pg8::EpiBf16<0>, pg8::StaticOrder, false, true>(lds + RING_OFF, g, S, E); }
    VM_WAIT(); __syncthreads();
    { pg8::Gemm g{XN, WG, NTOK, DM, DM}; pg8::StaticOrder S; S.init(NTOK, DM, G, bx); pg8::EpiPle E{H, Y};
      pg8::gemm_phase<pg8::EpiPle, pg8::StaticOrder, false, true>(lds + RING_OFF, g, S, E); }
    } }
    xcd_barrier(bar);
    for (int rep_ = 0; rep_ < (((REP_MASK >> 11) & 1u) ? 1 + REP_N : 1); ++rep_) { if (rep_) xcd_barrier(bar);
    if (PH_MASK & (1u << 11)) {
    for (int r = gw; r < NTOK; r += NGW) nv::rms_row<true>(r, LANE_, H, a.fin, H);
    } }
#undef H
#undef cs
#undef sn
#undef WIN
#undef WOUT
#undef WQK
#undef WG
#undef WP
#undef U
#undef U8
#undef V8
#undef V
#undef XN
#undef Q
#undef Kb
#undef Vb
#undef GLU
#undef SC
#undef ATT
#undef Y
#undef EID
#undef GATE
#undef PP
#undef LANE_
#undef GT_
}

extern "C" void kernel_launch(void* const* d_in, const int* in_sizes, int n_in, void* d_out, int out_size, void* d_ws, size_t ws_size, hipStream_t stream) {
    static int grid = 0;
    if (grid == 0) {
        if (n_in != 21 || out_size != NTOK * DM || ws_size < WS_END) { fprintf(stderr, "kernel_launch: unexpected shapes n_in %d out %d ws %zu\n", n_in, out_size, ws_size); grid = -1; return; }
        int dev = 0, cus = 0, per_cu = 0;
        if (hipGetDevice(&dev) != hipSuccess || hipDeviceGetAttribute(&cus, hipDeviceAttributeMultiprocessorCount, dev) != hipSuccess) { grid = -1; return; }
        if (hipFuncSetAttribute((const void*)mega, hipFuncAttributeMaxDynamicSharedMemorySize, LDS_BYTES) != hipSuccess) { fprintf(stderr, "kernel_launch: hipFuncSetAttribute failed\n"); grid = -1; return; }
        if (hipOccupancyMaxActiveBlocksPerMultiprocessor(&per_cu, (const void*)mega, NWAVES * 64, LDS_BYTES) != hipSuccess || per_cu < 1) { fprintf(stderr, "kernel_launch: occupancy query says %d\n", per_cu); }
        (void)hipGetLastError();
        grid = cus;
    }
    if (grid < 0) return;
    (void)hipMemsetAsync((char*)d_ws + WS_CTL, 0, 1 * MiB, stream);
    Params a{};
    a.x = (const float*)d_in[0]; a.p = (const float*)d_in[1]; a.pos = (const int*)d_in[2]; a.norm_mix = (const float*)d_in[3]; a.w_in = (const float*)d_in[4]; a.conv_w = (const float*)d_in[5];
    a.conv_b = (const float*)d_in[6]; a.ln_g = (const float*)d_in[7]; a.ln_b = (const float*)d_in[8]; a.g_att = (const float*)d_in[9]; a.g_conv = (const float*)d_in[10]; a.w_out = (const float*)d_in[11];
    a.norm_ffn = (const float*)d_in[12]; a.wq = (const float*)d_in[13]; a.keys = (const float*)d_in[14]; a.eu = (const float*)d_in[15]; a.ev = (const float*)d_in[16]; a.norm_ple = (const float*)d_in[17];
    a.wg = (const float*)d_in[18]; a.wp = (const float*)d_in[19]; a.fin = (const float*)d_in[20]; a.out = (float*)d_out; a.ws = (unsigned char*)d_ws;
    for (int i = 0; i < 8; ++i) a.freq[i] = (float)pow(500000.0, -(double)i / 8.0);
    hipLaunchKernelGGL(mega, dim3(grid), dim3(NWAVES * 64), LDS_BYTES, stream, a);
}
```
